# Optimizing an MI355X kernel written in HIP

```python
import jax, jax.numpy as jnp
from jax import lax
import numpy as np

D_MODEL = 2048
BATCH = 1
SEQ = 8192
DEPTH = 1

HEAD_DIM = 128
DSA_HEADS = 8
MOBA_HEADS = 8
DSA_W = DSA_HEADS * HEAD_DIM
MOBA_W = MOBA_HEADS * HEAD_DIM
ROPE_DIM = HEAD_DIM // 4
ROPE_THETA = 500000.0
IDX_HEADS = 16
IDX_DIM = 64
IDX_ROPE_DIM = IDX_DIM // 4
DSA_TOPK = 256
MOBA_BLOCK = 256
MOBA_TOPK = 3
Q_BLOCK = 128
N_EXPERTS = 32
EXPERT_TOPK = 4
D_FF = 2048
SWIGLU_LIMIT = 7.0
SWIGLU_ALPHA = 1.702
PLE_DIM = 256
MOE_ROW_BLOCK = 256
EPS = 1e-6
IN_SIZES = (DSA_W, DSA_W, DSA_W, IDX_HEADS * IDX_DIM, IDX_DIM, IDX_HEADS,
            MOBA_W, MOBA_W, MOBA_W, D_MODEL, D_MODEL)
IN_WIDTH = sum(IN_SIZES)

kernel_name = "hybrid_dsa_moba_gated_moe_ple"


def rms_norm(x, g):
    xf = x.astype(jnp.float32)
    y = xf * lax.rsqrt(jnp.mean(xf * xf, axis=-1, keepdims=True) + EPS)
    return (y * g.astype(jnp.float32)).astype(x.dtype)


def layer_norm(x, g, b):
    xf = x.astype(jnp.float32)
    mu = jnp.mean(xf, axis=-1, keepdims=True)
    var = jnp.mean(jnp.square(xf - mu), axis=-1, keepdims=True)
    y = (xf - mu) * lax.rsqrt(var + EPS)
    return (y * g.astype(jnp.float32) + b.astype(jnp.float32)).astype(x.dtype)


def rope(x, pos, rot_dim):
    half = rot_dim // 2
    inv = 1.0 / (ROPE_THETA ** (jnp.arange(half, dtype=jnp.float32) / half))
    ang = pos.astype(jnp.float32)[:, None] * inv[None, :]
    cos = jnp.cos(ang)[:, None, :].astype(x.dtype)
    sin = jnp.sin(ang)[:, None, :].astype(x.dtype)
    x1 = x[..., :half]
    x2 = x[..., half:rot_dim]
    return jnp.concatenate([x1 * cos - x2 * sin, x2 * cos + x1 * sin, x[..., rot_dim:]], axis=-1)


def dsa_attention(q, k, v, q_idx, k_idx, w_idx):
    B, S, H, dh = q.shape
    n_sel = min(DSA_TOPK, S // 4)
    key_pos = jnp.arange(S)
    scale = dh ** -0.5

    def block(qb):
        start = qb * Q_BLOCK
        qpos = start + jnp.arange(Q_BLOCK)
        qi = lax.dynamic_slice_in_dim(q_idx, start, Q_BLOCK, axis=1)
        wi = lax.dynamic_slice_in_dim(w_idx, start, Q_BLOCK, axis=1)
        logits = jnp.einsum('bqhd,bsd->bqhs', qi, k_idx)
        score = jnp.einsum('bqhs,bqh->bqs', jax.nn.relu(logits), wi).astype(jnp.float32)
        score = jnp.where((key_pos[None, :] <= qpos[:, None])[None], score, -jnp.inf)
        _, sel = lax.top_k(score, n_sel)
        valid = sel <= qpos[None, :, None]
        k_sel = jax.vmap(lambda kb, ib: kb[ib])(k, sel)
        v_sel = jax.vmap(lambda vb, ib: vb[ib])(v, sel)
        qq = lax.dynamic_slice_in_dim(q, start, Q_BLOCK, axis=1)
        s = jnp.einsum('bqhd,bqkhd->bhqk', qq, k_sel).astype(jnp.float32) * scale
        s = jnp.where(valid[:, None], s, -jnp.inf)
        pr = jax.nn.softmax(s, axis=-1).astype(v.dtype)
        return jnp.einsum('bhqk,bqkhd->bqhd', pr, v_sel)

    out = lax.map(block, jnp.arange(S // Q_BLOCK))
    return out.transpose(1, 0, 2, 3, 4).reshape(B, S, H * dh)


def moba_attention(q, k, v):
    B, S, H, dh = q.shape
    nkb = -(-S // MOBA_BLOCK)
    s_pad = nkb * MOBA_BLOCK
    n_top = min(MOBA_TOPK, nkb)
    scale = dh ** -0.5
    pad = ((0, 0), (0, s_pad - S), (0, 0), (0, 0))
    k_blocks = jnp.pad(k, pad).reshape(B, nkb, MOBA_BLOCK, H, dh).transpose(0, 3, 1, 2, 4)
    v_blocks = jnp.pad(v, pad).reshape(B, nkb, MOBA_BLOCK, H, dh).transpose(0, 3, 1, 2, 4)
    k_mean = jnp.mean(k_blocks.astype(jnp.float32), axis=3)
    blk_idx = jnp.arange(nkb)
    gather2 = jax.vmap(jax.vmap(lambda kb, ib: kb[ib]))

    def block(qb):
        start = qb * Q_BLOCK
        qpos = start + jnp.arange(Q_BLOCK)
        own = start // MOBA_BLOCK
        qq = lax.dynamic_slice_in_dim(q, start, Q_BLOCK, axis=1)
        gate = jnp.einsum('bqhd,bhnd->bhqn', qq.astype(jnp.float32), k_mean)
        gate = jnp.where(blk_idx < own, gate, -jnp.inf)
        _, sel = lax.top_k(gate, n_top)
        sel_valid = sel < own
        k_sel = gather2(k_blocks, sel)
        v_sel = gather2(v_blocks, sel)
        s_sel = jnp.einsum('bqhd,bhqnkd->bhqnk', qq, k_sel).astype(jnp.float32) * scale
        s_sel = jnp.where(sel_valid[..., None], s_sel, -jnp.inf).reshape(B, H, Q_BLOCK, n_top * MOBA_BLOCK)
        k_own = lax.dynamic_index_in_dim(k_blocks, own, axis=2, keepdims=False)
        v_own = lax.dynamic_index_in_dim(v_blocks, own, axis=2, keepdims=False)
        s_own = jnp.einsum('bqhd,bhkd->bhqk', qq, k_own).astype(jnp.float32) * scale
        own_pos = own * MOBA_BLOCK + jnp.arange(MOBA_BLOCK)
        s_own = jnp.where(own_pos[None, :] <= qpos[:, None], s_own, -jnp.inf)
        pr = jax.nn.softmax(jnp.concatenate([s_sel, s_own], axis=-1), axis=-1).astype(v.dtype)
        p_sel = pr[..., :n_top * MOBA_BLOCK].reshape(B, H, Q_BLOCK, n_top, MOBA_BLOCK)
        p_own = pr[..., n_top * MOBA_BLOCK:]
        return (jnp.einsum('bhqnk,bhqnkd->bqhd', p_sel, v_sel)
                + jnp.einsum('bhqk,bhkd->bqhd', p_own, v_own))

    out = lax.map(block, jnp.arange(S // Q_BLOCK))
    return out.transpose(1, 0, 2, 3, 4).reshape(B, S, H * dh)


def moe(h, w_router, b_router, w_gate_up, b_gate_up, w_down, b_down):
    B, S, D = h.shape
    T = B * S
    xt = h.reshape(T, D)
    logits = (xt @ w_router + b_router).astype(jnp.float32)
    top_val, top_idx = lax.top_k(logits, EXPERT_TOPK)
    gates = jax.nn.softmax(top_val, axis=-1)
    n_slots = T * EXPERT_TOPK
    e_flat = top_idx.reshape(-1)
    tok_flat = jnp.arange(n_slots, dtype=jnp.int32) // EXPERT_TOPK
    g_flat = gates.reshape(-1)
    order = jnp.argsort(e_flat)
    e_sorted = e_flat[order]
    counts = jnp.bincount(e_flat, length=N_EXPERTS)
    padded = (counts + MOE_ROW_BLOCK - 1) // MOE_ROW_BLOCK * MOE_ROW_BLOCK
    pad_end = jnp.cumsum(padded)
    pad_start = pad_end - padded
    start = jnp.cumsum(counts) - counts
    dest = pad_start[e_sorted] + jnp.arange(n_slots, dtype=jnp.int32) - start[e_sorted]
    n_blocks = -(-n_slots // MOE_ROW_BLOCK) + N_EXPERTS
    n_rows = n_blocks * MOE_ROW_BLOCK
    row_tok = jnp.zeros((n_rows,), jnp.int32).at[dest].set(tok_flat[order])
    row_gate = jnp.zeros((n_rows,), jnp.float32).at[dest].set(g_flat[order])
    block_expert = jnp.minimum(
        jnp.searchsorted(pad_end, jnp.arange(n_blocks) * MOE_ROW_BLOCK, side='right'), N_EXPERTS - 1)
    x_rows = xt[row_tok].reshape(n_blocks, MOE_ROW_BLOCK, D)

    def expert_block(args):
        xb, e = args
        gu = xb @ w_gate_up[e] + b_gate_up[e]
        g = jnp.minimum(gu[..., ::2], SWIGLU_LIMIT)
        lin = jnp.clip(gu[..., 1::2], -SWIGLU_LIMIT, SWIGLU_LIMIT)
        glu = g * jax.nn.sigmoid(g * SWIGLU_ALPHA)
        return ((lin + 1.0) * glu) @ w_down[e] + b_down[e]

    y = lax.map(expert_block, (x_rows, block_expert)).reshape(n_rows, D)
    out = jnp.zeros((T, D), xt.dtype).at[row_tok].add(y * row_gate[:, None].astype(y.dtype))
    return out.reshape(B, S, D)


def setup_inputs(seed: int = 0) -> dict:
    key = jax.random.key(seed)
    ks = jax.random.split(key, 24)
    L, D = DEPTH, D_MODEL
    nrm = lambda k, shape, fan: jax.random.normal(k, shape, jnp.float32) * (fan ** -0.5)
    gain = lambda k, shape: 1.0 + 0.02 * jax.random.normal(k, shape, jnp.float32)
    small = lambda k, shape, s: s * jax.random.normal(k, shape, jnp.float32)
    return {
        "x": jax.random.normal(ks[0], (BATCH, SEQ, D), jnp.float32),
        "p": jax.random.normal(ks[1], (DEPTH, BATCH, SEQ, PLE_DIM), jnp.float32),
        "g_mix": gain(ks[2], (L, D)),
        "w_in": nrm(ks[3], (L, D, IN_WIDTH), D),
        "g_idx_k": gain(ks[4], (L, IDX_DIM)),
        "b_idx_k": small(ks[5], (L, IDX_DIM), 0.02),
        "w_br_a": nrm(ks[6], (L, DSA_W, D), DSA_W),
        "w_br_b": nrm(ks[7], (L, MOBA_W, D), MOBA_W),
        "w_out": nrm(ks[8], (L, D, D), D),
        "g_ffn": gain(ks[9], (L, D)),
        "w_router": nrm(ks[10], (L, D, N_EXPERTS), D),
        "b_router": small(ks[11], (L, N_EXPERTS), 0.01),
        "w_gate_up": nrm(ks[12], (L, N_EXPERTS, D, 2 * D_FF), D),
        "b_gate_up": small(ks[13], (L, N_EXPERTS, 2 * D_FF), 0.02),
        "w_down": nrm(ks[14], (L, N_EXPERTS, D_FF, D), D_FF),
        "b_down": small(ks[15], (L, N_EXPERTS, D), 0.02),
        "w_ple_proj": nrm(ks[16], (L, PLE_DIM, D), PLE_DIM),
        "w_ple_gate": nrm(ks[17], (L, D, D), D),
        "g_ple": gain(ks[18], (L, D)),
        "g_final": gain(ks[19], (D,)),
    }


def reference(x, p, g_mix, w_in, g_idx_k, b_idx_k, w_br_a, w_br_b, w_out, g_ffn,
              w_router, b_router, w_gate_up, b_gate_up, w_down, b_down,
              w_ple_proj, w_ple_gate, g_ple, g_final):
    B, S, D = x.shape
    pos = jnp.arange(S)
    split_pts = [int(c) for c in np.cumsum(IN_SIZES)[:-1]]
    idx_w_scale = (IDX_HEADS ** -0.5) * (IDX_DIM ** -0.5)
    for i in range(DEPTH):
        h = rms_norm(x, g_mix[i])
        proj = h @ w_in[i]
        qa, ka, va, qi, ki, wi, qb, kb, vb, ga, gb = jnp.split(proj, split_pts, axis=-1)
        qa = rope(qa.reshape(B, S, DSA_HEADS, HEAD_DIM), pos, ROPE_DIM)
        ka = rope(ka.reshape(B, S, DSA_HEADS, HEAD_DIM), pos, ROPE_DIM)
        va = va.reshape(B, S, DSA_HEADS, HEAD_DIM)
        qi = rope(qi.reshape(B, S, IDX_HEADS, IDX_DIM), pos, IDX_ROPE_DIM)
        ki = rope(layer_norm(ki, g_idx_k[i], b_idx_k[i])[:, :, None, :], pos, IDX_ROPE_DIM)[:, :, 0, :]
        wi = wi * idx_w_scale
        o_a = dsa_attention(qa, ka, va, qi, ki, wi)
        qb = rope(qb.reshape(B, S, MOBA_HEADS, HEAD_DIM), pos, ROPE_DIM)
        kb = rope(kb.reshape(B, S, MOBA_HEADS, HEAD_DIM), pos, ROPE_DIM)
        vb = vb.reshape(B, S, MOBA_HEADS, HEAD_DIM)
        o_b = moba_attention(qb, kb, vb)
        merged = jax.nn.sigmoid(ga) * (o_a @ w_br_a[i]) + jax.nn.sigmoid(gb) * (o_b @ w_br_b[i])
        x = x + merged @ w_out[i]
        h2 = rms_norm(x, g_ffn[i])
        x = x + moe(h2, w_router[i], b_router[i], w_gate_up[i], b_gate_up[i], w_down[i], b_down[i])
        ple = p[i] @ w_ple_proj[i]
        x = x + rms_norm(jax.nn.sigmoid(x @ w_ple_gate[i]) * ple, g_ple[i])
    return rms_norm(x, g_final)
```

```cpp
#include <hip/hip_runtime.h>
#include <hip/hip_bf16.h>
#include <cstdio>
#include <cstdint>

#define GAS __attribute__((address_space(1)))
#define LAS __attribute__((address_space(3)))
typedef unsigned short bf16_t;
typedef short bf16x8 __attribute__((ext_vector_type(8)));
typedef short s16x4 __attribute__((ext_vector_type(4)));
typedef float f32x4 __attribute__((ext_vector_type(4)));
typedef float f32x2 __attribute__((ext_vector_type(2)));
typedef float f32x16 __attribute__((ext_vector_type(16)));
typedef unsigned u32x4 __attribute__((ext_vector_type(4)));
typedef unsigned u32x2 __attribute__((ext_vector_type(2)));

typedef __bf16 bf16x2_n __attribute__((ext_vector_type(2)));
__device__ __forceinline__ unsigned cvt_pk_bf16(float lo, float hi) { const f32x2 v = {lo, hi}; return __builtin_bit_cast(unsigned, __builtin_convertvector(v, bf16x2_n)); }
__device__ __forceinline__ float bf_lo(unsigned w) { return __uint_as_float(w << 16); }
__device__ __forceinline__ float bf_hi(unsigned w) { return __uint_as_float(w & 0xffff0000u); }
__device__ __forceinline__ float sigmoidf_(float x) { return __builtin_amdgcn_rcpf(1.0f + __builtin_amdgcn_exp2f(x * -1.4426950408889634f)); }
__device__ __forceinline__ float sigmoid_fast(float x) { return sigmoidf_(x); }
__device__ __forceinline__ int lane_id_v() { int l; asm volatile("v_mbcnt_lo_u32_b32 %0, -1, 0\n\tv_mbcnt_hi_u32_b32 %0, -1, %0" : "=v"(l)); return l; }

namespace pg8 {
constexpr int BM = 256, BK = 64, HALF = 128, HTB = HALF * BK * 2, STAGE_BYTES = 8 * HTB, NXCD = 8, WGM = 8;
__host__ __device__ __forceinline__ int lds_byte(int r, int c) { const int st = (r >> 4) * 2 + (c >> 5), rr = r & 15, cc = c & 31, ob = rr * 64 + cc * 2; return st * 1024 + (ob ^ (((ob >> 9) & 1) << 5)); }
__host__ __device__ __forceinline__ void stage_rc(int b, int& R, int& C) { const int st = b / 1024, sb = b % 1024, swz = sb ^ (((sb >> 9) & 1) << 5); R = (st >> 1) * 16 + swz / 64; C = (st & 1) * 32 + (swz % 64) / 2; }
__host__ __device__ __forceinline__ int perm32(int rho) { const int n = rho >> 4, i = rho & 15; return 8 * (i >> 2) + 4 * n + (i & 3); }

struct Unit { int pm, pn, e, b, rows, rb; };

struct DenseOrder {
    int nM, nN, nwg, G, c;
    __device__ void init(int M, int N, int G_, int c_) { nM = M / BM; nN = N / BM; nwg = nM * nN; G = G_; c = c_; }
    __device__ bool next(int i, Unit& u) const {
        const long L = (long)i * G + c; if (L >= nwg) return false;
        int wgid = (int)L; { const int q = nwg / NXCD, r = nwg % NXCD, xcd = wgid % NXCD, off = wgid / NXCD; wgid = (xcd < r ? xcd * (q + 1) : r * (q + 1) + (xcd - r) * q) + off; }
        const int nig = WGM * nN, gid = wgid / nig, fm = gid * WGM, gsz = (nM - fm) < WGM ? (nM - fm) : WGM;
        u.pm = fm + ((wgid % nig) % gsz); u.pn = (wgid % nig) / gsz; u.e = 0; u.b = 0; u.rows = 256; u.rb = u.pm; return true;
    }
    __device__ __forceinline__ size_t a_row0(const Unit& u) const { return (size_t)u.pm * BM; }
    __device__ __forceinline__ size_t b_row0(const Unit& u) const { return (size_t)u.pn * BM; }
    __device__ __forceinline__ int a_row(const Unit&, int) const { return 0; }
    static constexpr bool PARTIAL = false;
};

template <class Epi, class Sched, bool GATHER, bool ALIGN_EPI, bool BBLK = false>
__device__ __forceinline__ void gemm_phase(LAS unsigned char* lds, const bf16_t* A, const bf16_t* Bt, const int K, const Sched& S, const Epi& E, const int wid) {
    const int lane = lane_id_v(), tid = wid * 64 + lane, wr = wid >> 2, wc = wid & 3, fr = lane & 15, fq = lane >> 4;
    const int nt = K / BK;
    int Rr[2], Cc[2]; unsigned voffB[2], vC[2][2], vN[2][2];
#pragma unroll
    for (int i = 0; i < 2; ++i) { stage_rc(tid * 16 + i * 8192, Rr[i], Cc[i]); const int Rb = (Rr[i] & ~31) + perm32(Rr[i] & 31);
        voffB[i] = BBLK ? (unsigned)((Rb >> 6) * (K >> 6)) * 8192u + (unsigned)((Rb & 63) * 128 + Cc[i] * 2) : (unsigned)(Rb * K + Cc[i]) * 2u; }
    const size_t kstep = (size_t)(BK * 2), kstepB = BBLK ? (size_t)8192 : kstep;
    const size_t hstep = (size_t)HALF * K * 2;
    const unsigned ldsw = (unsigned)wid * 1024u;
    const int aoff = lds_byte(wr * 64 + fr, fq * 8), boff = lds_byte(wc * 32 + fr, fq * 8);
    const unsigned lbase = (unsigned)(unsigned long long)lds;
#define PG8_SA(b, h) (((b) * 2 + (h)) * HTB)
#define PG8_SB(b, h) ((4 + (b) * 2 + (h)) * HTB)
#define PG8_STAGE(bufoff, gbase, voff) do { _Pragma("unroll") for (int _i = 0; _i < 2; ++_i) \
        __builtin_amdgcn_global_load_lds((const unsigned*)((const char*)(gbase) + (voff)[_i]), (LAS unsigned*)(lds + (bufoff) + ldsw + _i * 8192), 16, 0, 0); } while (0)
#define PG8_STAGEA(bufoff, gbase, VO, h) PG8_STAGE(bufoff, (gbase) + (GATHER ? (size_t)0 : (size_t)(h) * hstep), (VO)[GATHER ? (h) : 0])
#define PG8_LDA(dst, b, h) do { _Pragma("unroll") for (int m = 0; m < 4; ++m) _Pragma("unroll") for (int k = 0; k < 2; ++k) dst[m][k] = *(const LAS bf16x8*)(lds + PG8_SA(b, h) + aoff + m * 2048 + k * 1024); } while (0)
#define PG8_LDB(dst, b, h) do { _Pragma("unroll") for (int n = 0; n < 2; ++n) _Pragma("unroll") for (int k = 0; k < 2; ++k) dst[n][k] = *(const LAS bf16x8*)(lds + PG8_SB(b, h) + boff + n * 2048 + k * 1024); } while (0)
#define PG8_MMA(ai, bj, At, Bt_) do { __builtin_amdgcn_s_setprio(1); _Pragma("unroll") for (int m = 0; m < 4; ++m) _Pragma("unroll") for (int n = 0; n < 2; ++n) _Pragma("unroll") for (int k = 0; k < 2; ++k) \
        acc[ai][bj][m][n] = __builtin_amdgcn_mfma_f32_16x16x32_bf16(Bt_[n][k], At[m][k], acc[ai][bj][m][n], 0, 0, 0); __builtin_amdgcn_s_setprio(0); } while (0)
#define PG8_WAIT_V(n) asm volatile("s_waitcnt vmcnt(" #n ")" ::: "memory")
#define PG8_WAIT_L(n) asm volatile("s_waitcnt lgkmcnt(" #n ")" ::: "memory")
#define PG8_BAR __builtin_amdgcn_s_barrier()
#define PG8_SCHED __builtin_amdgcn_sched_barrier(0)
#define PG8_VOFF(dst, u) do { _Pragma("unroll") for (int _h = 0; _h < 2; ++_h) _Pragma("unroll") for (int _i = 0; _i < 2; ++_i) { \
        const int _r = GATHER ? S.a_row(u, _h * HALF + Rr[_i]) : (_h * HALF + Rr[_i]); dst[_h][_i] = (unsigned)(_r * K + Cc[_i]) * 2u; } \
        if (GATHER) { asm volatile("s_waitcnt vmcnt(0)" ::: "memory"); } } while (0)
#define PG8_DSR(dst, base, off) asm volatile("ds_read_b128 %0, %1 offset:" #off : "=v"(dst) : "v"(base))
#define PG8_LDA_ASM(dst, b, h) do { const unsigned _ab = lbase + (unsigned)(PG8_SA(b, h) + aoff); PG8_DSR(dst[0][0], _ab, 0); PG8_DSR(dst[0][1], _ab, 1024); PG8_DSR(dst[1][0], _ab, 2048); PG8_DSR(dst[1][1], _ab, 3072); \
        PG8_DSR(dst[2][0], _ab, 4096); PG8_DSR(dst[2][1], _ab, 5120); PG8_DSR(dst[3][0], _ab, 6144); PG8_DSR(dst[3][1], _ab, 7168); } while (0)
#define PG8_LDB_ASM(dst, b, h) do { const unsigned _bb = lbase + (unsigned)(PG8_SB(b, h) + boff); PG8_DSR(dst[0][0], _bb, 0); PG8_DSR(dst[0][1], _bb, 1024); PG8_DSR(dst[1][0], _bb, 2048); PG8_DSR(dst[1][1], _bb, 3072); } while (0)
#define PG8_UNDEF_A(dst) do { _Pragma("unroll") for (int m = 0; m < 4; ++m) _Pragma("unroll") for (int k = 0; k < 2; ++k) asm volatile("" : "=v"(dst[m][k])); } while (0)
#define PG8_UNDEF_B(dst) do { _Pragma("unroll") for (int n = 0; n < 2; ++n) _Pragma("unroll") for (int k = 0; k < 2; ++k) asm volatile("" : "=v"(dst[n][k])); } while (0)
#define PG8_KLOOP(D0, D1, LDA_, LDB_) \
        _Pragma("unroll 1") for (int t = 0; t < nt; t += 2) { \
            const bool last = (t == nt - 2); \
            if constexpr (Epi::HAS_MID) { if (t == E.mid_t) E.mid(acc, cur, wr, wc, fr, fq); } \
            const char* a1 = cA + (size_t)(t + 1) * kstep; \
            const char* a2 = last ? nA : cA + (size_t)(t + 2) * kstep; const char* b2 = last ? nB : cB + (size_t)(t + 2) * kstepB; \
            const char* a3 = a2 + kstep; const char* b3 = b2 + kstepB; \
            unsigned o2[2][2]; \
            _Pragma("unroll") for (int h = 0; h < 2; ++h) _Pragma("unroll") for (int i = 0; i < 2; ++i) o2[h][i] = (GATHER && last) ? vN[h][i] : vC[h][i]; \
            if (D0) { LDB_(B0, 0, 0); LDB_(B1, 0, 1); PG8_SCHED; LDA_(At, 0, 0); } else { PG8_UNDEF_B(B0); PG8_UNDEF_B(B1); PG8_UNDEF_A(At); } PG8_STAGEA(PG8_SA(1, 1), a1, vC, 1); \
            PG8_WAIT_V(8); PG8_WAIT_L(0); PG8_BAR; if (D0) { PG8_MMA(0, 0, At, B0); PG8_MMA(0, 1, At, B1); } PG8_BAR; PG8_SCHED; \
            if (D1) { LDA_(At, 0, 1); } else { PG8_UNDEF_A(At); } PG8_STAGE(PG8_SB(0, 0), b2, voffB); PG8_STAGE(PG8_SB(0, 1), b2 + hstep, voffB); PG8_STAGEA(PG8_SA(0, 0), a2, o2, 0); \
            PG8_WAIT_V(8); PG8_WAIT_L(0); PG8_BAR; if (D1) { PG8_MMA(1, 0, At, B0); PG8_MMA(1, 1, At, B1); } PG8_BAR; PG8_SCHED; \
            if (D0) { LDB_(B0, 1, 0); LDB_(B1, 1, 1); PG8_SCHED; LDA_(At, 1, 0); } else { PG8_UNDEF_B(B0); PG8_UNDEF_B(B1); PG8_UNDEF_A(At); } PG8_STAGEA(PG8_SA(0, 1), a2, o2, 1); \
            PG8_WAIT_V(8); PG8_WAIT_L(0); PG8_BAR; if (D0) { PG8_MMA(0, 0, At, B0); PG8_MMA(0, 1, At, B1); } PG8_BAR; PG8_SCHED; \
            if (D1) { LDA_(At, 1, 1); } else { PG8_UNDEF_A(At); } PG8_STAGE(PG8_SB(1, 0), b3, voffB); PG8_STAGE(PG8_SB(1, 1), b3 + hstep, voffB); PG8_STAGEA(PG8_SA(1, 0), a3, o2, 0); \
            PG8_WAIT_V(8); PG8_WAIT_L(0); PG8_BAR; if (D1) { PG8_MMA(1, 0, At, B0); PG8_MMA(1, 1, At, B1); } PG8_BAR; PG8_SCHED; \
        }
    Unit cur, nxt; int ui = 0;
    if (!S.next(0, cur)) return;
    f32x4 acc[2][2][4][2];
#pragma unroll
    for (int a = 0; a < 2; ++a)
#pragma unroll
        for (int b = 0; b < 2; ++b)
#pragma unroll
            for (int m = 0; m < 4; ++m)
#pragma unroll
                for (int n = 0; n < 2; ++n) acc[a][b][m][n] = (f32x4){0.f, 0.f, 0.f, 0.f};
    bf16x8 At[4][2], B0[2][2], B1[2][2];
    PG8_VOFF(vC, cur);
#pragma unroll
    for (int h = 0; h < 2; ++h)
#pragma unroll
        for (int i = 0; i < 2; ++i) vN[h][i] = vC[h][i];
    const char* cA = (const char*)A + (GATHER ? (size_t)0 : S.a_row0(cur) * (size_t)K * 2); const char* cB = (const char*)Bt + S.b_row0(cur) * (size_t)K * 2;
    PG8_STAGE(PG8_SB(0, 0), cB, voffB); PG8_STAGE(PG8_SB(0, 1), cB + hstep, voffB); PG8_STAGEA(PG8_SA(0, 0), cA, vC, 0); PG8_STAGEA(PG8_SA(0, 1), cA, vC, 1);
    if (wr == 1) PG8_BAR;
    PG8_WAIT_V(2); PG8_BAR;
    PG8_STAGE(PG8_SB(1, 0), cB + kstepB, voffB); PG8_STAGEA(PG8_SA(1, 0), cA + kstep, vC, 0); PG8_STAGE(PG8_SB(1, 1), cB + hstep + kstepB, voffB);
    PG8_WAIT_V(6); PG8_BAR;
    for (;;) {
        bool do0 = true, do1 = true;
        if constexpr (Sched::PARTIAL) { do0 = wr * 64 < cur.rows; do1 = HALF + wr * 64 < cur.rows; }
        const bool has_next = S.next(ui + 1, nxt);
        const char* nA = (has_next && !GATHER) ? (const char*)A + S.a_row0(nxt) * (size_t)K * 2 : cA; const char* nB = has_next ? (const char*)Bt + S.b_row0(nxt) * (size_t)K * 2 : cB;
        if (GATHER && has_next) { PG8_VOFF(vN, nxt); }
        if (do1) { PG8_KLOOP(true, true, PG8_LDA, PG8_LDB) } else if (do0) { PG8_KLOOP(true, false, PG8_LDA, PG8_LDB) } else { PG8_KLOOP(false, false, PG8_LDA, PG8_LDB) }
        if constexpr (ALIGN_EPI) { if (wr == 0) PG8_BAR; }
        E(acc, cur, wr, wc, fr, fq);
#ifdef EPI_TWICE
        asm volatile("" ::: "memory"); E(acc, cur, wr, wc, fr, fq);
#endif
        if (!has_next) break;
#pragma unroll
        for (int a = 0; a < 2; ++a)
#pragma unroll
            for (int b = 0; b < 2; ++b)
#pragma unroll
                for (int m = 0; m < 4; ++m)
#pragma unroll
                    for (int n = 0; n < 2; ++n) acc[a][b][m][n] = (f32x4){0.f, 0.f, 0.f, 0.f};
        cur = nxt; cA = nA; cB = nB; ++ui;
#pragma unroll
        for (int h = 0; h < 2; ++h)
#pragma unroll
            for (int i = 0; i < 2; ++i) vC[h][i] = vN[h][i];
        if constexpr (ALIGN_EPI) { if (wr == 1) PG8_BAR; }
    }
    PG8_WAIT_V(0);
    if constexpr (!ALIGN_EPI) { if (wr == 0) PG8_BAR; }
    PG8_BAR;
#undef PG8_SA
#undef PG8_SB
#undef PG8_STAGE
#undef PG8_STAGEA
#undef PG8_LDA
#undef PG8_LDB
#undef PG8_MMA
#undef PG8_WAIT_V
#undef PG8_WAIT_L
#undef PG8_BAR
#undef PG8_SCHED
#undef PG8_VOFF
#undef PG8_KLOOP
#undef PG8_UNDEF_A
#undef PG8_UNDEF_B
#undef PG8_DSR
#undef PG8_LDA_ASM
#undef PG8_LDB_ASM
}
}
constexpr int SEQ = 8192, DM = 2048, HD = 128, NHEAD = 8, BRW = 1024, IDXH = 16, IDXD = 64, NEXP = 32, TOPK = 4, DFF = 2048, PLED = 256;
constexpr int INW = 11344, NPRJ = 11520;
constexpr int DSA_TOPK = 256, MOBA_BLK = 256, NKB = SEQ / MOBA_BLK;
constexpr float EPS = 1e-6f, SWI_LIMIT = 7.0f, SWI_ALPHA = 1.702f, IDX_W_SCALE = 0.03125f;

#define ACC_T f32x4 (&acc)[2][2][4][2]
#define CACC_T const f32x4 (&acc)[2][2][4][2]
__device__ __forceinline__ u32x4 pack8bf(const f32x4 a, const f32x4 b) { u32x4 w; w.x = cvt_pk_bf16(a[0], a[1]); w.y = cvt_pk_bf16(a[2], a[3]); w.z = cvt_pk_bf16(b[0], b[1]); w.w = cvt_pk_bf16(b[2], b[3]); return w; }
__device__ __forceinline__ void unpack8bf(const u32x4 w, float (&o)[8]) { o[0] = bf_lo(w.x); o[1] = bf_hi(w.x); o[2] = bf_lo(w.y); o[3] = bf_hi(w.y); o[4] = bf_lo(w.z); o[5] = bf_hi(w.z); o[6] = bf_lo(w.w); o[7] = bf_hi(w.w); }

struct EpiInProj {
    static constexpr bool HAS_MID = false; int mid_t;
    bf16_t* qkv7; bf16_t* sg; bf16_t* ki; float* wi; float* kmean; const float* ropeA; const float* ropeI; const float* g_idx; const float* b_idx;
    __device__ __forceinline__ void mid(ACC_T, const pg8::Unit&, int, int, int, int) const {}
    __device__ __forceinline__ void operator()(CACC_T, const pg8::Unit& u, int wr, int wc, int fr_in, int fq_in) const {
        int fr = fr_in, fq = fq_in; asm volatile("" : "+v"(fr), "+v"(fq));
        const int pn = u.pn, row0 = u.pm * 256 + wr * 64 + fr;
        if (pn < 28) {
            const int tsr = pn >> 2, colt = (pn & 3) * 256;
            bf16_t* dst = qkv7 + (size_t)tsr * ((size_t)SEQ * BRW);
            const bool rope32 = (tsr == 0 || tsr == 1 || tsr == 4 || tsr == 5) && (wc == 0);
            const bool rope16 = (tsr == 3) && ((wc & 1) == 0);
            const bool km = (tsr == 5);
#pragma unroll
            for (int bj = 0; bj < 2; ++bj) {
                float ks[8];
#pragma unroll
                for (int i = 0; i < 8; ++i) ks[i] = 0.f;
#pragma unroll
                for (int ai = 0; ai < 2; ++ai)
#pragma unroll
                    for (int m = 0; m < 4; ++m) {
                        const int row = row0 + ai * 128 + m * 16;
                        f32x4 cs[4];
                        if (rope32) { const f32x4* tp = (const f32x4*)(ropeA + ((size_t)row * 16 + 8 * (fq & 1)) * 2);
#pragma unroll
                            for (int q = 0; q < 4; ++q) cs[q] = tp[q]; }
                        else if (rope16) { const f32x4* tp = (const f32x4*)(ropeI + (size_t)row * 16);
#pragma unroll
                            for (int q = 0; q < 4; ++q) cs[q] = tp[q]; }
                        float v[8];
#pragma unroll
                        for (int i = 0; i < 4; ++i) { v[i] = acc[ai][bj][m][0][i]; v[4 + i] = acc[ai][bj][m][1][i]; }
                        if (rope32) {
#pragma unroll
                            for (int i = 0; i < 8; ++i) { const float p = __shfl_xor(v[i], 32); const float c = cs[i >> 1][(i & 1) * 2], s = cs[i >> 1][(i & 1) * 2 + 1];
                                v[i] = v[i] * c + (fq < 2 ? -p : p) * s; }
                        } else if (rope16) {
#pragma unroll
                            for (int i = 0; i < 8; ++i) { const float p = __shfl_xor(v[i], 16); const float c = cs[i >> 1][(i & 1) * 2], s = cs[i >> 1][(i & 1) * 2 + 1];
                                const float r = v[i] * c + (fq == 0 ? -p : p) * s; v[i] = (fq < 2) ? r : v[i]; }
                        }
                        if (km) {
#pragma unroll
                            for (int i = 0; i < 8; ++i) ks[i] += v[i];
                        }
                        u32x4 w; w.x = cvt_pk_bf16(v[0], v[1]); w.y = cvt_pk_bf16(v[2], v[3]); w.z = cvt_pk_bf16(v[4], v[5]); w.w = cvt_pk_bf16(v[6], v[7]);
                        *(u32x4*)(dst + (size_t)row * BRW + colt + bj * 128 + wc * 32 + fq * 8) = w;
                        asm volatile("" ::: "memory");
                    }
                if (km) {
#pragma unroll
                    for (int i = 0; i < 8; ++i) { float s = ks[i]; s += __shfl_xor(s, 1); s += __shfl_xor(s, 2); s += __shfl_xor(s, 4); s += __shfl_xor(s, 8);
                        if (fr == 0) atomicAdd(kmean + (size_t)u.pm * BRW + colt + bj * 128 + wc * 32 + fq * 8 + i, s); }
                }
            }
        } else if (pn < 44) {
            const int colt = (pn - 28) * 256;
#pragma unroll
            for (int ai = 0; ai < 2; ++ai)
#pragma unroll
                for (int m = 0; m < 4; ++m) {
                    const int row = row0 + ai * 128 + m * 16;
#pragma unroll
                    for (int bj = 0; bj < 2; ++bj) {
                        float v[8];
#pragma unroll
                        for (int i = 0; i < 4; ++i) { v[i] = sigmoid_fast(acc[ai][bj][m][0][i]); v[4 + i] = sigmoid_fast(acc[ai][bj][m][1][i]); }
                        u32x4 w; w.x = cvt_pk_bf16(v[0], v[1]); w.y = cvt_pk_bf16(v[2], v[3]); w.z = cvt_pk_bf16(v[4], v[5]); w.w = cvt_pk_bf16(v[6], v[7]);
                        *(u32x4*)(sg + (size_t)row * 4096 + colt + bj * 128 + wc * 32 + fq * 8) = w;
                    }
                    asm volatile("" ::: "memory");
                }
        } else {
            if (wc == 0) {
#pragma unroll 1
                for (int am = 0; am < 8; ++am) {
                    const int ai = am >> 2, m = am & 3;
                    const int row = row0 + ai * 128 + m * 16;
                    float v[2][8]; float s = 0.f;
#pragma unroll
                    for (int bj = 0; bj < 2; ++bj)
#pragma unroll
                        for (int i = 0; i < 4; ++i) {
                            float x0, x1;
                            x0 = acc[0][bj][0][0][i]; x1 = acc[0][bj][0][1][i];
#pragma unroll
                            for (int q = 1; q < 8; ++q) { x0 = (am == q) ? acc[q >> 2][bj][q & 3][0][i] : x0; x1 = (am == q) ? acc[q >> 2][bj][q & 3][1][i] : x1; }
                            v[bj][i] = x0; v[bj][4 + i] = x1; s += x0 + x1; }
                    s += __shfl_xor(s, 16); s += __shfl_xor(s, 32);
                    const float mu = s * (1.f / 64.f); float q2 = 0.f;
#pragma unroll
                    for (int bj = 0; bj < 2; ++bj)
#pragma unroll
                        for (int i = 0; i < 8; ++i) { v[bj][i] -= mu; q2 += v[bj][i] * v[bj][i]; }
                    q2 += __shfl_xor(q2, 16); q2 += __shfl_xor(q2, 32);
                    const float rstd = rsqrtf(q2 * (1.f / 64.f) + EPS);
#pragma unroll
                    for (int bj = 0; bj < 2; ++bj)
#pragma unroll
                        for (int i = 0; i < 8; ++i) v[bj][i] = v[bj][i] * rstd * g_idx[bj * 32 + fq * 8 + i] + b_idx[bj * 32 + fq * 8 + i];
                    const float* tp = ropeI + (size_t)row * 16;
#pragma unroll
                    for (int i = 0; i < 8; ++i) { const float p = __shfl_xor(v[0][i], 16); const float c = tp[2 * i], sn = tp[2 * i + 1];
                        const float r = v[0][i] * c + (fq == 0 ? -p : p) * sn; v[0][i] = (fq < 2) ? r : v[0][i]; }
#pragma unroll
                    for (int bj = 0; bj < 2; ++bj) { u32x4 w; w.x = cvt_pk_bf16(v[bj][0], v[bj][1]); w.y = cvt_pk_bf16(v[bj][2], v[bj][3]); w.z = cvt_pk_bf16(v[bj][4], v[bj][5]); w.w = cvt_pk_bf16(v[bj][6], v[bj][7]);
                        *(u32x4*)(ki + (size_t)row * IDXD + bj * 32 + fq * 8) = w; }
                    asm volatile("" ::: "memory");
                }
            } else if (wc == 1) {
                if (fq < 2) {
#pragma unroll
                    for (int ai = 0; ai < 2; ++ai)
#pragma unroll
                        for (int m = 0; m < 4; ++m) { const int row = row0 + ai * 128 + m * 16;
                            *(f32x4*)(wi + (size_t)row * IDXH + fq * 8) = acc[ai][0][m][0] * IDX_W_SCALE; *(f32x4*)(wi + (size_t)row * IDXH + fq * 8 + 4) = acc[ai][0][m][1] * IDX_W_SCALE; }
                }
            }
        }
    }
};

struct EpiBf16Plain {
    static constexpr bool HAS_MID = false; int mid_t;
    bf16_t* O; int ldc;
    __device__ __forceinline__ void mid(ACC_T, const pg8::Unit&, int, int, int, int) const {}
    __device__ __forceinline__ void operator()(CACC_T, const pg8::Unit& u, int wr, int wc, int fr_in, int fq_in) const {
        int fr = fr_in, fq = fq_in; asm volatile("" : "+v"(fr), "+v"(fq));
        const int row0 = u.pm * 256 + wr * 64 + fr, col0 = u.pn * 256 + wc * 32 + fq * 8;
#pragma unroll
        for (int ai = 0; ai < 2; ++ai)
#pragma unroll
            for (int m = 0; m < 4; ++m)
#pragma unroll
                for (int bj = 0; bj < 2; ++bj)
                    *(u32x4*)(O + (size_t)(row0 + ai * 128 + m * 16) * ldc + col0 + bj * 128) = pack8bf(acc[ai][bj][m][0], acc[ai][bj][m][1]);
    }
};

struct EpiMerged {
    static constexpr bool HAS_MID = true; int mid_t;
    const bf16_t* sg; bf16_t* O;
    __device__ __forceinline__ void mid(ACC_T, const pg8::Unit& u, int wr, int wc, int fr_in, int fq_in) const {
        int fr = fr_in, fq = fq_in; asm volatile("" : "+v"(fr), "+v"(fq));
        const int row0 = u.pm * 256 + wr * 64 + fr, col0 = u.pn * 256 + wc * 32 + fq * 8;
#pragma unroll
        for (int ai = 0; ai < 2; ++ai)
#pragma unroll
            for (int mh = 0; mh < 2; ++mh) {
                u32x4 A[2][2], B[2][2];
#pragma unroll
                for (int m2 = 0; m2 < 2; ++m2)
#pragma unroll
                    for (int bj = 0; bj < 2; ++bj) { const bf16_t* gp = sg + (size_t)(row0 + ai * 128 + (2 * mh + m2) * 16) * 4096 + col0 + bj * 128; A[m2][bj] = *(const u32x4*)gp; B[m2][bj] = *(const u32x4*)(gp + 2048); }
#pragma unroll
                for (int m2 = 0; m2 < 2; ++m2)
#pragma unroll
                    for (int bj = 0; bj < 2; ++bj) { const int m = 2 * mh + m2; float a[8], b[8]; unpack8bf(A[m2][bj], a); unpack8bf(B[m2][bj], b);
#pragma unroll
                        for (int i = 0; i < 4; ++i) { acc[ai][bj][m][0][i] *= a[i] * __builtin_amdgcn_rcpf(b[i]); acc[ai][bj][m][1][i] *= a[4 + i] * __builtin_amdgcn_rcpf(b[4 + i]); }
                        asm volatile("" : "+v"(acc[ai][bj][m][0]), "+v"(acc[ai][bj][m][1]) :: "memory"); }
            }
    }
    __device__ __forceinline__ void operator()(CACC_T, const pg8::Unit& u, int wr, int wc, int fr_in, int fq_in) const {
        int fr = fr_in, fq = fq_in; asm volatile("" : "+v"(fr), "+v"(fq));
        const int row0 = u.pm * 256 + wr * 64 + fr, col0 = u.pn * 256 + wc * 32 + fq * 8;
#pragma unroll
        for (int ai = 0; ai < 2; ++ai) {
            u32x4 B[4][2];
#pragma unroll
            for (int m = 0; m < 4; ++m)
#pragma unroll
                for (int bj = 0; bj < 2; ++bj) B[m][bj] = *(const u32x4*)(sg + (size_t)(row0 + ai * 128 + m * 16) * 4096 + 2048 + col0 + bj * 128);
#pragma unroll
            for (int m = 0; m < 4; ++m)
#pragma unroll
                for (int bj = 0; bj < 2; ++bj) { const size_t ro = (size_t)(row0 + ai * 128 + m * 16);
                    float b[8]; unpack8bf(B[m][bj], b);
                    f32x4 v0 = acc[ai][bj][m][0], v1 = acc[ai][bj][m][1];
#pragma unroll
                    for (int i = 0; i < 4; ++i) { v0[i] *= b[i]; v1[i] *= b[4 + i]; }
                    *(u32x4*)(O + ro * DM + col0 + bj * 128) = pack8bf(v0, v1); }
            asm volatile("" ::: "memory");
        }
    }
};

struct EpiResF32 {
    static constexpr bool HAS_MID = false; int mid_t;
    const float* X; float* O;
    __device__ __forceinline__ void mid(ACC_T, const pg8::Unit&, int, int, int, int) const {}
    __device__ __forceinline__ void operator()(CACC_T, const pg8::Unit& u, int wr, int wc, int fr_in, int fq_in) const {
        int fr = fr_in, fq = fq_in; asm volatile("" : "+v"(fr), "+v"(fq));
        const int row0 = u.pm * 256 + wr * 64 + fr, col0 = u.pn * 256 + wc * 32 + fq * 8;
#pragma unroll
        for (int ai = 0; ai < 2; ++ai)
#pragma unroll
            for (int mh = 0; mh < 2; ++mh) {
                f32x4 x0[2][2], x1[2][2];
#pragma unroll
                for (int m2 = 0; m2 < 2; ++m2)
#pragma unroll
                    for (int bj = 0; bj < 2; ++bj) { const size_t o = (size_t)(row0 + ai * 128 + (2 * mh + m2) * 16) * DM + col0 + bj * 128; x0[m2][bj] = *(const f32x4*)(X + o); x1[m2][bj] = *(const f32x4*)(X + o + 4); }
#pragma unroll
                for (int m2 = 0; m2 < 2; ++m2)
#pragma unroll
                    for (int bj = 0; bj < 2; ++bj) { const int m = 2 * mh + m2; const size_t o = (size_t)(row0 + ai * 128 + m * 16) * DM + col0 + bj * 128;
                        *(f32x4*)(O + o) = x0[m2][bj] + acc[ai][bj][m][0]; *(f32x4*)(O + o + 4) = x1[m2][bj] + acc[ai][bj][m][1]; }
                asm volatile("" ::: "memory");
            }
    }
};

struct MoeOrder {
    static constexpr bool PARTIAL = true;
    int cnt_l, nb_l, rbx_l, pin_l, pex_l, total, NT, G, c; const int* list;
    __device__ void init(const int* cnt, const int* list_, int NT_, int G_, int c_) {
        const int lane = lane_id_v(), e = lane & 31; NT = NT_; G = G_; c = c_; list = list_;
        cnt_l = cnt[e]; if (cnt_l > SEQ) cnt_l = SEQ; if (cnt_l < 0) cnt_l = 0;
        nb_l = (cnt_l + 255) >> 8;
        int p = nb_l;
#pragma unroll
        for (int o = 1; o < 32; o <<= 1) { const int q = __shfl_up(p, o, 32); if (e >= o) p += q; }
        rbx_l = p - nb_l; pin_l = p * NT; pex_l = (p - nb_l) * NT;
        total = __builtin_amdgcn_readlane(pin_l, 31);
    }
    __device__ bool next(int i, pg8::Unit& u) const {
        const long L = (long)i * G + c; if (L >= total) return false;
        const unsigned long long mk = __ballot(pin_l > (int)L); const int e = __builtin_ctz((unsigned)mk);
        const int base = __builtin_amdgcn_readlane(pex_l, e), nb = __builtin_amdgcn_readlane(nb_l, e), cn = __builtin_amdgcn_readlane(cnt_l, e), rbx = __builtin_amdgcn_readlane(rbx_l, e);
        const int idx = (int)L - base; u.e = e; u.b = idx % nb; u.pn = idx / nb; u.pm = 0; u.rb = rbx + u.b; const int rem = cn - u.b * 256; u.rows = rem < 256 ? rem : 256; return true;
    }
    __device__ __forceinline__ size_t a_row0(const pg8::Unit& u) const { return (size_t)u.rb * 256; }
    __device__ __forceinline__ size_t b_row0(const pg8::Unit& u) const { return (size_t)u.e * ((size_t)NT * 256) + (size_t)u.pn * 256; }
    __device__ __forceinline__ int a_row(const pg8::Unit& u, int r) const { const int rr = r < u.rows ? r : 0; return list[u.e * SEQ + u.b * 256 + rr] >> 2; }
};

struct EpiGateUp {
    static constexpr bool HAS_MID = false; int mid_t;
    const int* list; const float* rstd; const float* bias; bf16_t* act;
    __device__ __forceinline__ void mid(ACC_T, const pg8::Unit&, int, int, int, int) const {}
    __device__ __forceinline__ void operator()(CACC_T, const pg8::Unit& u, int wr, int wc, int fr_in, int fq_in) const {
        int fr = fr_in, fq = fq_in; asm volatile("" : "+v"(fr), "+v"(fq));
        const int jj0 = u.pn * 128 + wc * 32 + fq * 8;
        const f32x4* bp = (const f32x4*)(bias + (size_t)u.e * (2 * DFF) + 2 * jj0);
        const f32x4 b0 = bp[0], b1 = bp[1], b2 = bp[2], b3 = bp[3];
        const float bg[8] = {b0[0], b0[2], b1[0], b1[2], b2[0], b2[2], b3[0], b3[2]}, bl[8] = {b0[1], b0[3], b1[1], b1[3], b2[1], b2[3], b3[1], b3[3]};
        float rsv[2][4];
#pragma unroll
        for (int ai = 0; ai < 2; ++ai)
#pragma unroll
            for (int m = 0; m < 4; ++m) { const int r = ai * 128 + wr * 64 + m * 16 + fr; rsv[ai][m] = rstd[u.e * SEQ + u.b * 256 + (r < u.rows ? r : 0)]; }
#pragma unroll
        for (int ai = 0; ai < 2; ++ai)
#pragma unroll
            for (int m = 0; m < 4; ++m) asm volatile("" :: "v"(rsv[ai][m]));
#pragma unroll
        for (int ai = 0; ai < 2; ++ai)
#pragma unroll
            for (int m = 0; m < 4; ++m) {
                const int r = ai * 128 + wr * 64 + m * 16 + fr;
                if (r < u.rows) {
                    const float rs = rsv[ai][m];
                    float o[8];
#pragma unroll
                    for (int i = 0; i < 8; ++i) { const float g0 = acc[ai][0][m][i >> 2][i & 3] * rs + bg[i], l0 = acc[ai][1][m][i >> 2][i & 3] * rs + bl[i];
                        const float g = fminf(g0, SWI_LIMIT), l = fminf(fmaxf(l0, -SWI_LIMIT), SWI_LIMIT);
                        o[i] = (l + 1.0f) * (g * sigmoid_fast(g * SWI_ALPHA)); }
                    u32x4 w; w.x = cvt_pk_bf16(o[0], o[1]); w.y = cvt_pk_bf16(o[2], o[3]); w.z = cvt_pk_bf16(o[4], o[5]); w.w = cvt_pk_bf16(o[6], o[7]);
                    *(u32x4*)(act + ((size_t)u.rb * 256 + r) * DFF + jj0) = w;
                }
                asm volatile("" ::: "memory");
            }
    }
};

struct EpiDown {
    static constexpr bool HAS_MID = false; int mid_t;
    const int* list; const float* gates; const float* bias; bf16_t* ys;
    __device__ __forceinline__ void mid(ACC_T, const pg8::Unit&, int, int, int, int) const {}
    __device__ __forceinline__ void operator()(CACC_T, const pg8::Unit& u, int wr, int wc, int fr_in, int fq_in) const {
        int fr = fr_in, fq = fq_in; asm volatile("" : "+v"(fr), "+v"(fq));
        const int col0 = u.pn * 256 + wc * 32 + fq * 8;
        f32x4 bv[2][2];
#pragma unroll
        for (int bj = 0; bj < 2; ++bj) { bv[bj][0] = *(const f32x4*)(bias + (size_t)u.e * DM + col0 + bj * 128); bv[bj][1] = *(const f32x4*)(bias + (size_t)u.e * DM + col0 + bj * 128 + 4); }
        asm volatile("" :: "v"(bv[0][0]), "v"(bv[0][1]), "v"(bv[1][0]), "v"(bv[1][1]));
        int slv[2][4]; float gv[2][4];
#pragma unroll
        for (int ai = 0; ai < 2; ++ai)
#pragma unroll
            for (int m = 0; m < 4; ++m) { const int r = ai * 128 + wr * 64 + m * 16 + fr, rr = u.e * SEQ + u.b * 256 + (r < u.rows ? r : 0); slv[ai][m] = list[rr]; gv[ai][m] = gates[rr]; }
#pragma unroll
        for (int ai = 0; ai < 2; ++ai)
#pragma unroll
            for (int m = 0; m < 4; ++m) asm volatile("" :: "v"(slv[ai][m]), "v"(gv[ai][m]));
#pragma unroll
        for (int ai = 0; ai < 2; ++ai)
#pragma unroll
            for (int m = 0; m < 4; ++m) {
                const int r = ai * 128 + wr * 64 + m * 16 + fr;
                if (r < u.rows) {
                    const int slot = slv[ai][m]; const float g = gv[ai][m];
#pragma unroll
                    for (int bj = 0; bj < 2; ++bj)
                        *(u32x4*)(ys + (size_t)slot * DM + col0 + bj * 128) = pack8bf((acc[ai][bj][m][0] + bv[bj][0]) * g, (acc[ai][bj][m][1] + bv[bj][1]) * g);
                }
            }
    }
};

struct EpiPleGate {
    static constexpr bool HAS_MID = false; int mid_t;
    const bf16_t* ple; bf16_t* T; float* tss;
    __device__ __forceinline__ void mid(ACC_T, const pg8::Unit&, int, int, int, int) const {}
    __device__ __forceinline__ void operator()(CACC_T, const pg8::Unit& u, int wr, int wc, int fr_in, int fq_in) const {
        int fr = fr_in, fq = fq_in; asm volatile("" : "+v"(fr), "+v"(fq));
        const int row0 = u.pm * 256 + wr * 64 + fr, col0 = u.pn * 256 + wc * 32 + fq * 8;
#pragma unroll
        for (int ai = 0; ai < 2; ++ai) {
            u32x4 P[4][2];
#pragma unroll
            for (int m = 0; m < 4; ++m)
#pragma unroll
                for (int bj = 0; bj < 2; ++bj) P[m][bj] = *(const u32x4*)(ple + (size_t)(row0 + ai * 128 + m * 16) * DM + col0 + bj * 128);
#pragma unroll
            for (int m = 0; m < 4; ++m) { const size_t ro = (size_t)(row0 + ai * 128 + m * 16); float ss = 0.f;
#pragma unroll
                for (int bj = 0; bj < 2; ++bj) { float pv[8]; unpack8bf(P[m][bj], pv);
                    f32x4 t0, t1;
#pragma unroll
                    for (int i = 0; i < 4; ++i) { t0[i] = sigmoidf_(acc[ai][bj][m][0][i]) * pv[i]; t1[i] = sigmoidf_(acc[ai][bj][m][1][i]) * pv[4 + i]; ss += t0[i] * t0[i] + t1[i] * t1[i]; }
                    *(u32x4*)(T + ro * DM + col0 + bj * 128) = pack8bf(t0, t1); }
                ss += __shfl_xor(ss, 16); ss += __shfl_xor(ss, 32);
                if (fq == 0) tss[ro * 32 + u.pn * 4 + wc] = ss; }
            asm volatile("" ::: "memory");
        }
    }
};
namespace att {
constexpr int D = 128, NW = 8, QBLK = 32, KVBLK = 64, QB = NW * QBLK;
constexpr int SHM_V = KVBLK * D * 2, SHM_K = KVBLK * D * 2;
constexpr int LDS_BYTES = 2 * SHM_V + 2 * SHM_K + NW * 64 * 4;
constexpr float SCALE = 0.08838834764831845f, THR = 8.f;
constexpr int QP = 1024, KP = 1024, OP = 2048;
#define KSWZ(row, colB) ((row) * 256 + ((colB) ^ (((row) & 7) << 4)))
#define SBAR() __builtin_amdgcn_sched_barrier(0)
__device__ __forceinline__ int v_st(int k, int c) { const int kk = (k & ~0xC) | ((k & 4) << 1) | ((k & 8) >> 1); return ((kk >> 3) * 4 + (c >> 5)) * 512 + ((kk & 7) * 32 + (c & 31)) * 2; }
__device__ __forceinline__ int v_rd_base(int lane) { return ((lane & 3) << 3) | (((lane >> 2) & 3) << 6) | (((lane >> 4) & 1) << 5) | (((lane >> 5) & 1) << 8); }
constexpr int v_rd_off(int d0, int ks, int half) { return d0 * 512 + ks * 4096 + half * 2048; }
__device__ __forceinline__ int crow(int r, int hi) { return (r & 3) + 8 * (r >> 2) + 4 * hi; }
__device__ __forceinline__ bf16x8 load8(const bf16_t* p) { return *reinterpret_cast<const bf16x8*>(p); }

__device__ __forceinline__ void mask_causal(f32x16& p0, f32x16& p1, int dq) {
    const float NEG = -__builtin_inff();
#pragma unroll
    for (int r = 0; r < 16; ++r) { const int c = (r & 3) + 8 * (r >> 2); if (dq - c < 0) p0[r] = NEG; if (dq - c - 32 < 0) p1[r] = NEG; }
}
__device__ __forceinline__ void mask_bits(f32x16& p0, f32x16& p1, unsigned lo, unsigned hi32, int hi) {
    const float NEG = -__builtin_inff(); lo >>= 4 * hi; hi32 >>= 4 * hi;
#pragma unroll
    for (int r = 0; r < 16; ++r) { const int c = (r & 3) + 8 * (r >> 2); if (!((lo >> c) & 1u)) p0[r] = NEG; if (!((hi32 >> c) & 1u)) p1[r] = NEG; }
}
__device__ __forceinline__ void mask_all(f32x16& p0, f32x16& p1, bool keep) {
    const float NEG = -__builtin_inff();
#pragma unroll
    for (int r = 0; r < 16; ++r) { p0[r] = keep ? p0[r] : NEG; p1[r] = keep ? p1[r] : NEG; }
}
__device__ __forceinline__ void partialSM(f32x16& p0, f32x16& p1, float& m_reg, float& mn, float& alpha) {
    float pmax = p0[0]; for (int r = 1; r < 16; ++r) pmax = fmaxf(pmax, p0[r]); for (int r = 0; r < 16; ++r) pmax = fmaxf(pmax, p1[r]);
    { auto rr = __builtin_amdgcn_permlane32_swap(__float_as_uint(pmax), __float_as_uint(pmax), false, false);
      pmax = fmaxf(__uint_as_float(rr[0]), __uint_as_float(rr[1])); }
    constexpr float C2 = 1.4426950408889634f * SCALE;
    if (__builtin_expect(__all((pmax - m_reg) * SCALE <= THR), 1)) { mn = m_reg; alpha = 1.f; }
    else { mn = fmaxf(m_reg, pmax); alpha = __builtin_amdgcn_exp2f((m_reg - mn) * C2); m_reg = mn; }
    const float mnL = -mn * C2;
    for (int r = 0; r < 16; ++r) p0[r] = fmaf(p0[r], C2, mnL); for (int r = 0; r < 16; ++r) p1[r] = fmaf(p1[r], C2, mnL);
    for (int r = 0; r < 16; ++r) p0[r] = __builtin_amdgcn_exp2f(p0[r]);
}
__device__ __forceinline__ void finishSM(f32x16& p0, f32x16& p1, float alpha, float& l_reg, bf16x8& pa0, bf16x8& pa1, bf16x8& pa2, bf16x8& pa3) {
    for (int r = 0; r < 16; ++r) p1[r] = __builtin_amdgcn_exp2f(p1[r]);
    float ps = 0; for (int r = 0; r < 16; ++r) ps += p0[r]; for (int r = 0; r < 16; ++r) ps += p1[r];
    { auto rr = __builtin_amdgcn_permlane32_swap(__float_as_uint(ps), __float_as_uint(ps), false, false);
      ps = __uint_as_float(rr[0]) + __uint_as_float(rr[1]); }
    l_reg = l_reg * alpha + ps;
#define PK4(P, B_, OUT) do { unsigned a0 = cvt_pk_bf16(P[B_+0], P[B_+1]), a1 = cvt_pk_bf16(P[B_+2], P[B_+3]);                          \
        unsigned b0 = cvt_pk_bf16(P[B_+4], P[B_+5]), b1 = cvt_pk_bf16(P[B_+6], P[B_+7]);                                             \
        auto r0 = __builtin_amdgcn_permlane32_swap(a0, b0, false, false); auto r1 = __builtin_amdgcn_permlane32_swap(a1, b1, false, false); \
        u32x4 w = {r0[0], r1[0], r0[1], r1[1]}; OUT = *reinterpret_cast<bf16x8*>(&w); } while (0)
    PK4(p0, 0, pa0); PK4(p0, 8, pa1); PK4(p1, 0, pa2); PK4(p1, 8, pa3);
#undef PK4
}
template <int KB>
__device__ __forceinline__ void qkt(f32x16& p0, f32x16& p1, const char* K_lds, int r32, int hi, const bf16x8* qr) {
    p0 = f32x16{}; p1 = f32x16{};
    const char* kb[4];
#pragma unroll
    for (int dd = 0; dd < 4; ++dd) kb[dd] = K_lds + KB * SHM_K + KSWZ(r32, (dd * 16 + hi * 8) * 2);
#pragma unroll
    for (int d0 = 0; d0 < 8; ++d0) { const char* a = kb[d0 & 3] + (d0 >> 2) * 128;
        bf16x8 b0 = *reinterpret_cast<const bf16x8*>(a);
        bf16x8 b1 = *reinterpret_cast<const bf16x8*>(a + 32 * 256);
        p0 = __builtin_amdgcn_mfma_f32_32x32x16_bf16(b0, qr[d0], p0, 0, 0, 0);
        p1 = __builtin_amdgcn_mfma_f32_32x32x16_bf16(b1, qr[d0], p1, 0, 0, 0); }
}
template <int VB>
__device__ __forceinline__ void pv_tile(f32x16* o, int vb0, bf16x8 pa0, bf16x8 pa1, bf16x8 pa2, bf16x8 pa3) {
#define TRRD(dst, off) asm volatile("ds_read_b64_tr_b16 %0, %1 offset:%2" : "=&v"(dst) : "v"(vb0), "i"(off) : "memory")
#define PV_D0(d0) do { s16x4 l0, l1, l2, l3, h0, h1, h2, h3; constexpr int b_ = VB * SHM_V + v_rd_off(d0, 0, 0); \
        TRRD(l0, b_); TRRD(h0, b_ + 2048); TRRD(l1, b_ + 4096); TRRD(h1, b_ + 6144); TRRD(l2, b_ + 8192); TRRD(h2, b_ + 10240); TRRD(l3, b_ + 12288); TRRD(h3, b_ + 14336); \
        asm volatile("s_waitcnt lgkmcnt(0)" ::: "memory"); SBAR();   \
        o[d0] = __builtin_amdgcn_mfma_f32_32x32x16_bf16(pa0, (bf16x8){l0[0], l0[1], l0[2], l0[3], h0[0], h0[1], h0[2], h0[3]}, o[d0], 0, 0, 0);   \
        o[d0] = __builtin_amdgcn_mfma_f32_32x32x16_bf16(pa1, (bf16x8){l1[0], l1[1], l1[2], l1[3], h1[0], h1[1], h1[2], h1[3]}, o[d0], 0, 0, 0);   \
        o[d0] = __builtin_amdgcn_mfma_f32_32x32x16_bf16(pa2, (bf16x8){l2[0], l2[1], l2[2], l2[3], h2[0], h2[1], h2[2], h2[3]}, o[d0], 0, 0, 0);   \
        o[d0] = __builtin_amdgcn_mfma_f32_32x32x16_bf16(pa3, (bf16x8){l3[0], l3[1], l3[2], l3[3], h3[0], h3[1], h3[2], h3[3]}, o[d0], 0, 0, 0); } while (0)
    PV_D0(0); PV_D0(1); PV_D0(2); PV_D0(3);
#undef PV_D0
#undef TRRD
}

struct BlockRef { const bf16_t* Q; const bf16_t* K; const bf16_t* V; bf16_t* O; int P0; int mode; const unsigned long long* bm; const unsigned* selw; };
struct Seam { bf16x8 qr[8]; bf16x8 st_v0, st_v1, st_k0, st_k1; };
#define ROWK(p, k0, rr) ((p) + (size_t)((k0) + (rr)) * KP + sc)
#define VMW() asm volatile("s_waitcnt vmcnt(0)" ::: "memory")
#define VMWN(n) asm volatile("s_waitcnt vmcnt(%0)" :: "i"(n) : "memory")
#define SLOAD_H(Kp, Vp, k0) do { S.st_v0 = load8(ROWK(Vp, k0, sr)); S.st_v1 = load8(ROWK(Vp, k0, 32 + sr));              \
                         S.st_k0 = load8(ROWK(Kp, k0, sr)); S.st_k1 = load8(ROWK(Kp, k0, 32 + sr)); } while (0)
#define SWRITE_HK(bf) do { *(bf16x8*)(K_lds + (bf) * SHM_K + kws) = S.st_k0; *(bf16x8*)(K_lds + (bf) * SHM_K + kws + 32 * 256) = S.st_k1; } while (0)
#define SWRITE_HV(bf) do { *(bf16x8*)(V_lds + (bf) * SHM_V + vst0) = S.st_v0; *(bf16x8*)(V_lds + (bf) * SHM_V + vst1) = S.st_v1; } while (0)
#define SWRITE_H(bf) do { SWRITE_HV(bf); SWRITE_HK(bf); } while (0)
__device__ __forceinline__ void attn_prime(const BlockRef& cur, char* lds, Seam& S, const int wid) {
    const int lane = lane_id_v(), tid = wid * 64 + lane, r32 = lane & 31, hi = lane >> 5;
    const int sr = tid >> 4, sc = (tid & 15) * 8, kws = KSWZ(sr, sc * 2); char* K_lds = lds + 2 * SHM_V;
    for (int d0 = 0; d0 < 8; ++d0) S.qr[d0] = load8(cur.Q + (size_t)(wid * QBLK + r32) * QP + d0 * 16 + hi * 8);
    SLOAD_H(cur.K, cur.V, 0); VMW(); SWRITE_HK(0);
    __syncthreads();
}
__device__ __forceinline__ void attn_block(const BlockRef& cur, const BlockRef& nxt, char* lds, Seam& S, const int wid) {
    const int lane = lane_id_v(), tid = wid * 64 + lane, r32 = lane & 31, hi = lane >> 5;
    const int NT = cur.P0 / KVBLK + 4;
    const int qlo = cur.P0 + wid * QBLK, qm = qlo + r32 - 4 * hi;
    char* V_lds = lds; char* K_lds = lds + 2 * SHM_V;
    float* ws = (float*)(lds + 2 * SHM_V + 2 * SHM_K) + wid * 64; float* li_l = ws, * al_l = ws + 32;
    float m_reg = -1e30f, l_reg = 0; f32x16 o[4] = {};
    const int sr = tid >> 4, sc = (tid & 15) * 8, vst0 = v_st(sr, sc), vst1 = v_st(32 + sr, sc), kws = KSWZ(sr, sc * 2);
    const int vb0 = (int)(uintptr_t)V_lds + v_rd_base(lane);
    const bf16_t* Kh = cur.K; const bf16_t* Vh = cur.V;
    const int mode = cur.mode, own = cur.P0 >> 8;
    unsigned mlo = 0u, mhi = 0u;
    if (mode == 1) mlo = cur.selw[(size_t)(wid * QBLK + r32) * NHEAD];
#define RESC(a) do { if (__any((a) < 1.f)) { if (hi == 0) al_l[r32] = (a); asm volatile("s_waitcnt lgkmcnt(0)" ::: "memory");              \
                     for (int d_ = 0; d_ < 4; ++d_) for (int r = 0; r < 16; ++r) o[d_][r] *= al_l[crow(r, hi)]; } } while (0)
#define KBASE(t) ((t) * KVBLK)
#define MLOAD(t) do { if (mode == 0) { unsigned r_ = (unsigned)r32; asm volatile("" : "+v"(r_));   \
        const u32x2 w_ = *(const u32x2*)(cur.bm + ((unsigned)(wid * QBLK) + r_) * (unsigned)(SEQ / 64) + (unsigned)(t)); mlo = w_.x; mhi = w_.y; } } while (0)
#define MASKT(P0_, P1_, t) do { const int kb_ = KBASE(t); \
        if (mode == 0) { mask_bits(P0_, P1_, mlo, mhi, hi); } \
        else { const int n_ = (t) >> 2; if (n_ == own) { if (kb_ + KVBLK - 1 > qlo) mask_causal(P0_, P1_, qm - kb_); } else mask_all(P0_, P1_, ((mlo >> n_) & 1u) != 0u); } } while (0)
    f32x16 pA0, pA1, pB0, pB1; float mnA, mnB, alA, alB; bf16x8 pa0, pa1, pa2, pa3;
    SWRITE_HV(0); SBAR();
    MLOAD(0);
    if (NT > 1) { SLOAD_H(Kh, Vh, KBASE(1)); }
    SBAR(); qkt<0>(pA0, pA1, K_lds, r32, hi, S.qr);
    MASKT(pA0, pA1, 0); partialSM(pA0, pA1, m_reg, mnA, alA);
    if (NT > 1) { VMW(); SWRITE_H(1); }
    __syncthreads();
#define HALF_STEP(PX0, PX1, mnX, alX, PY0, PY1, alY, t, KB, VB, SB) do {                                                      \
        SBAR(); MLOAD(t); qkt<KB>(PX0, PX1, K_lds, r32, hi, S.qr);                                             \
        finishSM(PY0, PY1, alY, l_reg, pa0, pa1, pa2, pa3); SBAR();                                                           \
        if ((t) + 1 < NT) { SLOAD_H(Kh, Vh, KBASE((t) + 1)); SBAR(); }                                               \
        pv_tile<VB>(o, vb0, pa0, pa1, pa2, pa3); MASKT(PX0, PX1, (t)); partialSM(PX0, PX1, m_reg, mnX, alX);                                        \
        __syncthreads();                                                                                                      \
        if ((t) + 1 < NT) { VMW(); SWRITE_H(SB); }                                                                          \
        RESC(alX); __syncthreads(); } while (0)
    for (int t = 1; t + 1 < NT; t += 2) {
        HALF_STEP(pB0, pB1, mnB, alB, pA0, pA1, alA, t, 1, 0, 0);
        HALF_STEP(pA0, pA1, mnA, alA, pB0, pB1, alB, t + 1, 0, 1, 1);
    }
    SBAR(); MLOAD(NT - 1); qkt<1>(pB0, pB1, K_lds, r32, hi, S.qr); SBAR();
    SLOAD_H(nxt.K, nxt.V, 0); SBAR();
#pragma unroll
    for (int d0 = 0; d0 < 8; ++d0) S.qr[d0] = load8(nxt.Q + (size_t)(wid * QBLK + r32) * QP + d0 * 16 + hi * 8);
    SBAR();
    finishSM(pA0, pA1, alA, l_reg, pa0, pa1, pa2, pa3); SBAR();
    pv_tile<0>(o, vb0, pa0, pa1, pa2, pa3);
    MASKT(pB0, pB1, NT - 1); partialSM(pB0, pB1, m_reg, mnB, alB); __syncthreads(); RESC(alB);
    finishSM(pB0, pB1, alB, l_reg, pa0, pa1, pa2, pa3); SBAR(); pv_tile<1>(o, vb0, pa0, pa1, pa2, pa3);
    SBAR(); VMWN(8); SWRITE_HK(0); SBAR();
    if (hi == 0) li_l[r32] = l_reg; asm volatile("s_waitcnt lgkmcnt(0)" ::: "memory");
    float rli[16];
#pragma unroll
    for (int r = 0; r < 16; ++r) rli[r] = __builtin_amdgcn_rcpf(li_l[crow(r, hi)]);
    bf16_t* Ow = cur.O + (size_t)(wid * QBLK) * OP;
    int r32e = r32, hie = hi; asm volatile("" : "+v"(r32e), "+v"(hie));
#pragma unroll
    for (int r = 0; r < 16; ++r) { const int orow = crow(r, hie);
#pragma unroll
        for (int d0 = 0; d0 < 4; ++d0) { const float v = o[d0][r] * rli[r];
            const float vn = __shfl_xor(v, 1);
            if ((r32e & 1) == 0) *(unsigned*)(Ow + (unsigned)(orow * OP + d0 * 32 + r32e)) = cvt_pk_bf16(v, vn); } }
    __syncthreads();
#undef RESC
#undef KBASE
#undef MLOAD
#undef MASKT
#undef HALF_STEP
}
#undef ROWK
#undef VMW
#undef VMWN
#undef SLOAD_H
#undef SWRITE_HK
#undef SWRITE_HV
#undef SWRITE_H
}
constexpr size_t MiB = 1u << 20;
constexpr size_t WS_CTL = 0, CTL_ZERO_BYTES = 1 * MiB;
constexpr int CW_TMO = 0, CW_BAR = 4096, CW_CNT = 16384;
constexpr size_t CTL_KMEAN = 512 * 1024;
constexpr size_t WS_ROPEA = 1 * MiB, WS_ROPEI = 2 * MiB;
constexpr size_t WS_WIN = 3 * MiB;
constexpr size_t WS_WBR = 48 * MiB, WS_WOUT = 56 * MiB, WS_WPG = 64 * MiB, WS_WPP = 72 * MiB;
constexpr size_t WS_WGU = 73 * MiB, WS_WD = 585 * MiB;
constexpr size_t WS_H1 = 841 * MiB, WS_PB = 873 * MiB;
constexpr size_t WS_QKV7 = 877 * MiB;
constexpr size_t WS_SG = 989 * MiB;
constexpr size_t WS_KI = 1053 * MiB, WS_WI = 1054 * MiB;
constexpr size_t WS_PLEB = 1055 * MiB;
constexpr size_t WS_SC = 1087 * MiB;
constexpr size_t WS_BM = 1343 * MiB, WS_SELB = 1351 * MiB;
constexpr size_t WS_OAB = 1352 * MiB, WS_MERGED = 1384 * MiB;
constexpr size_t WS_X1 = 1416 * MiB, WS_H2U = 1480 * MiB, WS_RSTD = 1512 * MiB;
constexpr size_t WS_LIST = 1513 * MiB, WS_GATES = 1514 * MiB;
constexpr size_t WS_ACT = 1515 * MiB;
constexpr size_t WS_YS = 1675 * MiB;
constexpr size_t WS_X2 = 1803 * MiB, WS_X2B = 1867 * MiB;
constexpr size_t WS_T = 1899 * MiB, WS_TSS = 1963 * MiB;
constexpr size_t WS_RSL = 1964 * MiB, WS_GTL = 1965 * MiB;
constexpr size_t WS_END = 1966 * MiB;

constexpr int NWAVES = 8;
constexpr int RING_BYTES = 131072, MISC_OFF = RING_BYTES, LDS_BYTES = RING_BYTES + 1024;
static_assert(att::LDS_BYTES <= RING_BYTES && pg8::STAGE_BYTES <= RING_BYTES, "LDS map");

typedef GAS unsigned gu32;
#define RLX_AGENT __ATOMIC_RELAXED, __HIP_MEMORY_SCOPE_AGENT
#define LDS_WAIT() asm volatile("s_waitcnt lgkmcnt(0)" ::: "memory")
#define VM_WAIT() asm volatile("s_waitcnt vmcnt(0)" ::: "memory")

#define XB_TMO      128
#define XB_XCNT(j)  (256  + 64 * (j))
#define XB_XSUB(j)  (1280 + 64 * (j))
#define XB_XGEN(j)  (2304 + 64 * (j))
#define XB_TOP      3328
#define XB_TOPGEN   3392
#define XCD_BAR_WORDS 3456
#define XB_SPIN_CAP (1u << 20)
__device__ __forceinline__ unsigned xb_ld(unsigned* p)              { return __hip_atomic_load(p, __ATOMIC_RELAXED, __HIP_MEMORY_SCOPE_AGENT); }
__device__ __forceinline__ unsigned xb_add(unsigned* p, unsigned v) { return __hip_atomic_fetch_add(p, v, __ATOMIC_RELAXED, __HIP_MEMORY_SCOPE_AGENT); }
__device__ __forceinline__ unsigned xb_xcc_id() { return (unsigned)__builtin_amdgcn_s_getreg((3 << 11) | 20) & 0xFu; }
#define XB_SPIN(cond, bar) do { unsigned _sp = 0; while (cond) { __builtin_amdgcn_s_sleep(1); \
    if ((++_sp & 255u) == 0u) { if (xb_ld(&(bar)[XB_TMO])) break; if (_sp > XB_SPIN_CAP) { atomicAdd(&(bar)[XB_TMO], 1u); break; } } } } while (0)
struct XcdBarrier { unsigned* bar; unsigned x; volatile LAS unsigned* st; int wave; };
__device__ __forceinline__ XcdBarrier xcd_barrier_post(unsigned* bar, volatile LAS unsigned* st, int wave) {
    XcdBarrier b; b.bar = bar; b.x = xb_xcc_id(); b.st = st; b.wave = wave;
    if (wave == 0 && lane_id_v() == 0) (void)xb_add(&bar[XB_XCNT(b.x)], 1u);
    return b;
}
__device__ __forceinline__ void xcd_barrier_complete(unsigned* bar, unsigned x, unsigned& nloc, unsigned& nx) {
    const unsigned G = gridDim.x * gridDim.y * gridDim.z;
    unsigned sum, cnt, mine, sp = 0u;
    for (;;) {
        sum = 0u; cnt = 0u; mine = 0u;
#pragma unroll
        for (unsigned j = 0; j < 16; ++j) { const unsigned c = xb_ld(&bar[XB_XCNT(j)]); sum += c; cnt += (c > 0u) ? 1u : 0u; mine = (j == x) ? c : mine; }
        if (sum == G) break;
        __builtin_amdgcn_s_sleep(1);
        if ((++sp & 255u) == 0u) { if (xb_ld(&bar[XB_TMO])) break; if (sp > XB_SPIN_CAP) { atomicAdd(&bar[XB_TMO], 1u); break; } }
    }
    nloc = mine > 0u ? mine : 1u; nx = cnt > 0u ? cnt : 1u;
}
__device__ __forceinline__ void xcd_barrier(const XcdBarrier& b) {
    asm volatile("s_waitcnt vmcnt(0)" ::: "memory");
    __syncthreads();
    if (b.wave == 0 && lane_id_v() == 0) {
        unsigned* bar = b.bar;
        __builtin_amdgcn_s_waitcnt(0);
        unsigned nloc = b.st[0], nx = b.st[1];
        if (nloc == 0u) { xcd_barrier_complete(bar, b.x, nloc, nx); b.st[0] = nloc; b.st[1] = nx; }
        const unsigned old = xb_add(&bar[XB_XSUB(b.x)], 1u);
        const unsigned gen = old / nloc;
        if (old + 1u == (gen + 1u) * nloc) {
            __builtin_amdgcn_fence(__ATOMIC_RELEASE, "agent");
            asm volatile("s_waitcnt vmcnt(0)" ::: "memory");
            const unsigned og = xb_add(&bar[XB_TOP], 1u);
            const unsigned tg = og / nx;
            if (og + 1u == (tg + 1u) * nx) xb_add(&bar[XB_TOPGEN], 1u);
            else XB_SPIN(xb_ld(&bar[XB_TOPGEN]) == tg, bar);
            __builtin_amdgcn_fence(__ATOMIC_ACQUIRE, "agent");
            xb_add(&bar[XB_XGEN(b.x)], 1u);
            asm volatile("s_waitcnt vmcnt(0)" ::: "memory");
        } else {
            XB_SPIN(xb_ld(&bar[XB_XGEN(b.x)]) == gen, bar);
            __builtin_amdgcn_fence(__ATOMIC_ACQUIRE, "agent");
            asm volatile("s_waitcnt vmcnt(0)" ::: "memory");
        }
    }
    __syncthreads();
}

__device__ __forceinline__ float wave_sum(float v) {
#pragma unroll
    for (int o = 1; o < 64; o <<= 1) v += __shfl_xor(v, o);
    return v;
}
__device__ __forceinline__ unsigned f2bf(float f) { unsigned u = __float_as_uint(f); return (u + 0x7fffu + ((u >> 16) & 1u)) >> 16; }
__device__ __forceinline__ unsigned pk2(float lo, float hi) { return f2bf(lo) | (f2bf(hi) << 16); }

struct MapId { __device__ __forceinline__ int operator()(int n) const { return n; } };
struct MapIn { __device__ __forceinline__ int operator()(int s) const {
    if (s < 4096) return s; if (s >= 4176) return s - 80;
    if (s < 4160) { const int j = s - 4096; return 11264 + (j < 32 ? j : 128 + (j - 32)); }
    return 11264 + 32 + (s - 4160); } };
struct MapGu { __device__ __forceinline__ int operator()(int s) const { return (s & ~255) + ((s & 1) << 7) + ((s & 255) >> 1); } };
constexpr int CV_PITCH = 128, CV_SCR = 12288;
struct P0Item { const float* W; int N; bf16_t* WT; int dpitch, koff, k0, n0, map; };
__device__ __forceinline__ void p0_item_load(const P0Item& it, int lane, f32x4 (&v)[16]) {
    int col = it.n0 + (lane & 15) * 4; if (col > it.N - 4) col = it.N - 4;
    const float* src = it.W + (size_t)(it.k0 + 2 * (lane >> 4)) * it.N + col;
#pragma unroll
    for (int i = 0; i < 8; ++i) { v[2 * i] = *(const f32x4*)(src + (size_t)(8 * i) * it.N); v[2 * i + 1] = *(const f32x4*)(src + (size_t)(8 * i + 1) * it.N); }
}
__device__ __forceinline__ void p0_item_finish(const P0Item& it, LAS unsigned char* scr, int lane, const f32x4 (&v)[16]) {
    const int nq = lane & 15, q = lane >> 4;
    LAS unsigned char* wb = scr + nq * 512 + 4 * q;
#pragma unroll
    for (int i = 0; i < 8; ++i) { LAS unsigned char* wp = wb + ((i ^ (nq & 7)) << 4);
#pragma unroll
        for (int e = 0; e < 4; ++e) *(LAS unsigned*)(wp + e * 128) = cvt_pk_bf16(v[2 * i][e], v[2 * i + 1][e]); }
    LDS_WAIT(); asm volatile("" ::: "memory");
    const int ar = lane >> 3, kc = lane & 7;
    bf16x8 pc[8];
#pragma unroll
    for (int s8 = 0; s8 < 8; ++s8) pc[s8] = *(const LAS bf16x8*)(scr + (8 * s8 + ar) * 128 + ((kc ^ ((2 * s8 + (ar >> 2)) & 7)) << 4));
    LDS_WAIT(); asm volatile("" ::: "memory");
#pragma unroll
    for (int s8 = 0; s8 < 8; ++s8) { const int sn = it.n0 + 8 * s8 + ar;
        const int dr = (it.map == 0 || it.map == 3) ? MapId()(sn) : (it.map == 1 ? MapIn()(sn) : MapGu()(sn));
        bf16_t* dst = (it.map >= 2) ? it.WT + ((size_t)(dr >> 6) * (it.dpitch >> 6) + (it.k0 >> 6)) * 4096 + (dr & 63) * 64
                                     : it.WT + (size_t)dr * it.dpitch + it.koff + it.k0;
        if (sn < it.N) *(bf16x8*)(dst + 8 * kc) = pc[s8]; }
}
struct Args { const float* in[20]; float* out; unsigned char* ws; int ph_lo, ph_hi; };
enum { IN_X = 0, IN_P, IN_GMIX, IN_WIN, IN_GIDX, IN_BIDX, IN_WBRA, IN_WBRB, IN_WOUT, IN_GFFN, IN_WROUTER, IN_BROUTER, IN_WGU, IN_BGU, IN_WDOWN, IN_BDOWN, IN_WPP, IN_WPG, IN_GPLE, IN_GFINAL };

constexpr int NB_IN = (INW + 63) / 64;
constexpr int CI_IN = 32 * NB_IN, CI_BR = 16 * 32, CI_SQ = 32 * 32, CI_PP = 4 * 32, CI_GU1 = 32 * 64, CI_D1 = 32 * 32;
constexpr int CD0 = CI_IN, CD1 = CD0 + CI_BR, CD2 = CD1 + CI_BR, CD3 = CD2 + CI_SQ, CD4 = CD3 + CI_SQ, CD5 = CD4 + CI_PP;
constexpr int CE_GU = NEXP * CI_GU1, CE_ALL = CE_GU + NEXP * CI_D1;
__device__ __forceinline__ P0Item p0_dense_item(const Args& a, int it) {
    unsigned char* ws = a.ws;
    if (it < CD0) return P0Item{a.in[IN_WIN], INW, (bf16_t*)(ws + WS_WIN), DM, 0, 64 * (it / NB_IN), 64 * (it % NB_IN), 1};
    if (it < CD1) { const int r = it - CD0; return P0Item{a.in[IN_WBRA], DM, (bf16_t*)(ws + WS_WBR), DM, 0, 64 * (r / 32), 64 * (r % 32), 0}; }
    if (it < CD2) { const int r = it - CD1; return P0Item{a.in[IN_WBRB], DM, (bf16_t*)(ws + WS_WBR), DM, BRW, 64 * (r / 32), 64 * (r % 32), 0}; }
    if (it < CD3) { const int r = it - CD2; return P0Item{a.in[IN_WOUT], DM, (bf16_t*)(ws + WS_WOUT), DM, 0, 64 * (r / 32), 64 * (r % 32), 0}; }
    if (it < CD4) { const int r = it - CD3; return P0Item{a.in[IN_WPG], DM, (bf16_t*)(ws + WS_WPG), DM, 0, 64 * (r / 32), 64 * (r % 32), 0}; }
    { const int r = it - CD4; return P0Item{a.in[IN_WPP], DM, (bf16_t*)(ws + WS_WPP), PLED, 0, 64 * (r / 32), 64 * (r % 32), 0}; }
}
__device__ __forceinline__ P0Item p0_expert_item(const Args& a, int it) {
    unsigned char* ws = a.ws;
    if (it < CE_GU) { const int e = it / CI_GU1, r = it % CI_GU1; return P0Item{a.in[IN_WGU] + (size_t)e * DM * (2 * DFF), 2 * DFF, (bf16_t*)(ws + WS_WGU) + (size_t)e * (2 * DFF) * DM, DM, 0, 64 * (r / 64), 64 * (r % 64), 2}; }
    { const int r2 = it - CE_GU, e = r2 / CI_D1, r = r2 % CI_D1; return P0Item{a.in[IN_WDOWN] + (size_t)e * DFF * DM, DM, (bf16_t*)(ws + WS_WD) + (size_t)e * DM * DFF, DFF, 0, 64 * (r / 32), 64 * (r % 32), 3}; }
}
template <int EXPERT>
__device__ __forceinline__ void p0_convert_strided(const Args& a, LAS unsigned char* scr, int lane, int first, int stride, int n_items) {
    if (first >= n_items) return;
    P0Item cur = EXPERT ? p0_expert_item(a, first) : p0_dense_item(a, first), nxt = cur; f32x4 va[16], vb[16];
    p0_item_load(cur, lane, va);
    for (int it = first; it < n_items; it += 2 * stride) {
        const bool h1 = it + stride < n_items;
        if (h1) { nxt = EXPERT ? p0_expert_item(a, it + stride) : p0_dense_item(a, it + stride); p0_item_load(nxt, lane, vb); }
        p0_item_finish(cur, scr, lane, va);
        if (!h1) break;
        const bool h2 = it + 2 * stride < n_items;
        if (h2) { cur = EXPERT ? p0_expert_item(a, it + 2 * stride) : p0_dense_item(a, it + 2 * stride); p0_item_load(cur, lane, va); }
        p0_item_finish(nxt, scr, lane, vb);
        if (!h2) break;
    }
}
__device__ __forceinline__ void p0_prologue(const Args& a, LAS unsigned char* lds, int c, int G, int wave, int lane) {
    unsigned char* ws = a.ws;
    LAS unsigned char* scr = lds + wave * CV_SCR;
    const int gw = c * NWAVES + wave, NGW = G * NWAVES;
    p0_convert_strided<0>(a, scr, lane, gw, NGW, CD5);
    { const float* X = a.in[IN_X]; const f32x4* g4 = (const f32x4*)a.in[IN_GMIX]; bf16_t* H1 = (bf16_t*)(ws + WS_H1);
      for (int m = gw; m < SEQ; m += NGW) { const f32x4* xr = (const f32x4*)(X + (size_t)m * DM) + lane; f32x4 v[8]; float s = 0.f;
#pragma unroll
          for (int j = 0; j < 8; ++j) { v[j] = xr[64 * j]; s += (v[j].x * v[j].x + v[j].y * v[j].y) + (v[j].z * v[j].z + v[j].w * v[j].w); }
          const float rstd = rsqrtf(wave_sum(s) * (1.f / DM) + EPS);
          unsigned long long* o8 = (unsigned long long*)(H1 + (size_t)m * DM) + lane;
#pragma unroll
          for (int j = 0; j < 8; ++j) { const f32x4 g = g4[lane + 64 * j];
              o8[64 * j] = (unsigned long long)pk2(v[j].x * rstd * g.x, v[j].y * rstd * g.y) | ((unsigned long long)pk2(v[j].z * rstd * g.z, v[j].w * rstd * g.w) << 32); } } }
    { const f32x4* P4 = (const f32x4*)a.in[IN_P]; unsigned long long* o8 = (unsigned long long*)(ws + WS_PB);
      for (int i = gw * 64 + lane; i < SEQ * PLED / 4; i += NGW * 64) { const f32x4 v = P4[i]; o8[i] = (unsigned long long)pk2(v.x, v.y) | ((unsigned long long)pk2(v.z, v.w) << 32); } }
    { float* RA = (float*)(ws + WS_ROPEA); float* RI = (float*)(ws + WS_ROPEI);
      for (int i = gw * 64 + lane; i < SEQ * 24; i += NGW * 64) { const int pos = i / 24, j = i % 24;
          const double ex = (j < 16) ? (double)j / 16.0 : (double)(j - 16) / 8.0;
          const float inv = (float)(1.0 / pow(500000.0, ex)); const float ang = (float)pos * inv;
          const float cv = (float)cos((double)ang), sv = (float)sin((double)ang);
          if (j < 16) { RA[((size_t)pos * 16 + j) * 2] = cv; RA[((size_t)pos * 16 + j) * 2 + 1] = sv; } else { RI[((size_t)pos * 8 + (j - 16)) * 2] = cv; RI[((size_t)pos * 8 + (j - 16)) * 2 + 1] = sv; } } }
}

__device__ __forceinline__ int cv_ticket(volatile LAS unsigned* ctr, int lane) {
    unsigned t = 0; if (lane == 0) t = __hip_atomic_fetch_add((LAS unsigned*)ctr, 1u, __ATOMIC_RELAXED, __HIP_MEMORY_SCOPE_WORKGROUP);
    return (int)__builtin_amdgcn_readfirstlane(t);
}
__device__ __forceinline__ void p2_convert_experts(const Args& a, LAS unsigned char* scr, volatile LAS unsigned* ctr, int c, int G, int lane, volatile LAS unsigned* flag, unsigned stop_at) {
    const int n_cu = (CE_ALL - c + G - 1) / G;
    for (;;) {
        if (stop_at != 0xffffffffu && (unsigned)__builtin_amdgcn_readfirstlane((int)*flag) >= stop_at) return;
        unsigned t0 = 0; if (lane == 0) t0 = __hip_atomic_fetch_add((LAS unsigned*)ctr, 6u, __ATOMIC_RELAXED, __HIP_MEMORY_SCOPE_WORKGROUP);
        const int tk = (int)__builtin_amdgcn_readfirstlane(t0);
        if (tk >= n_cu) return;
        if (tk + 6 <= n_cu) {
            f32x4 va[16], vb[16], vc[16];
            const P0Item i0 = p0_expert_item(a, (tk + 0) * G + c), i1 = p0_expert_item(a, (tk + 1) * G + c), i2 = p0_expert_item(a, (tk + 2) * G + c);
            p0_item_load(i0, lane, va); p0_item_load(i1, lane, vb); p0_item_load(i2, lane, vc);
            p0_item_finish(i0, scr, lane, va);
            const P0Item i3 = p0_expert_item(a, (tk + 3) * G + c); p0_item_load(i3, lane, va);
            p0_item_finish(i1, scr, lane, vb);
            const P0Item i4 = p0_expert_item(a, (tk + 4) * G + c); p0_item_load(i4, lane, vb);
            p0_item_finish(i2, scr, lane, vc);
            const P0Item i5 = p0_expert_item(a, (tk + 5) * G + c); p0_item_load(i5, lane, vc);
            p0_item_finish(i3, scr, lane, va); p0_item_finish(i4, scr, lane, vb); p0_item_finish(i5, scr, lane, vc);
        } else {
            for (int k = tk; k < n_cu; ++k) { f32x4 v[16]; const P0Item it = p0_expert_item(a, k * G + c); p0_item_load(it, lane, v); p0_item_finish(it, scr, lane, v); }
        }
    }
}
#ifndef REPEAT_MASK
#define REPEAT_MASK 0
#endif
#define P2_NREP(k) ((((REPEAT_MASK) >> (k)) & 1) ? 2 : 1)
#ifndef P2_NIDX
#define P2_NIDX 4
#endif
__device__ __forceinline__ unsigned f2ord(float f) { unsigned b = __float_as_uint(f); if ((b << 1) == 0u) b = 0u; return b ^ ((b >> 31) ? 0xffffffffu : 0x80000000u); }
__device__ __forceinline__ void idx_scores(const Args& a, int q0, int lane_in) {
    unsigned char* ws = a.ws;
    const bf16_t* QI = (const bf16_t*)(ws + WS_QKV7) + (size_t)3 * SEQ * BRW; const bf16_t* KI = (const bf16_t*)(ws + WS_KI); const float* WI = (const float*)(ws + WS_WI);
    float* SC = (float*)(ws + WS_SC);
    int lane = lane_in; asm volatile("" : "+v"(lane));
    const int r = lane & 31, hh = lane >> 5;
    {
        bf16x8 af[2][4]; float wreg[2][16];
#pragma unroll
        for (int t2 = 0; t2 < 2; ++t2) { const int qa = q0 + 2 * t2 + (r >> 4);
#pragma unroll
            for (int s = 0; s < 4; ++s) af[t2][s] = *(const bf16x8*)(QI + (size_t)qa * BRW + (r & 15) * IDXD + 16 * s + 8 * hh);
#pragma unroll
            for (int i = 0; i < 16; ++i) { const int row = (i & 3) + 8 * (i >> 2) + 4 * hh; wreg[t2][i] = WI[(size_t)(q0 + 2 * t2 + (row >> 4)) * IDXH + (row & 15)]; } }
        const int ntile = ((q0 + 3) >> 5) + 1;
#define IDX_LOADB(dst, tile) do { const int tl_ = (tile) < 256 ? (tile) : 255; _Pragma("unroll") for (int s = 0; s < 4; ++s) dst[s] = *(const bf16x8*)(KI + (size_t)(32 * tl_ + r) * IDXD + 16 * s + 8 * hh); } while (0)
#define IDX_TILE(bc, jt_) do { _Pragma("unroll") for (int t2 = 0; t2 < 2; ++t2) { \
            f32x16 ac = {}; \
            _Pragma("unroll") for (int s = 0; s < 4; ++s) ac = __builtin_amdgcn_mfma_f32_32x32x16_bf16(af[t2][s], bc[s], ac, 0, 0, 0); \
            float s0 = 0.f, s1 = 0.f; \
            _Pragma("unroll") for (int i = 0; i < 8; ++i) { s0 += wreg[t2][i] * __builtin_amdgcn_fmed3f(ac[i], 0.f, 3.0e38f); s1 += wreg[t2][8 + i] * __builtin_amdgcn_fmed3f(ac[8 + i], 0.f, 3.0e38f); }     \
            const float send = hh ? s0 : s1, keep = hh ? s1 : s0; \
            const float tot = keep + __shfl_xor(send, 32); \
            SC[(size_t)(q0 + 2 * t2 + hh) * SEQ + 32 * (jt_) + r] = tot; } } while (0)
        bf16x8 b0[4], b1[4], b2[4], b3[4];
        IDX_LOADB(b0, 0); IDX_LOADB(b1, 1); IDX_LOADB(b2, 2); IDX_LOADB(b3, 3);
        for (int jt = 0; jt < ntile; jt += 4) {
            { bf16x8 bc[4]; _Pragma("unroll") for (int s = 0; s < 4; ++s) bc[s] = b0[s]; IDX_LOADB(b0, jt + 4); IDX_TILE(bc, jt); }
            if (jt + 1 < ntile) { bf16x8 bc[4]; _Pragma("unroll") for (int s = 0; s < 4; ++s) bc[s] = b1[s]; IDX_LOADB(b1, jt + 5); IDX_TILE(bc, jt + 1); }
            if (jt + 2 < ntile) { bf16x8 bc[4]; _Pragma("unroll") for (int s = 0; s < 4; ++s) bc[s] = b2[s]; IDX_LOADB(b2, jt + 6); IDX_TILE(bc, jt + 2); }
            if (jt + 3 < ntile) { bf16x8 bc[4]; _Pragma("unroll") for (int s = 0; s < 4; ++s) bc[s] = b3[s]; IDX_LOADB(b3, jt + 7); IDX_TILE(bc, jt + 3); }
        }
#undef IDX_LOADB
#undef IDX_TILE
    }
}
__device__ __forceinline__ void idx_select_rows(const Args& a, int q0, int nrows, int lane_in) {
    unsigned char* ws = a.ws;
    float* SC = (float*)(ws + WS_SC); unsigned long long* BM = (unsigned long long*)(ws + WS_BM);
    int lane = lane_in;
    {
        for (int qq = 0; qq < nrows; ++qq) {
            asm volatile("" : "+v"(lane));
            const int t = q0 + qq;
            unsigned long long* brow = BM + (size_t)t * (SEQ / 64);
            if (t < DSA_TOPK) {
#pragma unroll
                for (int w2 = 0; w2 < 2; ++w2) { const int j = lane + 64 * w2, lo = 64 * j;
                    brow[j] = (t >= lo + 63) ? ~0ull : (t < lo ? 0ull : ((2ull << (t - lo)) - 1ull)); }
                continue;
            }
            const int nj = (t >> 6) + 1;
            unsigned u[128];
            const float* srow = SC + (size_t)t * SEQ;
#pragma unroll
            for (int ch = 0; ch < 8; ++ch) {
                const float* cb = (ch * 16 < nj) ? srow : srow - 1024 * ch;
#pragma unroll
                for (int jj = 0; jj < 16; ++jj) { const int j = ch * 16 + jj;
                    u[j] = __float_as_uint(__builtin_nontemporal_load(cb + lane + 64 * j)); }
            }
#pragma unroll
            for (int ch = 0; ch < 8; ++ch) {
                if (ch * 16 < nj) {
#pragma unroll
                    for (int jj = 0; jj < 16; ++jj) { const int j = ch * 16 + jj, key = 64 * j + lane; const int neg = (t - key) >> 31;
                        u[j] = f2ord(__uint_as_float(u[j])) & ~(unsigned)neg; }
                } else {
#pragma unroll
                    for (int jj = 0; jj < 16; ++jj) u[ch * 16 + jj] = 0u;
                }
            }
            unsigned T = 0u; int Ti = 0; bool exact = false;
            for (int b = 31; b >= 0; --b) {
                const unsigned Tc = T | (1u << b); int cnt = 0;
#pragma unroll
                for (int ch = 0; ch < 8; ++ch) {
                    if (ch * 16 < nj) {
#pragma unroll
                        for (int jj = 0; jj < 16; ++jj) { cnt += __popcll(__ballot(u[ch * 16 + jj] >= Tc)); if ((jj & 3) == 3) __builtin_amdgcn_sched_barrier(0); }
                    }
                }
                if (cnt >= DSA_TOPK) T = Tc;
                if (cnt == DSA_TOPK) { exact = true; break; }
            }
            if (!exact) {
                for (int b = 12; b >= 0; --b) {
                    const int Tic = Ti | (1 << b); int cnt = 0; unsigned Tl = T; asm volatile("" : "+s"(Tl));
#pragma unroll
                    for (int ch = 0; ch < 8; ++ch) {
                        if (ch * 16 < nj) {
#pragma unroll
                            for (int jj = 0; jj < 16; ++jj) { const int j = ch * 16 + jj;
                                cnt += __popcll(__ballot((u[j] > Tl) || (u[j] == Tl && lane <= (SEQ - 1 - 64 * j) - Tic))); if ((jj & 3) == 3) __builtin_amdgcn_sched_barrier(0); }
                        }
                    }
                    if (cnt >= DSA_TOPK) Ti = Tic;
                    if (cnt == DSA_TOPK) break;
                }
            }
            int w0l = 0, w0h = 0, w1l = 0, w1h = 0; asm volatile("" : "+s"(T), "+s"(Ti));
#pragma unroll
            for (int ch = 0; ch < 8; ++ch) {
                if (ch * 16 < nj) {
#pragma unroll
                    for (int jj = 0; jj < 16; ++jj) { const int j = ch * 16 + jj;
                        const unsigned long long word = __ballot((u[j] > T) || (u[j] == T && lane <= (SEQ - 1 - 64 * j) - Ti));
                        const int lo = (int)(unsigned)word, hi = (int)(unsigned)(word >> 32);
                        if (j < 64) { w0l = (lane == (j & 63)) ? lo : w0l; w0h = (lane == (j & 63)) ? hi : w0h; }
                        else { w1l = (lane == (j & 63)) ? lo : w1l; w1h = (lane == (j & 63)) ? hi : w1h; }
                        if ((jj & 3) == 3) __builtin_amdgcn_sched_barrier(0); }
                }
            }
            brow[lane] = ((unsigned long long)(unsigned)w0h << 32) | (unsigned)w0l;
            brow[64 + lane] = ((unsigned long long)(unsigned)w1h << 32) | (unsigned)w1l;
        }
    }
}
__device__ __forceinline__ void p2_indexer_and_convert(const Args& a, LAS unsigned char* lds, volatile LAS unsigned* MISC, int c, int G, int wave, int lane) {
    const int w = wave & 3; volatile LAS unsigned* flag = MISC + 24 + w; volatile LAS unsigned* ctr = MISC + 16;
    LAS unsigned char* scr = lds + wave * CV_SCR;
    if (wave < 4) {
        for (int p = c; p < 256; p += G) {
            const int qh = (511 - p) * 16 + w * 4, ql = p * 16 + w * 4;
            for (int rep_s = 0; rep_s < P2_NREP(12); ++rep_s) { idx_scores(a, qh, lane); idx_scores(a, ql, lane); }
        }
        VM_WAIT();
    }
    p2_convert_experts(a, scr, ctr, c, G, lane, flag, 0xffffffffu);
    __syncthreads();
    for (int p = c; p < 256; p += G) {
        for (int rep_q = 0; rep_q < P2_NREP(13); ++rep_q) { idx_select_rows(a, p * 16 + 2 * wave, 2, lane); idx_select_rows(a, (511 - p) * 16 + 2 * wave, 2, lane); }
    }
}
__device__ __forceinline__ void p2_moba_gate(const Args& a, LAS unsigned char* lds, int c, int G, int wave, int lane) {
    unsigned char* ws = a.ws;
    const bf16_t* QBp = (const bf16_t*)(ws + WS_QKV7) + (size_t)4 * SEQ * BRW; const float* KM = (const float*)(ws + WS_CTL + CTL_KMEAN); unsigned* SELB = (unsigned*)(ws + WS_SELB);
    const int r = lane & 31, hh = lane >> 5;
    LAS float* scr = (LAS float*)(lds + wave * 4352);
    for (int base = c * 256; base < SEQ * NHEAD; base += G * 256) {
        const int h = base >> 13, t0 = (base & (SEQ - 1)) + 32 * wave, own = t0 >> 8;
        if (own > 0) {
            f32x16 acc = {};
#pragma unroll
            for (int s8 = 0; s8 < 8; ++s8) {
                const bf16x8 af = *(const bf16x8*)(QBp + (size_t)(t0 + r) * BRW + h * HD + 16 * s8 + 8 * hh);
                const f32x4 k0 = *(const f32x4*)(KM + (size_t)r * BRW + h * HD + 16 * s8 + 8 * hh), k1 = *(const f32x4*)(KM + (size_t)r * BRW + h * HD + 16 * s8 + 8 * hh + 4);
                float kv[8];
#pragma unroll
                for (int i = 0; i < 4; ++i) { kv[i] = k0[i] * (1.f / MOBA_BLK); kv[4 + i] = k1[i] * (1.f / MOBA_BLK); }
                unsigned bh[4], bl[4];
#pragma unroll
                for (int i = 0; i < 4; ++i) { bh[i] = cvt_pk_bf16(kv[2 * i], kv[2 * i + 1]); bl[i] = cvt_pk_bf16(kv[2 * i] - bf_lo(bh[i]), kv[2 * i + 1] - bf_hi(bh[i])); }
                u32x4 BH = {bh[0], bh[1], bh[2], bh[3]}, BL = {bl[0], bl[1], bl[2], bl[3]};
                acc = __builtin_amdgcn_mfma_f32_32x32x16_bf16(af, *(bf16x8*)&BH, acc, 0, 0, 0);
                acc = __builtin_amdgcn_mfma_f32_32x32x16_bf16(af, *(bf16x8*)&BL, acc, 0, 0, 0);
            }
#pragma unroll
            for (int i = 0; i < 16; ++i) scr[((i & 3) + 8 * (i >> 2) + 4 * hh) * 33 + r] = acc[i];
            LDS_WAIT(); asm volatile("" ::: "memory");
            float v[32];
#pragma unroll
            for (int m = 0; m < 32; ++m) v[m] = scr[r * 33 + m];
            unsigned selw = 0u;
#pragma unroll
            for (int rd = 0; rd < 3; ++rd) { float best = -__builtin_inff(); int bi = -1;
#pragma unroll
                for (int m = 0; m < 32; ++m) { if (m < own && v[m] > best) { best = v[m]; bi = m; } }
                if (bi >= 0) selw |= 1u << bi;
#pragma unroll
                for (int m = 0; m < 32; ++m) v[m] = (m == bi) ? -__builtin_inff() : v[m]; }
            if (lane < 32) SELB[(size_t)(t0 + r) * NHEAD + h] = selw;
            LDS_WAIT(); asm volatile("" ::: "memory");
        } else { if (lane < 32) SELB[(size_t)(t0 + r) * NHEAD + h] = 0u; }
    }
}

__device__ __forceinline__ void p6_route(const Args& a, LAS unsigned char* lds, int c, int G, int wave, int lane) {
    unsigned char* ws = a.ws;
    const float* X1 = (const float*)(ws + WS_X1); const float* gf = a.in[IN_GFFN]; const float* WR = a.in[IN_WROUTER]; const float* BR = a.in[IN_BROUTER];
    bf16_t* H2U = (bf16_t*)(ws + WS_H2U); float* RSTD = (float*)(ws + WS_RSTD); int* LIST = (int*)(ws + WS_LIST); float* GATES = (float*)(ws + WS_GATES);
    float* RSL = (float*)(ws + WS_RSL); float* GTL = (float*)(ws + WS_GTL);
    unsigned* CNT = (unsigned*)(ws + WS_CTL) + CW_CNT;
    LAS float* part = (LAS float*)lds;
    LAS float* ssp = (LAS float*)(lds + 32768);
    LAS int* hist = (LAS int*)(lds + 32768 + 2048);
    LAS int* hbase = hist + 32;
    const int r = lane & 31, hh = lane >> 5;
    for (int un = c; un < SEQ / 32; un += G) {
        const int t0 = un * 32;
        f32x16 acc = {}; float ss = 0.f;
        const int kbase = wave * 256;
        for (int ks = 0; ks < 16; ++ks) {
            const int k0 = kbase + ks * 16 + 8 * hh;
            const f32x4 xa = *(const f32x4*)(X1 + (size_t)(t0 + r) * DM + k0), xb = *(const f32x4*)(X1 + (size_t)(t0 + r) * DM + k0 + 4);
            const f32x4 ga = *(const f32x4*)(gf + k0), gb = *(const f32x4*)(gf + k0 + 4);
            float av[8], bv[8];
#pragma unroll
            for (int i = 0; i < 4; ++i) { ss += xa[i] * xa[i] + xb[i] * xb[i]; av[i] = xa[i] * ga[i]; av[4 + i] = xb[i] * gb[i]; }
#pragma unroll
            for (int i = 0; i < 8; ++i) bv[i] = WR[(size_t)(k0 + i) * NEXP + r];
            unsigned ahi[4], alo[4], bhi[4], blo[4];
#pragma unroll
            for (int i = 0; i < 4; ++i) { ahi[i] = cvt_pk_bf16(av[2 * i], av[2 * i + 1]); alo[i] = cvt_pk_bf16(av[2 * i] - bf_lo(ahi[i]), av[2 * i + 1] - bf_hi(ahi[i]));
                                          bhi[i] = cvt_pk_bf16(bv[2 * i], bv[2 * i + 1]); blo[i] = cvt_pk_bf16(bv[2 * i] - bf_lo(bhi[i]), bv[2 * i + 1] - bf_hi(bhi[i])); }
            u32x4 AH = {ahi[0], ahi[1], ahi[2], ahi[3]}, AL = {alo[0], alo[1], alo[2], alo[3]}, BH = {bhi[0], bhi[1], bhi[2], bhi[3]}, BL = {blo[0], blo[1], blo[2], blo[3]};
            *(u32x4*)(H2U + (size_t)(t0 + r) * DM + k0) = AH;
            acc = __builtin_amdgcn_mfma_f32_32x32x16_bf16(*(bf16x8*)&AH, *(bf16x8*)&BH, acc, 0, 0, 0);
            acc = __builtin_amdgcn_mfma_f32_32x32x16_bf16(*(bf16x8*)&AH, *(bf16x8*)&BL, acc, 0, 0, 0);
            acc = __builtin_amdgcn_mfma_f32_32x32x16_bf16(*(bf16x8*)&AL, *(bf16x8*)&BH, acc, 0, 0, 0);
        }
#pragma unroll
        for (int i = 0; i < 16; ++i) part[(wave * 32 + (i & 3) + 8 * (i >> 2) + 4 * hh) * 32 + r] = acc[i];
        ssp[(wave * 32 + r) * 2 + hh] = ss;
        const bool w0 = (wave == 0) && (lane < 32);
        if (w0) hist[lane] = 0;
        __syncthreads();
        int ek[4]; int pl[4]; float gk[4]; float rstd = 0.f;
        if (w0) {
            const int tk = lane; float lg[32]; float s2 = 0.f;
#pragma unroll
            for (int w = 0; w < 8; ++w) s2 += ssp[(w * 32 + tk) * 2] + ssp[(w * 32 + tk) * 2 + 1];
            rstd = rsqrtf(s2 * (1.f / DM) + EPS);
#pragma unroll
            for (int e = 0; e < 32; ++e) { float s = 0.f;
#pragma unroll
                for (int w = 0; w < 8; ++w) s += part[(w * 32 + tk) * 32 + e];
                lg[e] = s * rstd + BR[e]; }
            float tv[4];
#pragma unroll
            for (int k = 0; k < 4; ++k) { float best = -__builtin_inff(); int bi = 0;
#pragma unroll
                for (int e = 0; e < 32; ++e) { if (lg[e] > best) { best = lg[e]; bi = e; } }
                tv[k] = best; ek[k] = bi;
#pragma unroll
                for (int e = 0; e < 32; ++e) lg[e] = (e == bi) ? -__builtin_inff() : lg[e]; }
            float den = 0.f;
#pragma unroll
            for (int k = 0; k < 4; ++k) { gk[k] = __expf(tv[k] - tv[0]); den += gk[k]; }
            const float rden = 1.f / den;
#pragma unroll
            for (int k = 0; k < 4; ++k) { gk[k] *= rden; pl[k] = __hip_atomic_fetch_add(&hist[ek[k]], 1, __ATOMIC_RELAXED, __HIP_MEMORY_SCOPE_WORKGROUP); }
        }
        __syncthreads();
        if (w0) { const int hc = hist[lane]; hbase[lane] = hc > 0 ? (int)atomicAdd(&CNT[lane], (unsigned)hc) : 0; }
        __syncthreads();
        if (w0) { const int tok = t0 + lane; RSTD[tok] = rstd;
#pragma unroll
            for (int k = 0; k < 4; ++k) { const int pos = hbase[ek[k]] + pl[k]; if (pos < SEQ) { LIST[(size_t)ek[k] * SEQ + pos] = tok * 4 + k; RSL[(size_t)ek[k] * SEQ + pos] = rstd; GTL[(size_t)ek[k] * SEQ + pos] = gk[k]; } GATES[tok * 4 + k] = gk[k]; } }
        __syncthreads();
    }
}

__device__ __forceinline__ void p9_x2(const Args& a, int c, int G, int wave, int lane) {
    unsigned char* ws = a.ws; const float* X1 = (const float*)(ws + WS_X1); const bf16_t* YS = (const bf16_t*)(ws + WS_YS); bf16_t* X2B = (bf16_t*)(ws + WS_X2B);
    const int gw = c * NWAVES + wave, NGW = G * NWAVES;
    for (int m = gw; m < SEQ; m += NGW) {
#pragma unroll
        for (int j = 0; j < 4; ++j) { const int col = (j * 64 + lane) * 8; const size_t o = (size_t)m * DM + col;
            f32x4 v0 = *(const f32x4*)(X1 + o), v1 = *(const f32x4*)(X1 + o + 4);
#pragma unroll
            for (int k = 0; k < 4; ++k) { float y[8]; unpack8bf(*(const u32x4*)(YS + ((size_t)m * 4 + k) * DM + col), y);
#pragma unroll
                for (int i = 0; i < 4; ++i) { v0[i] += y[i]; v1[i] += y[4 + i]; } }
            *(u32x4*)(X2B + o) = pack8bf(v0, v1); }
    }
}
__device__ __forceinline__ void p11_final(const Args& a, int c, int G, int wave, int lane) {
    unsigned char* ws = a.ws; const bf16_t* X2B = (const bf16_t*)(ws + WS_X2B); const bf16_t* T = (const bf16_t*)(ws + WS_T); const float* TSS = (const float*)(ws + WS_TSS);
    const float* gp = a.in[IN_GPLE]; const float* gfin = a.in[IN_GFINAL]; float* out = a.out;
    const int gw = c * NWAVES + wave, NGW = G * NWAVES;
    for (int m = gw; m < SEQ; m += NGW) {
        float ts = (lane < 32) ? TSS[(size_t)m * 32 + lane] : 0.f; ts = wave_sum(ts);
        const float rt = rsqrtf(ts * (1.f / DM) + EPS);
        f32x4 v[8]; float s = 0.f;
#pragma unroll
        for (int j = 0; j < 8; ++j) { const size_t o = (size_t)m * DM + (j * 64 + lane) * 4; const u32x2 xw = *(const u32x2*)(X2B + o), tw = *(const u32x2*)(T + o); const f32x4 g = *(const f32x4*)(gp + (j * 64 + lane) * 4);
            const f32x4 x = {bf_lo(xw.x), bf_hi(xw.x), bf_lo(xw.y), bf_hi(xw.y)}, t = {bf_lo(tw.x), bf_hi(tw.x), bf_lo(tw.y), bf_hi(tw.y)};
            v[j] = x + t * rt * g; s += (v[j].x * v[j].x + v[j].y * v[j].y) + (v[j].z * v[j].z + v[j].w * v[j].w); }
        const float r3 = rsqrtf(wave_sum(s) * (1.f / DM) + EPS);
#pragma unroll
        for (int j = 0; j < 8; ++j) { const f32x4 g = *(const f32x4*)(gfin + (j * 64 + lane) * 4); *(f32x4*)(out + (size_t)m * DM + (j * 64 + lane) * 4) = v[j] * r3 * g; }
    }
}
constexpr int N_PHASES = 12;
__global__ void __launch_bounds__(NWAVES * 64, 2) hybrid_fwd(Args args) {
    extern __shared__ __attribute__((aligned(16))) unsigned char lds_raw[];
    LAS unsigned char* lds = (LAS unsigned char*)lds_raw;
    volatile LAS unsigned* MISC = (volatile LAS unsigned*)(lds + MISC_OFF);
    const int wave = __builtin_amdgcn_readfirstlane(threadIdx.x >> 6);
    const int G = gridDim.x, c = blockIdx.x;
    unsigned char* ws = args.ws;
    unsigned* ctl = (unsigned*)(ws + WS_CTL);
    for (int u = wave * 64 + lane_id_v(); u < (LDS_BYTES - MISC_OFF) / 4; u += NWAVES * 64) ((LAS unsigned*)(lds + MISC_OFF))[u] = 0u;
    __syncthreads();
    const int lo = args.ph_lo, hi = args.ph_hi;
    XcdBarrier bar; bar.bar = ctl + CW_BAR; bar.x = 0; bar.st = nullptr; bar.wave = wave;
    if (hi - lo > 1) bar = xcd_barrier_post(ctl + CW_BAR, MISC + 8, wave);
#ifndef PH_MASK
#define PH_MASK 0xFFF
#endif
#define IN(k) ((((PH_MASK) >> (k)) & 1) && lo <= (k) && (k) < hi)
#define BOTH(k) (IN(k) && IN((k) + 1))
#define SEAM(k) do { if (BOTH(k)) xcd_barrier(bar); } while (0)
#ifndef REPEAT_MASK
#define REPEAT_MASK 0
#endif
#define NREP(k) ((((REPEAT_MASK) >> (k)) & 1) ? 2 : 1)
#define REP_BEGIN(k) for (int rep_ = 0; rep_ < NREP(k); ++rep_) { if (rep_) xcd_barrier(bar);
#define REP_END }

    bf16_t* QKV7 = (bf16_t*)(ws + WS_QKV7);
    if (IN(0)) { REP_BEGIN(0) p0_prologue(args, lds, c, G, wave, lane_id_v()); REP_END SEAM(0); }

    if (IN(1)) {
        REP_BEGIN(1)
        { pg8::DenseOrder S; S.init(SEQ, NPRJ, G, c);
          EpiInProj E{0, QKV7, (bf16_t*)(ws + WS_SG), (bf16_t*)(ws + WS_KI), (float*)(ws + WS_WI), (float*)(ws + WS_CTL + CTL_KMEAN), (const float*)(ws + WS_ROPEA), (const float*)(ws + WS_ROPEI), args.in[IN_GIDX], args.in[IN_BIDX]};
          pg8::gemm_phase<EpiInProj, pg8::DenseOrder, false, true>(lds, (const bf16_t*)(ws + WS_H1), (const bf16_t*)(ws + WS_WIN), DM, S, E, wave); }
        { constexpr int NU_IN = (SEQ / 256) * (NPRJ / 256); const int rem = NU_IN % G;
          pg8::DenseOrder S; if (rem == 0) S.init(SEQ, DM, G, c); else S.init(SEQ, DM, G - rem, c >= rem ? c - rem : (1 << 30));
          EpiBf16Plain E{0, (bf16_t*)(ws + WS_PLEB), DM};
          pg8::gemm_phase<EpiBf16Plain, pg8::DenseOrder, false, true>(lds, (const bf16_t*)(ws + WS_PB), (const bf16_t*)(ws + WS_WPP), PLED, S, E, wave); }
        REP_END
        SEAM(1);
    }
    if (IN(2)) { REP_BEGIN(2)
        if (rep_) { if (wave == 0 && lane_id_v() == 0) MISC[16] = 0u; __syncthreads(); }
        for (int rg_ = 0; rg_ < P2_NREP(14); ++rg_) p2_moba_gate(args, lds, c, G, wave, lane_id_v());
        __syncthreads();
        p2_indexer_and_convert(args, lds, MISC, c, G, wave, lane_id_v());
        REP_END SEAM(2); }

    if (IN(3)) {
        const unsigned long long* BM = (const unsigned long long*)(ws + WS_BM); const unsigned* SELB = (const unsigned*)(ws + WS_SELB); bf16_t* OAB = (bf16_t*)(ws + WS_OAB);
        REP_BEGIN(3)
        int L = c;
        if (L < 256) {
#define ATT_REF(R, L_, pass_) do { const int bh_ = (L_) >> 4, x_ = (L_) & 15, br_ = bh_ >> 3, h_ = bh_ & 7, qb_ = (pass_) ? 31 - x_ : x_, P0_ = qb_ * 256; \
            const bf16_t* qt_ = QKV7 + (size_t)(br_ ? 4 : 0) * SEQ * BRW; \
            R.Q = qt_ + (size_t)P0_ * BRW + h_ * HD; R.K = qt_ + (size_t)SEQ * BRW + h_ * HD; R.V = qt_ + (size_t)2 * SEQ * BRW + h_ * HD; \
            R.O = OAB + (size_t)P0_ * DM + br_ * BRW + h_ * HD; R.P0 = P0_; R.mode = br_; R.bm = BM + (size_t)P0_ * (SEQ / 64); R.selw = SELB + (size_t)P0_ * NHEAD + h_; } while (0)
            att::BlockRef cur, nxt; int pass = 0; ATT_REF(cur, L, 0);
            att::Seam S;
            att::attn_prime(cur, (char*)lds_raw, S, wave);
            for (;;) {
                const bool more_pass = (pass == 0), more_item = (L + G < 256), last = !more_pass && !more_item;
                int Ln = L, passn = pass + 1;
                if (!more_pass) { passn = 0; Ln = more_item ? L + G : L; }
                if (last) nxt = cur; else ATT_REF(nxt, Ln, passn);
                att::attn_block(cur, nxt, (char*)lds_raw, S, wave);
                if (last) break;
                cur = nxt; pass = passn; L = Ln;
            }
#undef ATT_REF
        }
        REP_END
        SEAM(3);
    }
    if (IN(4)) {
        pg8::DenseOrder S; S.init(SEQ, DM, G, c);
        EpiMerged E{16, (const bf16_t*)(ws + WS_SG), (bf16_t*)(ws + WS_MERGED)};
        REP_BEGIN(4)
        pg8::gemm_phase<EpiMerged, pg8::DenseOrder, false, true>(lds, (const bf16_t*)(ws + WS_OAB), (const bf16_t*)(ws + WS_WBR), DM, S, E, wave);
        REP_END
        SEAM(4);
    }
    if (IN(5)) {
        pg8::DenseOrder S; S.init(SEQ, DM, G, c);
        EpiResF32 E{0, args.in[IN_X], (float*)(ws + WS_X1)};
        REP_BEGIN(5)
        pg8::gemm_phase<EpiResF32, pg8::DenseOrder, false, true>(lds, (const bf16_t*)(ws + WS_MERGED), (const bf16_t*)(ws + WS_WOUT), DM, S, E, wave);
        REP_END
        SEAM(5);
    }
    if (IN(6)) { p6_route(args, lds, c, G, wave, lane_id_v()); SEAM(6); }
    if (IN(7)) {
        const int vcu = (G % 8 == 0) ? (c % 8) * (G / 8) + c / 8 : c;
        MoeOrder S; S.init((const int*)(ctl + CW_CNT), (const int*)(ws + WS_LIST), 16, G, vcu);
        EpiGateUp E{0, (const int*)(ws + WS_LIST), (const float*)(ws + WS_RSL), args.in[IN_BGU], (bf16_t*)(ws + WS_ACT)};
        REP_BEGIN(7)
        pg8::gemm_phase<EpiGateUp, MoeOrder, true, true, true>(lds, (const bf16_t*)(ws + WS_H2U), (const bf16_t*)(ws + WS_WGU), DM, S, E, wave);
        REP_END
        SEAM(7);
    }
    if (IN(8)) {
        const int vcu = (G % 8 == 0) ? (c % 8) * (G / 8) + c / 8 : c;
        MoeOrder S; S.init((const int*)(ctl + CW_CNT), (const int*)(ws + WS_LIST), 8, G, vcu);
        EpiDown E{0, (const int*)(ws + WS_LIST), (const float*)(ws + WS_GTL), args.in[IN_BDOWN], (bf16_t*)(ws + WS_YS)};
        REP_BEGIN(8)
        pg8::gemm_phase<EpiDown, MoeOrder, false, true, true>(lds, (const bf16_t*)(ws + WS_ACT), (const bf16_t*)(ws + WS_WD), DFF, S, E, wave);
        REP_END
        SEAM(8);
    }
    if (IN(9)) { REP_BEGIN(9) p9_x2(args, c, G, wave, lane_id_v()); REP_END SEAM(9); }
    if (IN(10)) {
        pg8::DenseOrder S; S.init(SEQ, DM, G, c);
        EpiPleGate E{0, (const bf16_t*)(ws + WS_PLEB), (bf16_t*)(ws + WS_T), (float*)(ws + WS_TSS)};
        REP_BEGIN(10)
        pg8::gemm_phase<EpiPleGate, pg8::DenseOrder, false, true>(lds, (const bf16_t*)(ws + WS_X2B), (const bf16_t*)(ws + WS_WPG), DM, S, E, wave);
        REP_END
        SEAM(10);
    }
    if (IN(11)) { REP_BEGIN(11) p11_final(args, c, G, wave, lane_id_v()); REP_END }
#undef IN
#undef BOTH
#undef SEAM
#undef NREP
#undef REP_BEGIN
#undef REP_END
}

#ifndef MK_N_LAUNCHES
#define MK_N_LAUNCHES 1
#endif
extern "C" void kernel_launch(void* const* d_in, const int* in_sizes, int n_in, void* d_out, int out_size, void* d_ws, size_t ws_size, hipStream_t stream) {
    static int grid = 0;
    if (grid == 0) {
        if (n_in != 20 || in_sizes[0] != SEQ * DM || out_size != SEQ * DM || ws_size < WS_END) { fprintf(stderr, "kernel_launch: unexpected shapes (n_in %d, in0 %d, out %d, ws %zu)\n", n_in, n_in > 0 ? in_sizes[0] : -1, out_size, ws_size); grid = -1; return; }
        int dev = 0, cus = 0, per_cu = 0;
        if (hipGetDevice(&dev) != hipSuccess || hipDeviceGetAttribute(&cus, hipDeviceAttributeMultiprocessorCount, dev) != hipSuccess) { grid = -1; return; }
        if (hipFuncSetAttribute((const void*)hybrid_fwd, hipFuncAttributeMaxDynamicSharedMemorySize, LDS_BYTES) != hipSuccess) { fprintf(stderr, "kernel_launch: hipFuncSetAttribute failed\n"); grid = -1; return; }
        if (hipOccupancyMaxActiveBlocksPerMultiprocessor(&per_cu, (const void*)hybrid_fwd, NWAVES * 64, LDS_BYTES) != hipSuccess || per_cu < 1) { fprintf(stderr, "kernel_launch: occupancy query says %d blocks per CU\n", per_cu); }
        (void)hipGetLastError();
        grid = cus > 0 ? cus : 256;
    }
    if (grid < 0) return;
    if (hipMemsetAsync((char*)d_ws + WS_CTL, 0, CTL_ZERO_BYTES, stream) != hipSuccess) return;
    Args a{};
    for (int i = 0; i < 20; ++i) a.in[i] = (const float*)d_in[i];
    a.out = (float*)d_out; a.ws = (unsigned char*)d_ws;
    if (MK_N_LAUNCHES == 1) { a.ph_lo = 0; a.ph_hi = N_PHASES; hipLaunchKernelGGL(hybrid_fwd, dim3(grid), dim3(NWAVES * 64), LDS_BYTES, stream, a); }
    else { for (int p = 0; p < N_PHASES; ++p) { a.ph_lo = p; a.ph_hi = p + 1; hipLaunchKernelGGL(hybrid_fwd, dim3(grid), dim3(NWAVES * 64), LDS_BYTES, stream, a); } }
    const hipError_t le = hipPeekAtLastError();
    if (le != hipSuccess) fprintf(stderr, "kernel_launch: launch failed: %s\n", hipGetErrorName(le));
}
```

```cpp
#include <hip/hip_runtime.h>
#include <hip/hip_bf16.h>
#include <cstdio>
#include <cstdint>

#define GAS __attribute__((address_space(1)))
#define LAS __attribute__((address_space(3)))
typedef unsigned short bf16_t;
typedef short bf16x8 __attribute__((ext_vector_type(8)));
typedef short s16x4 __attribute__((ext_vector_type(4)));
typedef float f32x4 __attribute__((ext_vector_type(4)));
typedef float f32x2 __attribute__((ext_vector_type(2)));
typedef float f32x16 __attribute__((ext_vector_type(16)));
typedef unsigned u32x4 __attribute__((ext_vector_type(4)));
typedef unsigned u32x2 __attribute__((ext_vector_type(2)));

typedef __bf16 bf16x2_n __attribute__((ext_vector_type(2)));
__device__ __forceinline__ unsigned cvt_pk_bf16(float lo, float hi) { const f32x2 v = {lo, hi}; return __builtin_bit_cast(unsigned, __builtin_convertvector(v, bf16x2_n)); }
__device__ __forceinline__ float bf_lo(unsigned w) { return __uint_as_float(w << 16); }
__device__ __forceinline__ float bf_hi(unsigned w) { return __uint_as_float(w & 0xffff0000u); }
__device__ __forceinline__ float sigmoidf_(float x) { return __builtin_amdgcn_rcpf(1.0f + __builtin_amdgcn_exp2f(x * -1.4426950408889634f)); }
__device__ __forceinline__ float sigmoid_fast(float x) { return sigmoidf_(x); }
__device__ __forceinline__ int lane_id_v() { int l; asm volatile("v_mbcnt_lo_u32_b32 %0, -1, 0\n\tv_mbcnt_hi_u32_b32 %0, -1, %0" : "=v"(l)); return l; }

namespace pg8 {
constexpr int BM = 256, BK = 64, HALF = 128, HTB = HALF * BK * 2, STAGE_BYTES = 8 * HTB, NXCD = 8, WGM = 8;
__host__ __device__ __forceinline__ int lds_byte(int r, int c) { const int st = (r >> 4) * 2 + (c >> 5), rr = r & 15, cc = c & 31, ob = rr * 64 + cc * 2; return st * 1024 + (ob ^ (((ob >> 9) & 1) << 5)); }
__host__ __device__ __forceinline__ void stage_rc(int b, int& R, int& C) { const int st = b / 1024, sb = b % 1024, swz = sb ^ (((sb >> 9) & 1) << 5); R = (st >> 1) * 16 + swz / 64; C = (st & 1) * 32 + (swz % 64) / 2; }
__host__ __device__ __forceinline__ int perm32(int rho) { const int n = rho >> 4, i = rho & 15; return 8 * (i >> 2) + 4 * n + (i & 3); }

struct Unit { int pm, pn, e, b, rows, rb; };

struct DenseOrder {
    int nM, nN, nwg, G, c;
    __device__ void init(int M, int N, int G_, int c_) { nM = M / BM; nN = N / BM; nwg = nM * nN; G = G_; c = c_; }
    __device__ bool next(int i, Unit& u) const {
        const long L = (long)i * G + c; if (L >= nwg) return false;
        int wgid = (int)L; { const int q = nwg / NXCD, r = nwg % NXCD, xcd = wgid % NXCD, off = wgid / NXCD; wgid = (xcd < r ? xcd * (q + 1) : r * (q + 1) + (xcd - r) * q) + off; }
        const int nig = WGM * nN, gid = wgid / nig, fm = gid * WGM, gsz = (nM - fm) < WGM ? (nM - fm) : WGM;
        u.pm = fm + ((wgid % nig) % gsz); u.pn = (wgid % nig) / gsz; u.e = 0; u.b = 0; u.rows = 256; u.rb = u.pm; return true;
    }
    __device__ __forceinline__ size_t a_row0(const Unit& u) const { return (size_t)u.pm * BM; }
    __device__ __forceinline__ size_t b_row0(const Unit& u) const { return (size_t)u.pn * BM; }
    __device__ __forceinline__ int a_row(const Unit&, int) const { return 0; }
    static constexpr bool PARTIAL = false;
};

template <class Epi, class Sched, bool GATHER, bool ALIGN_EPI, bool BBLK = false>
__device__ __forceinline__ void gemm_phase(LAS unsigned char* lds, const bf16_t* A, const bf16_t* Bt, const int K, const Sched& S, const Epi& E, const int wid) {
    const int lane = lane_id_v(), tid = wid * 64 + lane, wr = wid >> 2, wc = wid & 3, fr = lane & 15, fq = lane >> 4;
    const int nt = K / BK;
    int Rr[2], Cc[2]; unsigned voffB[2], vC[2][2], vN[2][2];
#pragma unroll
    for (int i = 0; i < 2; ++i) { stage_rc(tid * 16 + i * 8192, Rr[i], Cc[i]); const int Rb = (Rr[i] & ~31) + perm32(Rr[i] & 31);
        voffB[i] = BBLK ? (unsigned)((Rb >> 6) * (K >> 6)) * 8192u + (unsigned)((Rb & 63) * 128 + Cc[i] * 2) : (unsigned)(Rb * K + Cc[i]) * 2u; }
    const size_t kstep = (size_t)(BK * 2), kstepB = BBLK ? (size_t)8192 : kstep;
    const size_t hstep = (size_t)HALF * K * 2;
    const unsigned ldsw = (unsigned)wid * 1024u;
    const int aoff = lds_byte(wr * 64 + fr, fq * 8), boff = lds_byte(wc * 32 + fr, fq * 8);
    const unsigned lbase = (unsigned)(unsigned long long)lds;
#define PG8_SA(b, h) (((b) * 2 + (h)) * HTB)
#define PG8_SB(b, h) ((4 + (b) * 2 + (h)) * HTB)
#define PG8_STAGE(bufoff, gbase, voff) do { _Pragma("unroll") for (int _i = 0; _i < 2; ++_i) \
        __builtin_amdgcn_global_load_lds((const unsigned*)((const char*)(gbase) + (voff)[_i]), (LAS unsigned*)(lds + (bufoff) + ldsw + _i * 8192), 16, 0, 0); } while (0)
#define PG8_STAGEA(bufoff, gbase, VO, h) PG8_STAGE(bufoff, (gbase) + (GATHER ? (size_t)0 : (size_t)(h) * hstep), (VO)[GATHER ? (h) : 0])
#define PG8_LDA(dst, b, h) do { _Pragma("unroll") for (int m = 0; m < 4; ++m) _Pragma("unroll") for (int k = 0; k < 2; ++k) dst[m][k] = *(const LAS bf16x8*)(lds + PG8_SA(b, h) + aoff + m * 2048 + k * 1024); } while (0)
#define PG8_LDB(dst, b, h) do { _Pragma("unroll") for (int n = 0; n < 2; ++n) _Pragma("unroll") for (int k = 0; k < 2; ++k) dst[n][k] = *(const LAS bf16x8*)(lds + PG8_SB(b, h) + boff + n * 2048 + k * 1024); } while (0)
#define PG8_MMA(ai, bj, At, Bt_) do { __builtin_amdgcn_s_setprio(1); _Pragma("unroll") for (int m = 0; m < 4; ++m) _Pragma("unroll") for (int n = 0; n < 2; ++n) _Pragma("unroll") for (int k = 0; k < 2; ++k) \
        acc[ai][bj][m][n] = __builtin_amdgcn_mfma_f32_16x16x32_bf16(Bt_[n][k], At[m][k], acc[ai][bj][m][n], 0, 0, 0); __builtin_amdgcn_s_setprio(0); } while (0)
#define PG8_WAIT_V(n) asm volatile("s_waitcnt vmcnt(" #n ")" ::: "memory")
#define PG8_WAIT_L(n) asm volatile("s_waitcnt lgkmcnt(" #n ")" ::: "memory")
#define PG8_BAR __builtin_amdgcn_s_barrier()
#define PG8_SCHED __builtin_amdgcn_sched_barrier(0)
#define PG8_VOFF(dst, u) do { _Pragma("unroll") for (int _h = 0; _h < 2; ++_h) _Pragma("unroll") for (int _i = 0; _i < 2; ++_i) { \
        const int _r = GATHER ? S.a_row(u, _h * HALF + Rr[_i]) : (_h * HALF + Rr[_i]); dst[_h][_i] = (unsigned)(_r * K + Cc[_i]) * 2u; } \
        if (GATHER) { asm volatile("s_waitcnt vmcnt(0)" ::: "memory"); } } while (0)
#define PG8_DSR(dst, base, off) asm volatile("ds_read_b128 %0, %1 offset:" #off : "=v"(dst) : "v"(base))
#define PG8_LDA_ASM(dst, b, h) do { const unsigned _ab = lbase + (unsigned)(PG8_SA(b, h) + aoff); PG8_DSR(dst[0][0], _ab, 0); PG8_DSR(dst[0][1], _ab, 1024); PG8_DSR(dst[1][0], _ab, 2048); PG8_DSR(dst[1][1], _ab, 3072); \
        PG8_DSR(dst[2][0], _ab, 4096); PG8_DSR(dst[2][1], _ab, 5120); PG8_DSR(dst[3][0], _ab, 6144); PG8_DSR(dst[3][1], _ab, 7168); } while (0)
#define PG8_LDB_ASM(dst, b, h) do { const unsigned _bb = lbase + (unsigned)(PG8_SB(b, h) + boff); PG8_DSR(dst[0][0], _bb, 0); PG8_DSR(dst[0][1], _bb, 1024); PG8_DSR(dst[1][0], _bb, 2048); PG8_DSR(dst[1][1], _bb, 3072); } while (0)
#define PG8_UNDEF_A(dst) do { _Pragma("unroll") for (int m = 0; m < 4; ++m) _Pragma("unroll") for (int k = 0; k < 2; ++k) asm volatile("" : "=v"(dst[m][k])); } while (0)
#define PG8_UNDEF_B(dst) do { _Pragma("unroll") for (int n = 0; n < 2; ++n) _Pragma("unroll") for (int k = 0; k < 2; ++k) asm volatile("" : "=v"(dst[n][k])); } while (0)
#define PG8_KLOOP(D0, D1, LDA_, LDB_) \
        _Pragma("unroll 1") for (int t = 0; t < nt; t += 2) { \
            const bool last = (t == nt - 2); \
            if constexpr (Epi::HAS_MID) { if (t == E.mid_t) E.mid(acc, cur, wr, wc, fr, fq); } \
            const char* a1 = cA + (size_t)(t + 1) * kstep; \
            const char* a2 = last ? nA : cA + (size_t)(t + 2) * kstep; const char* b2 = last ? nB : cB + (size_t)(t + 2) * kstepB; \
            const char* a3 = a2 + kstep; const char* b3 = b2 + kstepB; \
            unsigned o2[2][2]; \
            _Pragma("unroll") for (int h = 0; h < 2; ++h) _Pragma("unroll") for (int i = 0; i < 2; ++i) o2[h][i] = (GATHER && last) ? vN[h][i] : vC[h][i]; \
            if (D0) { LDB_(B0, 0, 0); LDB_(B1, 0, 1); PG8_SCHED; LDA_(At, 0, 0); } else { PG8_UNDEF_B(B0); PG8_UNDEF_B(B1); PG8_UNDEF_A(At); } PG8_STAGEA(PG8_SA(1, 1), a1, vC, 1); \
            PG8_WAIT_V(8); PG8_WAIT_L(0); PG8_BAR; if (D0) { PG8_MMA(0, 0, At, B0); PG8_MMA(0, 1, At, B1); } PG8_BAR; PG8_SCHED; \
            if (D1) { LDA_(At, 0, 1); } else { PG8_UNDEF_A(At); } PG8_STAGE(PG8_SB(0, 0), b2, voffB); PG8_STAGE(PG8_SB(0, 1), b2 + hstep, voffB); PG8_STAGEA(PG8_SA(0, 0), a2, o2, 0); \
            PG8_WAIT_V(8); PG8_WAIT_L(0); PG8_BAR; if (D1) { PG8_MMA(1, 0, At, B0); PG8_MMA(1, 1, At, B1); } PG8_BAR; PG8_SCHED; \
            if (D0) { LDB_(B0, 1, 0); LDB_(B1, 1, 1); PG8_SCHED; LDA_(At, 1, 0); } else { PG8_UNDEF_B(B0); PG8_UNDEF_B(B1); PG8_UNDEF_A(At); } PG8_STAGEA(PG8_SA(0, 1), a2, o2, 1); \
            PG8_WAIT_V(8); PG8_WAIT_L(0); PG8_BAR; if (D0) { PG8_MMA(0, 0, At, B0); PG8_MMA(0, 1, At, B1); } PG8_BAR; PG8_SCHED; \
            if (D1) { LDA_(At, 1, 1); } else { PG8_UNDEF_A(At); } PG8_STAGE(PG8_SB(1, 0), b3, voffB); PG8_STAGE(PG8_SB(1, 1), b3 + hstep, voffB); PG8_STAGEA(PG8_SA(1, 0), a3, o2, 0); \
            PG8_WAIT_V(8); PG8_WAIT_L(0); PG8_BAR; if (D1) { PG8_MMA(1, 0, At, B0); PG8_MMA(1, 1, At, B1); } PG8_BAR; PG8_SCHED; \
        }
    Unit cur, nxt; int ui = 0;
    if (!S.next(0, cur)) return;
    f32x4 acc[2][2][4][2];
#pragma unroll
    for (int a = 0; a < 2; ++a)
#pragma unroll
        for (int b = 0; b < 2; ++b)
#pragma unroll
            for (int m = 0; m < 4; ++m)
#pragma unroll
                for (int n = 0; n < 2; ++n) acc[a][b][m][n] = (f32x4){0.f, 0.f, 0.f, 0.f};
    bf16x8 At[4][2], B0[2][2], B1[2][2];
    PG8_VOFF(vC, cur);
#pragma unroll
    for (int h = 0; h < 2; ++h)
#pragma unroll
        for (int i = 0; i < 2; ++i) vN[h][i] = vC[h][i];
    const char* cA = (const char*)A + (GATHER ? (size_t)0 : S.a_row0(cur) * (size_t)K * 2); const char* cB = (const char*)Bt + S.b_row0(cur) * (size_t)K * 2;
    PG8_STAGE(PG8_SB(0, 0), cB, voffB); PG8_STAGE(PG8_SB(0, 1), cB + hstep, voffB); PG8_STAGEA(PG8_SA(0, 0), cA, vC, 0); PG8_STAGEA(PG8_SA(0, 1), cA, vC, 1);
    if (wr == 1) PG8_BAR;
    PG8_WAIT_V(2); PG8_BAR;
    PG8_STAGE(PG8_SB(1, 0), cB + kstepB, voffB); PG8_STAGEA(PG8_SA(1, 0), cA + kstep, vC, 0); PG8_STAGE(PG8_SB(1, 1), cB + hstep + kstepB, voffB);
    PG8_WAIT_V(6); PG8_BAR;
    for (;;) {
        bool do0 = true, do1 = true;
        if constexpr (Sched::PARTIAL) { do0 = wr * 64 < cur.rows; do1 = HALF + wr * 64 < cur.rows; }
        const bool has_next = S.next(ui + 1, nxt);
        const char* nA = (has_next && !GATHER) ? (const char*)A + S.a_row0(nxt) * (size_t)K * 2 : cA; const char* nB = has_next ? (const char*)Bt + S.b_row0(nxt) * (size_t)K * 2 : cB;
        if (GATHER && has_next) { PG8_VOFF(vN, nxt); }
        if (do1) { PG8_KLOOP(true, true, PG8_LDA, PG8_LDB) } else if (do0) { PG8_KLOOP(true, false, PG8_LDA, PG8_LDB) } else { PG8_KLOOP(false, false, PG8_LDA, PG8_LDB) }
        if constexpr (ALIGN_EPI) { if (wr == 0) PG8_BAR; }
        E(acc, cur, wr, wc, fr, fq);
        if (!has_next) break;
#pragma unroll
        for (int a = 0; a < 2; ++a)
#pragma unroll
            for (int b = 0; b < 2; ++b)
#pragma unroll
                for (int m = 0; m < 4; ++m)
#pragma unroll
                    for (int n = 0; n < 2; ++n) acc[a][b][m][n] = (f32x4){0.f, 0.f, 0.f, 0.f};
        cur = nxt; cA = nA; cB = nB; ++ui;
#pragma unroll
        for (int h = 0; h < 2; ++h)
#pragma unroll
            for (int i = 0; i < 2; ++i) vC[h][i] = vN[h][i];
        if constexpr (ALIGN_EPI) { if (wr == 1) PG8_BAR; }
    }
    PG8_WAIT_V(0);
    if constexpr (!ALIGN_EPI) { if (wr == 0) PG8_BAR; }
    PG8_BAR;
#undef PG8_SA
#undef PG8_SB
#undef PG8_STAGE
#undef PG8_STAGEA
#undef PG8_LDA
#undef PG8_LDB
#undef PG8_MMA
#undef PG8_WAIT_V
#undef PG8_WAIT_L
#undef PG8_BAR
#undef PG8_SCHED
#undef PG8_VOFF
#undef PG8_KLOOP
#undef PG8_UNDEF_A
#undef PG8_UNDEF_B
#undef PG8_DSR
#undef PG8_LDA_ASM
#undef PG8_LDB_ASM
}
}
constexpr int SEQ = 8192, DM = 2048, HD = 128, NHEAD = 8, BRW = 1024, IDXH = 16, IDXD = 64, NEXP = 32, TOPK = 4, DFF = 2048, PLED = 256;
constexpr int INW = 11344, NPRJ = 11520;
constexpr int DSA_TOPK = 256, MOBA_BLK = 256, NKB = SEQ / MOBA_BLK;
constexpr float EPS = 1e-6f, SWI_LIMIT = 7.0f, SWI_ALPHA = 1.702f, IDX_W_SCALE = 0.03125f;

#define ACC_T f32x4 (&acc)[2][2][4][2]
#define CACC_T const f32x4 (&acc)[2][2][4][2]
__device__ __forceinline__ u32x4 pack8bf(const f32x4 a, const f32x4 b) { u32x4 w; w.x = cvt_pk_bf16(a[0], a[1]); w.y = cvt_pk_bf16(a[2], a[3]); w.z = cvt_pk_bf16(b[0], b[1]); w.w = cvt_pk_bf16(b[2], b[3]); return w; }
__device__ __forceinline__ void unpack8bf(const u32x4 w, float (&o)[8]) { o[0] = bf_lo(w.x); o[1] = bf_hi(w.x); o[2] = bf_lo(w.y); o[3] = bf_hi(w.y); o[4] = bf_lo(w.z); o[5] = bf_hi(w.z); o[6] = bf_lo(w.w); o[7] = bf_hi(w.w); }

struct EpiInProj {
    static constexpr bool HAS_MID = false; int mid_t;
    bf16_t* qkv7; bf16_t* sg; bf16_t* ki; float* wi; float* kmean; const float* ropeA; const float* ropeI; const float* g_idx; const float* b_idx;
    __device__ __forceinline__ void mid(ACC_T, const pg8::Unit&, int, int, int, int) const {}
    __device__ __forceinline__ void operator()(CACC_T, const pg8::Unit& u, int wr, int wc, int fr_in, int fq_in) const {
        int fr = fr_in, fq = fq_in; asm volatile("" : "+v"(fr), "+v"(fq));
        const int pn = u.pn, row0 = u.pm * 256 + wr * 64 + fr;
        if (pn < 28) {
            const int tsr = pn >> 2, colt = (pn & 3) * 256;
            bf16_t* dst = qkv7 + (size_t)tsr * ((size_t)SEQ * BRW);
            const bool rope32 = (tsr == 0 || tsr == 1 || tsr == 4 || tsr == 5) && (wc == 0);
            const bool rope16 = (tsr == 3) && ((wc & 1) == 0);
            const bool km = (tsr == 5);
#pragma unroll
            for (int bj = 0; bj < 2; ++bj) {
                float ks[8];
#pragma unroll
                for (int i = 0; i < 8; ++i) ks[i] = 0.f;
#pragma unroll
                for (int ai = 0; ai < 2; ++ai)
#pragma unroll
                    for (int m = 0; m < 4; ++m) {
                        const int row = row0 + ai * 128 + m * 16;
                        f32x4 cs[4];
                        if (rope32) { const f32x4* tp = (const f32x4*)(ropeA + ((size_t)row * 16 + 8 * (fq & 1)) * 2);
#pragma unroll
                            for (int q = 0; q < 4; ++q) cs[q] = tp[q]; }
                        else if (rope16) { const f32x4* tp = (const f32x4*)(ropeI + (size_t)row * 16);
#pragma unroll
                            for (int q = 0; q < 4; ++q) cs[q] = tp[q]; }
                        float v[8];
#pragma unroll
                        for (int i = 0; i < 4; ++i) { v[i] = acc[ai][bj][m][0][i]; v[4 + i] = acc[ai][bj][m][1][i]; }
                        if (rope32) {
#pragma unroll
                            for (int i = 0; i < 8; ++i) { const float p = __shfl_xor(v[i], 32); const float c = cs[i >> 1][(i & 1) * 2], s = cs[i >> 1][(i & 1) * 2 + 1];
                                v[i] = v[i] * c + (fq < 2 ? -p : p) * s; }
                        } else if (rope16) {
#pragma unroll
                            for (int i = 0; i < 8; ++i) { const float p = __shfl_xor(v[i], 16); const float c = cs[i >> 1][(i & 1) * 2], s = cs[i >> 1][(i & 1) * 2 + 1];
                                const float r = v[i] * c + (fq == 0 ? -p : p) * s; v[i] = (fq < 2) ? r : v[i]; }
                        }
                        if (km) {
#pragma unroll
                            for (int i = 0; i < 8; ++i) ks[i] += v[i];
                        }
                        u32x4 w; w.x = cvt_pk_bf16(v[0], v[1]); w.y = cvt_pk_bf16(v[2], v[3]); w.z = cvt_pk_bf16(v[4], v[5]); w.w = cvt_pk_bf16(v[6], v[7]);
                        *(u32x4*)(dst + (size_t)row * BRW + colt + bj * 128 + wc * 32 + fq * 8) = w;
                        asm volatile("" ::: "memory");
                    }
                if (km) {
#pragma unroll
                    for (int i = 0; i < 8; ++i) { float s = ks[i]; s += __shfl_xor(s, 1); s += __shfl_xor(s, 2); s += __shfl_xor(s, 4); s += __shfl_xor(s, 8);
                        if (fr == 0) atomicAdd(kmean + (size_t)u.pm * BRW + colt + bj * 128 + wc * 32 + fq * 8 + i, s); }
                }
            }
        } else if (pn < 44) {
            const int colt = (pn - 28) * 256;
#pragma unroll
            for (int ai = 0; ai < 2; ++ai)
#pragma unroll
                for (int m = 0; m < 4; ++m) {
                    const int row = row0 + ai * 128 + m * 16;
#pragma unroll
                    for (int bj = 0; bj < 2; ++bj) {
                        float v[8];
#pragma unroll
                        for (int i = 0; i < 4; ++i) { v[i] = sigmoid_fast(acc[ai][bj][m][0][i]); v[4 + i] = sigmoid_fast(acc[ai][bj][m][1][i]); }
                        u32x4 w; w.x = cvt_pk_bf16(v[0], v[1]); w.y = cvt_pk_bf16(v[2], v[3]); w.z = cvt_pk_bf16(v[4], v[5]); w.w = cvt_pk_bf16(v[6], v[7]);
                        *(u32x4*)(sg + (size_t)row * 4096 + colt + bj * 128 + wc * 32 + fq * 8) = w;
                    }
                    asm volatile("" ::: "memory");
                }
        } else {
            if (wc == 0) {
#pragma unroll 1
                for (int am = 0; am < 8; ++am) {
                    const int ai = am >> 2, m = am & 3;
                    const int row = row0 + ai * 128 + m * 16;
                    float v[2][8]; float s = 0.f;
#pragma unroll
                    for (int bj = 0; bj < 2; ++bj)
#pragma unroll
                        for (int i = 0; i < 4; ++i) {
                            float x0, x1;
                            x0 = acc[0][bj][0][0][i]; x1 = acc[0][bj][0][1][i];
#pragma unroll
                            for (int q = 1; q < 8; ++q) { x0 = (am == q) ? acc[q >> 2][bj][q & 3][0][i] : x0; x1 = (am == q) ? acc[q >> 2][bj][q & 3][1][i] : x1; }
                            v[bj][i] = x0; v[bj][4 + i] = x1; s += x0 + x1; }
                    s += __shfl_xor(s, 16); s += __shfl_xor(s, 32);
                    const float mu = s * (1.f / 64.f); float q2 = 0.f;
#pragma unroll
                    for (int bj = 0; bj < 2; ++bj)
#pragma unroll
                        for (int i = 0; i < 8; ++i) { v[bj][i] -= mu; q2 += v[bj][i] * v[bj][i]; }
                    q2 += __shfl_xor(q2, 16); q2 += __shfl_xor(q2, 32);
                    const float rstd = rsqrtf(q2 * (1.f / 64.f) + EPS);
#pragma unroll
                    for (int bj = 0; bj < 2; ++bj)
#pragma unroll
                        for (int i = 0; i < 8; ++i) v[bj][i] = v[bj][i] * rstd * g_idx[bj * 32 + fq * 8 + i] + b_idx[bj * 32 + fq * 8 + i];
                    const float* tp = ropeI + (size_t)row * 16;
#pragma unroll
                    for (int i = 0; i < 8; ++i) { const float p = __shfl_xor(v[0][i], 16); const float c = tp[2 * i], sn = tp[2 * i + 1];
                        const float r = v[0][i] * c + (fq == 0 ? -p : p) * sn; v[0][i] = (fq < 2) ? r : v[0][i]; }
#pragma unroll
                    for (int bj = 0; bj < 2; ++bj) { u32x4 w; w.x = cvt_pk_bf16(v[bj][0], v[bj][1]); w.y = cvt_pk_bf16(v[bj][2], v[bj][3]); w.z = cvt_pk_bf16(v[bj][4], v[bj][5]); w.w = cvt_pk_bf16(v[bj][6], v[bj][7]);
                        *(u32x4*)(ki + (size_t)row * IDXD + bj * 32 + fq * 8) = w; }
                    asm volatile("" ::: "memory");
                }
            } else if (wc == 1) {
                if (fq < 2) {
#pragma unroll
                    for (int ai = 0; ai < 2; ++ai)
#pragma unroll
                        for (int m = 0; m < 4; ++m) { const int row = row0 + ai * 128 + m * 16;
                            *(f32x4*)(wi + (size_t)row * IDXH + fq * 8) = acc[ai][0][m][0] * IDX_W_SCALE; *(f32x4*)(wi + (size_t)row * IDXH + fq * 8 + 4) = acc[ai][0][m][1] * IDX_W_SCALE; }
                }
            }
        }
    }
};

struct EpiBf16Plain {
    static constexpr bool HAS_MID = false; int mid_t;
    bf16_t* O; int ldc;
    __device__ __forceinline__ void mid(ACC_T, const pg8::Unit&, int, int, int, int) const {}
    __device__ __forceinline__ void operator()(CACC_T, const pg8::Unit& u, int wr, int wc, int fr_in, int fq_in) const {
        int fr = fr_in, fq = fq_in; asm volatile("" : "+v"(fr), "+v"(fq));
        const int row0 = u.pm * 256 + wr * 64 + fr, col0 = u.pn * 256 + wc * 32 + fq * 8;
#pragma unroll
        for (int ai = 0; ai < 2; ++ai)
#pragma unroll
            for (int m = 0; m < 4; ++m)
#pragma unroll
                for (int bj = 0; bj < 2; ++bj)
                    *(u32x4*)(O + (size_t)(row0 + ai * 128 + m * 16) * ldc + col0 + bj * 128) = pack8bf(acc[ai][bj][m][0], acc[ai][bj][m][1]);
    }
};

struct EpiMerged {
    static constexpr bool HAS_MID = true; int mid_t;
    const bf16_t* sg; bf16_t* O;
    __device__ __forceinline__ void mid(ACC_T, const pg8::Unit& u, int wr, int wc, int fr_in, int fq_in) const {
        int fr = fr_in, fq = fq_in; asm volatile("" : "+v"(fr), "+v"(fq));
        const int row0 = u.pm * 256 + wr * 64 + fr, col0 = u.pn * 256 + wc * 32 + fq * 8;
#pragma unroll
        for (int ai = 0; ai < 2; ++ai)
#pragma unroll
            for (int m = 0; m < 4; ++m)
#pragma unroll
                for (int bj = 0; bj < 2; ++bj) { const bf16_t* gp = sg + (size_t)(row0 + ai * 128 + m * 16) * 4096 + col0 + bj * 128;
                    float a[8], b[8]; unpack8bf(*(const u32x4*)gp, a); unpack8bf(*(const u32x4*)(gp + 2048), b);
#pragma unroll
                    for (int i = 0; i < 4; ++i) { acc[ai][bj][m][0][i] *= a[i] * __builtin_amdgcn_rcpf(b[i]); acc[ai][bj][m][1][i] *= a[4 + i] * __builtin_amdgcn_rcpf(b[4 + i]); }
                    asm volatile("" : "+v"(acc[ai][bj][m][0]), "+v"(acc[ai][bj][m][1]) :: "memory"); }
    }
    __device__ __forceinline__ void operator()(CACC_T, const pg8::Unit& u, int wr, int wc, int fr_in, int fq_in) const {
        int fr = fr_in, fq = fq_in; asm volatile("" : "+v"(fr), "+v"(fq));
        const int row0 = u.pm * 256 + wr * 64 + fr, col0 = u.pn * 256 + wc * 32 + fq * 8;
#pragma unroll
        for (int ai = 0; ai < 2; ++ai)
#pragma unroll
            for (int m = 0; m < 4; ++m)
#pragma unroll
                for (int bj = 0; bj < 2; ++bj) { const size_t ro = (size_t)(row0 + ai * 128 + m * 16);
                    float b[8]; unpack8bf(*(const u32x4*)(sg + ro * 4096 + 2048 + col0 + bj * 128), b);
                    f32x4 v0 = acc[ai][bj][m][0], v1 = acc[ai][bj][m][1];
#pragma unroll
                    for (int i = 0; i < 4; ++i) { v0[i] *= b[i]; v1[i] *= b[4 + i]; }
                    *(u32x4*)(O + ro * DM + col0 + bj * 128) = pack8bf(v0, v1); asm volatile("" ::: "memory"); }
    }
};

struct EpiResF32 {
    static constexpr bool HAS_MID = false; int mid_t;
    const float* X; float* O;
    __device__ __forceinline__ void mid(ACC_T, const pg8::Unit&, int, int, int, int) const {}
    __device__ __forceinline__ void operator()(CACC_T, const pg8::Unit& u, int wr, int wc, int fr_in, int fq_in) const {
        int fr = fr_in, fq = fq_in; asm volatile("" : "+v"(fr), "+v"(fq));
        const int row0 = u.pm * 256 + wr * 64 + fr, col0 = u.pn * 256 + wc * 32 + fq * 8;
#pragma unroll
        for (int ai = 0; ai < 2; ++ai)
#pragma unroll
            for (int m = 0; m < 4; ++m)
#pragma unroll
                for (int bj = 0; bj < 2; ++bj) { const size_t o = (size_t)(row0 + ai * 128 + m * 16) * DM + col0 + bj * 128;
                    const f32x4 x0 = *(const f32x4*)(X + o), x1 = *(const f32x4*)(X + o + 4);
                    *(f32x4*)(O + o) = x0 + acc[ai][bj][m][0]; *(f32x4*)(O + o + 4) = x1 + acc[ai][bj][m][1]; }
    }
};

struct MoeOrder {
    static constexpr bool PARTIAL = true;
    int cnt_l, nb_l, rbx_l, pin_l, pex_l, total, NT, G, c; const int* list;
    __device__ void init(const int* cnt, const int* list_, int NT_, int G_, int c_) {
        const int lane = lane_id_v(), e = lane & 31; NT = NT_; G = G_; c = c_; list = list_;
        cnt_l = cnt[e]; if (cnt_l > SEQ) cnt_l = SEQ; if (cnt_l < 0) cnt_l = 0;
        nb_l = (cnt_l + 255) >> 8;
        int p = nb_l;
#pragma unroll
        for (int o = 1; o < 32; o <<= 1) { const int q = __shfl_up(p, o, 32); if (e >= o) p += q; }
        rbx_l = p - nb_l; pin_l = p * NT; pex_l = (p - nb_l) * NT;
        total = __builtin_amdgcn_readlane(pin_l, 31);
    }
    __device__ bool next(int i, pg8::Unit& u) const {
        const long L = (long)i * G + c; if (L >= total) return false;
        const unsigned long long mk = __ballot(pin_l > (int)L); const int e = __builtin_ctz((unsigned)mk);
        const int base = __builtin_amdgcn_readlane(pex_l, e), nb = __builtin_amdgcn_readlane(nb_l, e), cn = __builtin_amdgcn_readlane(cnt_l, e), rbx = __builtin_amdgcn_readlane(rbx_l, e);
        const int idx = (int)L - base; u.e = e; u.b = idx % nb; u.pn = idx / nb; u.pm = 0; u.rb = rbx + u.b; const int rem = cn - u.b * 256; u.rows = rem < 256 ? rem : 256; return true;
    }
    __device__ __forceinline__ size_t a_row0(const pg8::Unit& u) const { return (size_t)u.rb * 256; }
    __device__ __forceinline__ size_t b_row0(const pg8::Unit& u) const { return (size_t)u.e * ((size_t)NT * 256) + (size_t)u.pn * 256; }
    __device__ __forceinline__ int a_row(const pg8::Unit& u, int r) const { const int rr = r < u.rows ? r : 0; return list[u.e * SEQ + u.b * 256 + rr] >> 2; }
};

struct EpiGateUp {
    static constexpr bool HAS_MID = false; int mid_t;
    const int* list; const float* rstd; const float* bias; bf16_t* act;
    __device__ __forceinline__ void mid(ACC_T, const pg8::Unit&, int, int, int, int) const {}
    __device__ __forceinline__ void operator()(CACC_T, const pg8::Unit& u, int wr, int wc, int fr_in, int fq_in) const {
        int fr = fr_in, fq = fq_in; asm volatile("" : "+v"(fr), "+v"(fq));
        const int jj0 = u.pn * 128 + wc * 32 + fq * 8;
        const f32x4* bp = (const f32x4*)(bias + (size_t)u.e * (2 * DFF) + 2 * jj0);
        const f32x4 b0 = bp[0], b1 = bp[1], b2 = bp[2], b3 = bp[3];
        const float bg[8] = {b0[0], b0[2], b1[0], b1[2], b2[0], b2[2], b3[0], b3[2]}, bl[8] = {b0[1], b0[3], b1[1], b1[3], b2[1], b2[3], b3[1], b3[3]};
#pragma unroll
        for (int ai = 0; ai < 2; ++ai)
#pragma unroll
            for (int m = 0; m < 4; ++m) {
                const int r = ai * 128 + wr * 64 + m * 16 + fr;
                if (r < u.rows) {
                    const float rs = rstd[u.e * SEQ + u.b * 256 + r];
                    float o[8];
#pragma unroll
                    for (int i = 0; i < 8; ++i) { const float g0 = acc[ai][0][m][i >> 2][i & 3] * rs + bg[i], l0 = acc[ai][1][m][i >> 2][i & 3] * rs + bl[i];
                        const float g = fminf(g0, SWI_LIMIT), l = fminf(fmaxf(l0, -SWI_LIMIT), SWI_LIMIT);
                        o[i] = (l + 1.0f) * (g * sigmoid_fast(g * SWI_ALPHA)); }
                    u32x4 w; w.x = cvt_pk_bf16(o[0], o[1]); w.y = cvt_pk_bf16(o[2], o[3]); w.z = cvt_pk_bf16(o[4], o[5]); w.w = cvt_pk_bf16(o[6], o[7]);
                    *(u32x4*)(act + ((size_t)u.rb * 256 + r) * DFF + jj0) = w;
                }
                asm volatile("" ::: "memory");
            }
    }
};

struct EpiDown {
    static constexpr bool HAS_MID = false; int mid_t;
    const int* list; const float* gates; const float* bias; bf16_t* ys;
    __device__ __forceinline__ void mid(ACC_T, const pg8::Unit&, int, int, int, int) const {}
    __device__ __forceinline__ void operator()(CACC_T, const pg8::Unit& u, int wr, int wc, int fr_in, int fq_in) const {
        int fr = fr_in, fq = fq_in; asm volatile("" : "+v"(fr), "+v"(fq));
        const int col0 = u.pn * 256 + wc * 32 + fq * 8;
        f32x4 bv[2][2];
#pragma unroll
        for (int bj = 0; bj < 2; ++bj) { bv[bj][0] = *(const f32x4*)(bias + (size_t)u.e * DM + col0 + bj * 128); bv[bj][1] = *(const f32x4*)(bias + (size_t)u.e * DM + col0 + bj * 128 + 4); }
        asm volatile("" :: "v"(bv[0][0]), "v"(bv[0][1]), "v"(bv[1][0]), "v"(bv[1][1]));
#pragma unroll
        for (int ai = 0; ai < 2; ++ai)
#pragma unroll
            for (int m = 0; m < 4; ++m) {
                const int r = ai * 128 + wr * 64 + m * 16 + fr;
                if (r < u.rows) {
                    const int slot = list[u.e * SEQ + u.b * 256 + r]; const float g = gates[u.e * SEQ + u.b * 256 + r];
#pragma unroll
                    for (int bj = 0; bj < 2; ++bj)
                        *(u32x4*)(ys + (size_t)slot * DM + col0 + bj * 128) = pack8bf((acc[ai][bj][m][0] + bv[bj][0]) * g, (acc[ai][bj][m][1] + bv[bj][1]) * g);
                }
            }
    }
};

struct EpiPleGate {
    static constexpr bool HAS_MID = false; int mid_t;
    const bf16_t* ple; bf16_t* T; float* tss;
    __device__ __forceinline__ void mid(ACC_T, const pg8::Unit&, int, int, int, int) const {}
    __device__ __forceinline__ void operator()(CACC_T, const pg8::Unit& u, int wr, int wc, int fr_in, int fq_in) const {
        int fr = fr_in, fq = fq_in; asm volatile("" : "+v"(fr), "+v"(fq));
        const int row0 = u.pm * 256 + wr * 64 + fr, col0 = u.pn * 256 + wc * 32 + fq * 8;
#pragma unroll
        for (int ai = 0; ai < 2; ++ai)
#pragma unroll
            for (int m = 0; m < 4; ++m) { const size_t ro = (size_t)(row0 + ai * 128 + m * 16); float ss = 0.f;
#pragma unroll
                for (int bj = 0; bj < 2; ++bj) { float pv[8]; unpack8bf(*(const u32x4*)(ple + ro * DM + col0 + bj * 128), pv);
                    f32x4 t0, t1;
#pragma unroll
                    for (int i = 0; i < 4; ++i) { t0[i] = sigmoidf_(acc[ai][bj][m][0][i]) * pv[i]; t1[i] = sigmoidf_(acc[ai][bj][m][1][i]) * pv[4 + i]; ss += t0[i] * t0[i] + t1[i] * t1[i]; }
                    *(u32x4*)(T + ro * DM + col0 + bj * 128) = pack8bf(t0, t1); }
                ss += __shfl_xor(ss, 16); ss += __shfl_xor(ss, 32);
                if (fq == 0) tss[ro * 32 + u.pn * 4 + wc] = ss; }
    }
};
namespace att {
constexpr int D = 128, NW = 8, QBLK = 32, KVBLK = 64, QB = NW * QBLK;
constexpr int SHM_V = KVBLK * D * 2, SHM_K = KVBLK * D * 2;
constexpr int LDS_BYTES = 2 * SHM_V + 2 * SHM_K + NW * 64 * 4;
constexpr float SCALE = 0.08838834764831845f, THR = 8.f;
constexpr int QP = 1024, KP = 1024, OP = 2048;
#define KSWZ(row, colB) ((row) * 256 + ((colB) ^ (((row) & 7) << 4)))
#define SBAR() __builtin_amdgcn_sched_barrier(0)
__device__ __forceinline__ int v_st(int k, int c) { const int kk = (k & ~0xC) | ((k & 4) << 1) | ((k & 8) >> 1); return ((kk >> 3) * 4 + (c >> 5)) * 512 + ((kk & 7) * 32 + (c & 31)) * 2; }
__device__ __forceinline__ int v_rd_base(int lane) { return ((lane & 3) << 3) | (((lane >> 2) & 3) << 6) | (((lane >> 4) & 1) << 5) | (((lane >> 5) & 1) << 8); }
constexpr int v_rd_off(int d0, int ks, int half) { return d0 * 512 + ks * 4096 + half * 2048; }
__device__ __forceinline__ int crow(int r, int hi) { return (r & 3) + 8 * (r >> 2) + 4 * hi; }
__device__ __forceinline__ bf16x8 load8(const bf16_t* p) { return *reinterpret_cast<const bf16x8*>(p); }

__device__ __forceinline__ void mask_causal(f32x16& p0, f32x16& p1, int dq) {
    const float NEG = -__builtin_inff();
#pragma unroll
    for (int r = 0; r < 16; ++r) { const int c = (r & 3) + 8 * (r >> 2); if (dq - c < 0) p0[r] = NEG; if (dq - c - 32 < 0) p1[r] = NEG; }
}
__device__ __forceinline__ void mask_bits(f32x16& p0, f32x16& p1, unsigned lo, unsigned hi32, int hi) {
    const float NEG = -__builtin_inff(); lo >>= 4 * hi; hi32 >>= 4 * hi;
#pragma unroll
    for (int r = 0; r < 16; ++r) { const int c = (r & 3) + 8 * (r >> 2); if (!((lo >> c) & 1u)) p0[r] = NEG; if (!((hi32 >> c) & 1u)) p1[r] = NEG; }
}
__device__ __forceinline__ void mask_all(f32x16& p0, f32x16& p1, bool keep) {
    const float NEG = -__builtin_inff();
#pragma unroll
    for (int r = 0; r < 16; ++r) { p0[r] = keep ? p0[r] : NEG; p1[r] = keep ? p1[r] : NEG; }
}
__device__ __forceinline__ void partialSM(f32x16& p0, f32x16& p1, float& m_reg, float& mn, float& alpha) {
    float pmax = p0[0]; for (int r = 1; r < 16; ++r) pmax = fmaxf(pmax, p0[r]); for (int r = 0; r < 16; ++r) pmax = fmaxf(pmax, p1[r]);
    { auto rr = __builtin_amdgcn_permlane32_swap(__float_as_uint(pmax), __float_as_uint(pmax), false, false);
      pmax = fmaxf(__uint_as_float(rr[0]), __uint_as_float(rr[1])); }
    constexpr float C2 = 1.4426950408889634f * SCALE;
    if (__builtin_expect(__all((pmax - m_reg) * SCALE <= THR), 1)) { mn = m_reg; alpha = 1.f; }
    else { mn = fmaxf(m_reg, pmax); alpha = __builtin_amdgcn_exp2f((m_reg - mn) * C2); m_reg = mn; }
    const float mnL = -mn * C2;
    for (int r = 0; r < 16; ++r) p0[r] = fmaf(p0[r], C2, mnL); for (int r = 0; r < 16; ++r) p1[r] = fmaf(p1[r], C2, mnL);
    for (int r = 0; r < 16; ++r) p0[r] = __builtin_amdgcn_exp2f(p0[r]);
}
__device__ __forceinline__ void finishSM(f32x16& p0, f32x16& p1, float alpha, float& l_reg, bf16x8& pa0, bf16x8& pa1, bf16x8& pa2, bf16x8& pa3) {
    for (int r = 0; r < 16; ++r) p1[r] = __builtin_amdgcn_exp2f(p1[r]);
    float ps = 0; for (int r = 0; r < 16; ++r) ps += p0[r]; for (int r = 0; r < 16; ++r) ps += p1[r];
    { auto rr = __builtin_amdgcn_permlane32_swap(__float_as_uint(ps), __float_as_uint(ps), false, false);
      ps = __uint_as_float(rr[0]) + __uint_as_float(rr[1]); }
    l_reg = l_reg * alpha + ps;
#define PK4(P, B_, OUT) do { unsigned a0 = cvt_pk_bf16(P[B_+0], P[B_+1]), a1 = cvt_pk_bf16(P[B_+2], P[B_+3]);                          \
        unsigned b0 = cvt_pk_bf16(P[B_+4], P[B_+5]), b1 = cvt_pk_bf16(P[B_+6], P[B_+7]);                                             \
        auto r0 = __builtin_amdgcn_permlane32_swap(a0, b0, false, false); auto r1 = __builtin_amdgcn_permlane32_swap(a1, b1, false, false); \
        u32x4 w = {r0[0], r1[0], r0[1], r1[1]}; OUT = *reinterpret_cast<bf16x8*>(&w); } while (0)
    PK4(p0, 0, pa0); PK4(p0, 8, pa1); PK4(p1, 0, pa2); PK4(p1, 8, pa3);
#undef PK4
}
template <int KB>
__device__ __forceinline__ void qkt(f32x16& p0, f32x16& p1, const char* K_lds, int r32, int hi, const bf16x8* qr) {
    p0 = f32x16{}; p1 = f32x16{};
    const char* kb[4];
#pragma unroll
    for (int dd = 0; dd < 4; ++dd) kb[dd] = K_lds + KB * SHM_K + KSWZ(r32, (dd * 16 + hi * 8) * 2);
#pragma unroll
    for (int d0 = 0; d0 < 8; ++d0) { const char* a = kb[d0 & 3] + (d0 >> 2) * 128;
        bf16x8 b0 = *reinterpret_cast<const bf16x8*>(a);
        bf16x8 b1 = *reinterpret_cast<const bf16x8*>(a + 32 * 256);
        p0 = __builtin_amdgcn_mfma_f32_32x32x16_bf16(b0, qr[d0], p0, 0, 0, 0);
        p1 = __builtin_amdgcn_mfma_f32_32x32x16_bf16(b1, qr[d0], p1, 0, 0, 0); }
}
template <int VB>
__device__ __forceinline__ void pv_tile(f32x16* o, int vb0, bf16x8 pa0, bf16x8 pa1, bf16x8 pa2, bf16x8 pa3) {
#define TRRD(dst, off) asm volatile("ds_read_b64_tr_b16 %0, %1 offset:%2" : "=&v"(dst) : "v"(vb0), "i"(off) : "memory")
#define PV_D0(d0) do { s16x4 l0, l1, l2, l3, h0, h1, h2, h3; constexpr int b_ = VB * SHM_V + v_rd_off(d0, 0, 0); \
        TRRD(l0, b_); TRRD(h0, b_ + 2048); TRRD(l1, b_ + 4096); TRRD(h1, b_ + 6144); TRRD(l2, b_ + 8192); TRRD(h2, b_ + 10240); TRRD(l3, b_ + 12288); TRRD(h3, b_ + 14336); \
        asm volatile("s_waitcnt lgkmcnt(0)" ::: "memory"); SBAR();   \
        o[d0] = __builtin_amdgcn_mfma_f32_32x32x16_bf16(pa0, (bf16x8){l0[0], l0[1], l0[2], l0[3], h0[0], h0[1], h0[2], h0[3]}, o[d0], 0, 0, 0);   \
        o[d0] = __builtin_amdgcn_mfma_f32_32x32x16_bf16(pa1, (bf16x8){l1[0], l1[1], l1[2], l1[3], h1[0], h1[1], h1[2], h1[3]}, o[d0], 0, 0, 0);   \
        o[d0] = __builtin_amdgcn_mfma_f32_32x32x16_bf16(pa2, (bf16x8){l2[0], l2[1], l2[2], l2[3], h2[0], h2[1], h2[2], h2[3]}, o[d0], 0, 0, 0);   \
        o[d0] = __builtin_amdgcn_mfma_f32_32x32x16_bf16(pa3, (bf16x8){l3[0], l3[1], l3[2], l3[3], h3[0], h3[1], h3[2], h3[3]}, o[d0], 0, 0, 0); } while (0)
    PV_D0(0); PV_D0(1); PV_D0(2); PV_D0(3);
#undef PV_D0
#undef TRRD
}

struct BlockRef { const bf16_t* Q; const bf16_t* K; const bf16_t* V; bf16_t* O; int P0; int mode; const unsigned long long* bm; const unsigned* selw; };
struct Seam { bf16x8 qr[8]; bf16x8 st_v0, st_v1, st_k0, st_k1; };
#define ROWK(p, k0, rr) ((p) + (size_t)((k0) + (rr)) * KP + sc)
#define VMW() asm volatile("s_waitcnt vmcnt(0)" ::: "memory")
#define VMWN(n) asm volatile("s_waitcnt vmcnt(%0)" :: "i"(n) : "memory")
#define SLOAD_H(Kp, Vp, k0) do { S.st_v0 = load8(ROWK(Vp, k0, sr)); S.st_v1 = load8(ROWK(Vp, k0, 32 + sr));              \
                         S.st_k0 = load8(ROWK(Kp, k0, sr)); S.st_k1 = load8(ROWK(Kp, k0, 32 + sr)); } while (0)
#define SWRITE_HK(bf) do { *(bf16x8*)(K_lds + (bf) * SHM_K + kws) = S.st_k0; *(bf16x8*)(K_lds + (bf) * SHM_K + kws + 32 * 256) = S.st_k1; } while (0)
#define SWRITE_HV(bf) do { *(bf16x8*)(V_lds + (bf) * SHM_V + vst0) = S.st_v0; *(bf16x8*)(V_lds + (bf) * SHM_V + vst1) = S.st_v1; } while (0)
#define SWRITE_H(bf) do { SWRITE_HV(bf); SWRITE_HK(bf); } while (0)
__device__ __forceinline__ void attn_prime(const BlockRef& cur, char* lds, Seam& S, const int wid) {
    const int lane = lane_id_v(), tid = wid * 64 + lane, r32 = lane & 31, hi = lane >> 5;
    const int sr = tid >> 4, sc = (tid & 15) * 8, kws = KSWZ(sr, sc * 2); char* K_lds = lds + 2 * SHM_V;
    for (int d0 = 0; d0 < 8; ++d0) S.qr[d0] = load8(cur.Q + (size_t)(wid * QBLK + r32) * QP + d0 * 16 + hi * 8);
    SLOAD_H(cur.K, cur.V, 0); VMW(); SWRITE_HK(0);
    __syncthreads();
}
__device__ __forceinline__ void attn_block(const BlockRef& cur, const BlockRef& nxt, char* lds, Seam& S, const int wid) {
    const int lane = lane_id_v(), tid = wid * 64 + lane, r32 = lane & 31, hi = lane >> 5;
    const int NT = cur.P0 / KVBLK + 4;
    const int qlo = cur.P0 + wid * QBLK, qm = qlo + r32 - 4 * hi;
    char* V_lds = lds; char* K_lds = lds + 2 * SHM_V;
    float* ws = (float*)(lds + 2 * SHM_V + 2 * SHM_K) + wid * 64; float* li_l = ws, * al_l = ws + 32;
    float m_reg = -1e30f, l_reg = 0; f32x16 o[4] = {};
    const int sr = tid >> 4, sc = (tid & 15) * 8, vst0 = v_st(sr, sc), vst1 = v_st(32 + sr, sc), kws = KSWZ(sr, sc * 2);
    const int vb0 = (int)(uintptr_t)V_lds + v_rd_base(lane);
    const bf16_t* Kh = cur.K; const bf16_t* Vh = cur.V;
    const int mode = cur.mode, own = cur.P0 >> 8;
    unsigned mlo = 0u, mhi = 0u;
    if (mode == 1) mlo = cur.selw[(size_t)(wid * QBLK + r32) * NHEAD];
#define RESC(a) do { if (__any((a) < 1.f)) { if (hi == 0) al_l[r32] = (a); asm volatile("s_waitcnt lgkmcnt(0)" ::: "memory");              \
                     for (int d_ = 0; d_ < 4; ++d_) for (int r = 0; r < 16; ++r) o[d_][r] *= al_l[crow(r, hi)]; } } while (0)
#define KBASE(t) ((t) * KVBLK)
#define MLOAD(t) do { if (mode == 0) { unsigned r_ = (unsigned)r32; asm volatile("" : "+v"(r_));   \
        const u32x2 w_ = *(const u32x2*)(cur.bm + ((unsigned)(wid * QBLK) + r_) * (unsigned)(SEQ / 64) + (unsigned)(t)); mlo = w_.x; mhi = w_.y; } } while (0)
#define MASKT(P0_, P1_, t) do { const int kb_ = KBASE(t); \
        if (mode == 0) { mask_bits(P0_, P1_, mlo, mhi, hi); } \
        else { const int n_ = (t) >> 2; if (n_ == own) { if (kb_ + KVBLK - 1 > qlo) mask_causal(P0_, P1_, qm - kb_); } else mask_all(P0_, P1_, ((mlo >> n_) & 1u) != 0u); } } while (0)
    f32x16 pA0, pA1, pB0, pB1; float mnA, mnB, alA, alB; bf16x8 pa0, pa1, pa2, pa3;
    SWRITE_HV(0); SBAR();
    MLOAD(0);
    if (NT > 1) { SLOAD_H(Kh, Vh, KBASE(1)); }
    SBAR(); qkt<0>(pA0, pA1, K_lds, r32, hi, S.qr);
    MASKT(pA0, pA1, 0); partialSM(pA0, pA1, m_reg, mnA, alA);
    if (NT > 1) { VMW(); SWRITE_H(1); }
    __syncthreads();
#define HALF_STEP(PX0, PX1, mnX, alX, PY0, PY1, alY, t, KB, VB, SB) do {                                                      \
        SBAR(); MLOAD(t); qkt<KB>(PX0, PX1, K_lds, r32, hi, S.qr);                                             \
        finishSM(PY0, PY1, alY, l_reg, pa0, pa1, pa2, pa3); SBAR();                                                           \
        if ((t) + 1 < NT) { SLOAD_H(Kh, Vh, KBASE((t) + 1)); SBAR(); }                                               \
        pv_tile<VB>(o, vb0, pa0, pa1, pa2, pa3); MASKT(PX0, PX1, (t)); partialSM(PX0, PX1, m_reg, mnX, alX);                                        \
        __syncthreads();                                                                                                      \
        if ((t) + 1 < NT) { VMW(); SWRITE_H(SB); }                                                                          \
        RESC(alX); __syncthreads(); } while (0)
    for (int t = 1; t + 1 < NT; t += 2) {
        HALF_STEP(pB0, pB1, mnB, alB, pA0, pA1, alA, t, 1, 0, 0);
        HALF_STEP(pA0, pA1, mnA, alA, pB0, pB1, alB, t + 1, 0, 1, 1);
    }
    SBAR(); MLOAD(NT - 1); qkt<1>(pB0, pB1, K_lds, r32, hi, S.qr); SBAR();
    SLOAD_H(nxt.K, nxt.V, 0); SBAR();
#pragma unroll
    for (int d0 = 0; d0 < 8; ++d0) S.qr[d0] = load8(nxt.Q + (size_t)(wid * QBLK + r32) * QP + d0 * 16 + hi * 8);
    SBAR();
    finishSM(pA0, pA1, alA, l_reg, pa0, pa1, pa2, pa3); SBAR();
    pv_tile<0>(o, vb0, pa0, pa1, pa2, pa3);
    MASKT(pB0, pB1, NT - 1); partialSM(pB0, pB1, m_reg, mnB, alB); __syncthreads(); RESC(alB);
    finishSM(pB0, pB1, alB, l_reg, pa0, pa1, pa2, pa3); SBAR(); pv_tile<1>(o, vb0, pa0, pa1, pa2, pa3);
    SBAR(); VMWN(8); SWRITE_HK(0); SBAR();
    if (hi == 0) li_l[r32] = l_reg; asm volatile("s_waitcnt lgkmcnt(0)" ::: "memory");
    float rli[16];
#pragma unroll
    for (int r = 0; r < 16; ++r) rli[r] = __builtin_amdgcn_rcpf(li_l[crow(r, hi)]);
    bf16_t* Ow = cur.O + (size_t)(wid * QBLK) * OP;
    int r32e = r32, hie = hi; asm volatile("" : "+v"(r32e), "+v"(hie));
#pragma unroll
    for (int r = 0; r < 16; ++r) { const int orow = crow(r, hie);
#pragma unroll
        for (int d0 = 0; d0 < 4; ++d0) { const float v = o[d0][r] * rli[r];
            const float vn = __shfl_xor(v, 1);
            if ((r32e & 1) == 0) *(unsigned*)(Ow + (unsigned)(orow * OP + d0 * 32 + r32e)) = cvt_pk_bf16(v, vn); } }
    __syncthreads();
#undef RESC
#undef KBASE
#undef MLOAD
#undef MASKT
#undef HALF_STEP
}
#undef ROWK
#undef VMW
#undef VMWN
#undef SLOAD_H
#undef SWRITE_HK
#undef SWRITE_HV
#undef SWRITE_H
}
constexpr size_t MiB = 1u << 20;
constexpr size_t WS_CTL = 0, CTL_ZERO_BYTES = 1 * MiB;
constexpr int CW_TMO = 0, CW_BAR = 4096, CW_CNT = 16384;
constexpr size_t CTL_KMEAN = 512 * 1024;
constexpr size_t WS_ROPEA = 1 * MiB, WS_ROPEI = 2 * MiB;
constexpr size_t WS_WIN = 3 * MiB;
constexpr size_t WS_WBR = 48 * MiB, WS_WOUT = 56 * MiB, WS_WPG = 64 * MiB, WS_WPP = 72 * MiB;
constexpr size_t WS_WGU = 73 * MiB, WS_WD = 585 * MiB;
constexpr size_t WS_H1 = 841 * MiB, WS_PB = 873 * MiB;
constexpr size_t WS_QKV7 = 877 * MiB;
constexpr size_t WS_SG = 989 * MiB;
constexpr size_t WS_KI = 1053 * MiB, WS_WI = 1054 * MiB;
constexpr size_t WS_PLEB = 1055 * MiB;
constexpr size_t WS_SC = 1087 * MiB;
constexpr size_t WS_BM = 1343 * MiB, WS_SELB = 1351 * MiB;
constexpr size_t WS_OAB = 1352 * MiB, WS_MERGED = 1384 * MiB;
constexpr size_t WS_X1 = 1416 * MiB, WS_H2U = 1480 * MiB, WS_RSTD = 1512 * MiB;
constexpr size_t WS_LIST = 1513 * MiB, WS_GATES = 1514 * MiB;
constexpr size_t WS_ACT = 1515 * MiB;
constexpr size_t WS_YS = 1675 * MiB;
constexpr size_t WS_X2 = 1803 * MiB, WS_X2B = 1867 * MiB;
constexpr size_t WS_T = 1899 * MiB, WS_TSS = 1963 * MiB;
constexpr size_t WS_RSL = 1964 * MiB, WS_GTL = 1965 * MiB;
constexpr size_t WS_END = 1966 * MiB;

constexpr int NWAVES = 8;
constexpr int RING_BYTES = 131072, MISC_OFF = RING_BYTES, LDS_BYTES = RING_BYTES + 1024;
static_assert(att::LDS_BYTES <= RING_BYTES && pg8::STAGE_BYTES <= RING_BYTES, "LDS map");

typedef GAS unsigned gu32;
#define RLX_AGENT __ATOMIC_RELAXED, __HIP_MEMORY_SCOPE_AGENT
#define LDS_WAIT() asm volatile("s_waitcnt lgkmcnt(0)" ::: "memory")
#define VM_WAIT() asm volatile("s_waitcnt vmcnt(0)" ::: "memory")

#define XB_TMO      128
#define XB_XCNT(j)  (256  + 64 * (j))
#define XB_XSUB(j)  (1280 + 64 * (j))
#define XB_XGEN(j)  (2304 + 64 * (j))
#define XB_TOP      3328
#define XB_TOPGEN   3392
#define XCD_BAR_WORDS 3456
#define XB_SPIN_CAP (1u << 20)
__device__ __forceinline__ unsigned xb_ld(unsigned* p)              { return __hip_atomic_load(p, __ATOMIC_RELAXED, __HIP_MEMORY_SCOPE_AGENT); }
__device__ __forceinline__ unsigned xb_add(unsigned* p, unsigned v) { return __hip_atomic_fetch_add(p, v, __ATOMIC_RELAXED, __HIP_MEMORY_SCOPE_AGENT); }
__device__ __forceinline__ unsigned xb_xcc_id() { return (unsigned)__builtin_amdgcn_s_getreg((3 << 11) | 20) & 0xFu; }
#define XB_SPIN(cond, bar) do { unsigned _sp = 0; while (cond) { __builtin_amdgcn_s_sleep(1); \
    if ((++_sp & 255u) == 0u) { if (xb_ld(&(bar)[XB_TMO])) break; if (_sp > XB_SPIN_CAP) { atomicAdd(&(bar)[XB_TMO], 1u); break; } } } } while (0)
struct XcdBarrier { unsigned* bar; unsigned x; volatile LAS unsigned* st; int wave; };
__device__ __forceinline__ XcdBarrier xcd_barrier_post(unsigned* bar, volatile LAS unsigned* st, int wave) {
    XcdBarrier b; b.bar = bar; b.x = xb_xcc_id(); b.st = st; b.wave = wave;
    if (wave == 0 && lane_id_v() == 0) (void)xb_add(&bar[XB_XCNT(b.x)], 1u);
    return b;
}
__device__ __forceinline__ void xcd_barrier_complete(unsigned* bar, unsigned x, unsigned& nloc, unsigned& nx) {
    const unsigned G = gridDim.x * gridDim.y * gridDim.z;
    unsigned sum, cnt, mine, sp = 0u;
    for (;;) {
        sum = 0u; cnt = 0u; mine = 0u;
#pragma unroll
        for (unsigned j = 0; j < 16; ++j) { const unsigned c = xb_ld(&bar[XB_XCNT(j)]); sum += c; cnt += (c > 0u) ? 1u : 0u; mine = (j == x) ? c : mine; }
        if (sum == G) break;
        __builtin_amdgcn_s_sleep(1);
        if ((++sp & 255u) == 0u) { if (xb_ld(&bar[XB_TMO])) break; if (sp > XB_SPIN_CAP) { atomicAdd(&bar[XB_TMO], 1u); break; } }
    }
    nloc = mine > 0u ? mine : 1u; nx = cnt > 0u ? cnt : 1u;
}
__device__ __forceinline__ void xcd_barrier(const XcdBarrier& b) {
    asm volatile("s_waitcnt vmcnt(0)" ::: "memory");
    __syncthreads();
    if (b.wave == 0 && lane_id_v() == 0) {
        unsigned* bar = b.bar;
        __builtin_amdgcn_s_waitcnt(0);
        unsigned nloc = b.st[0], nx = b.st[1];
        if (nloc == 0u) { xcd_barrier_complete(bar, b.x, nloc, nx); b.st[0] = nloc; b.st[1] = nx; }
        const unsigned old = xb_add(&bar[XB_XSUB(b.x)], 1u);
        const unsigned gen = old / nloc;
        if (old + 1u == (gen + 1u) * nloc) {
            __builtin_amdgcn_fence(__ATOMIC_RELEASE, "agent");
            asm volatile("s_waitcnt vmcnt(0)" ::: "memory");
            const unsigned og = xb_add(&bar[XB_TOP], 1u);
            const unsigned tg = og / nx;
            if (og + 1u == (tg + 1u) * nx) xb_add(&bar[XB_TOPGEN], 1u);
            else XB_SPIN(xb_ld(&bar[XB_TOPGEN]) == tg, bar);
            __builtin_amdgcn_fence(__ATOMIC_ACQUIRE, "agent");
            xb_add(&bar[XB_XGEN(b.x)], 1u);
            asm volatile("s_waitcnt vmcnt(0)" ::: "memory");
        } else {
            XB_SPIN(xb_ld(&bar[XB_XGEN(b.x)]) == gen, bar);
            __builtin_amdgcn_fence(__ATOMIC_ACQUIRE, "agent");
            asm volatile("s_waitcnt vmcnt(0)" ::: "memory");
        }
    }
    __syncthreads();
}

__device__ __forceinline__ float wave_sum(float v) {
#pragma unroll
    for (int o = 1; o < 64; o <<= 1) v += __shfl_xor(v, o);
    return v;
}
__device__ __forceinline__ unsigned f2bf(float f) { unsigned u = __float_as_uint(f); return (u + 0x7fffu + ((u >> 16) & 1u)) >> 16; }
__device__ __forceinline__ unsigned pk2(float lo, float hi) { return f2bf(lo) | (f2bf(hi) << 16); }

struct MapId { __device__ __forceinline__ int operator()(int n) const { return n; } };
struct MapIn { __device__ __forceinline__ int operator()(int s) const {
    if (s < 4096) return s; if (s >= 4176) return s - 80;
    if (s < 4160) { const int j = s - 4096; return 11264 + (j < 32 ? j : 128 + (j - 32)); }
    return 11264 + 32 + (s - 4160); } };
struct MapGu { __device__ __forceinline__ int operator()(int s) const { return (s & ~255) + ((s & 1) << 7) + ((s & 255) >> 1); } };
constexpr int CV_PITCH = 128, CV_SCR = 12288;
struct P0Item { const float* W; int N; bf16_t* WT; int dpitch, koff, k0, n0, map; };
__device__ __forceinline__ void p0_item_load(const P0Item& it, int lane, f32x4 (&v)[16]) {
    int col = it.n0 + (lane & 15) * 4; if (col > it.N - 4) col = it.N - 4;
    const float* src = it.W + (size_t)(it.k0 + 2 * (lane >> 4)) * it.N + col;
#pragma unroll
    for (int i = 0; i < 8; ++i) { v[2 * i] = *(const f32x4*)(src + (size_t)(8 * i) * it.N); v[2 * i + 1] = *(const f32x4*)(src + (size_t)(8 * i + 1) * it.N); }
}
__device__ __forceinline__ void p0_item_finish(const P0Item& it, LAS unsigned char* scr, int lane, const f32x4 (&v)[16]) {
    const int nq = lane & 15, q = lane >> 4;
    LAS unsigned char* wb = scr + nq * 512 + 4 * q;
#pragma unroll
    for (int i = 0; i < 8; ++i) { LAS unsigned char* wp = wb + ((i ^ (nq & 7)) << 4);
#pragma unroll
        for (int e = 0; e < 4; ++e) *(LAS unsigned*)(wp + e * 128) = cvt_pk_bf16(v[2 * i][e], v[2 * i + 1][e]); }
    LDS_WAIT(); asm volatile("" ::: "memory");
    const int ar = lane >> 3, kc = lane & 7;
    bf16x8 pc[8];
#pragma unroll
    for (int s8 = 0; s8 < 8; ++s8) pc[s8] = *(const LAS bf16x8*)(scr + (8 * s8 + ar) * 128 + ((kc ^ ((2 * s8 + (ar >> 2)) & 7)) << 4));
    LDS_WAIT(); asm volatile("" ::: "memory");
#pragma unroll
    for (int s8 = 0; s8 < 8; ++s8) { const int sn = it.n0 + 8 * s8 + ar;
        const int dr = (it.map == 0 || it.map == 3) ? MapId()(sn) : (it.map == 1 ? MapIn()(sn) : MapGu()(sn));
        bf16_t* dst = (it.map >= 2) ? it.WT + ((size_t)(dr >> 6) * (it.dpitch >> 6) + (it.k0 >> 6)) * 4096 + (dr & 63) * 64
                                     : it.WT + (size_t)dr * it.dpitch + it.koff + it.k0;
        if (sn < it.N) *(bf16x8*)(dst + 8 * kc) = pc[s8]; }
}
struct Args { const float* in[20]; float* out; unsigned char* ws; int ph_lo, ph_hi; };
enum { IN_X = 0, IN_P, IN_GMIX, IN_WIN, IN_GIDX, IN_BIDX, IN_WBRA, IN_WBRB, IN_WOUT, IN_GFFN, IN_WROUTER, IN_BROUTER, IN_WGU, IN_BGU, IN_WDOWN, IN_BDOWN, IN_WPP, IN_WPG, IN_GPLE, IN_GFINAL };

constexpr int NB_IN = (INW + 63) / 64;
constexpr int CI_IN = 32 * NB_IN, CI_BR = 16 * 32, CI_SQ = 32 * 32, CI_PP = 4 * 32, CI_GU1 = 32 * 64, CI_D1 = 32 * 32;
constexpr int CD0 = CI_IN, CD1 = CD0 + CI_BR, CD2 = CD1 + CI_BR, CD3 = CD2 + CI_SQ, CD4 = CD3 + CI_SQ, CD5 = CD4 + CI_PP;
constexpr int CE_GU = NEXP * CI_GU1, CE_ALL = CE_GU + NEXP * CI_D1;
__device__ __forceinline__ P0Item p0_dense_item(const Args& a, int it) {
    unsigned char* ws = a.ws;
    if (it < CD0) return P0Item{a.in[IN_WIN], INW, (bf16_t*)(ws + WS_WIN), DM, 0, 64 * (it / NB_IN), 64 * (it % NB_IN), 1};
    if (it < CD1) { const int r = it - CD0; return P0Item{a.in[IN_WBRA], DM, (bf16_t*)(ws + WS_WBR), DM, 0, 64 * (r / 32), 64 * (r % 32), 0}; }
    if (it < CD2) { const int r = it - CD1; return P0Item{a.in[IN_WBRB], DM, (bf16_t*)(ws + WS_WBR), DM, BRW, 64 * (r / 32), 64 * (r % 32), 0}; }
    if (it < CD3) { const int r = it - CD2; return P0Item{a.in[IN_WOUT], DM, (bf16_t*)(ws + WS_WOUT), DM, 0, 64 * (r / 32), 64 * (r % 32), 0}; }
    if (it < CD4) { const int r = it - CD3; return P0Item{a.in[IN_WPG], DM, (bf16_t*)(ws + WS_WPG), DM, 0, 64 * (r / 32), 64 * (r % 32), 0}; }
    { const int r = it - CD4; return P0Item{a.in[IN_WPP], DM, (bf16_t*)(ws + WS_WPP), PLED, 0, 64 * (r / 32), 64 * (r % 32), 0}; }
}
__device__ __forceinline__ P0Item p0_expert_item(const Args& a, int it) {
    unsigned char* ws = a.ws;
    if (it < CE_GU) { const int e = it / CI_GU1, r = it % CI_GU1; return P0Item{a.in[IN_WGU] + (size_t)e * DM * (2 * DFF), 2 * DFF, (bf16_t*)(ws + WS_WGU) + (size_t)e * (2 * DFF) * DM, DM, 0, 64 * (r / 64), 64 * (r % 64), 2}; }
    { const int r2 = it - CE_GU, e = r2 / CI_D1, r = r2 % CI_D1; return P0Item{a.in[IN_WDOWN] + (size_t)e * DFF * DM, DM, (bf16_t*)(ws + WS_WD) + (size_t)e * DM * DFF, DFF, 0, 64 * (r / 32), 64 * (r % 32), 3}; }
}
template <int EXPERT>
__device__ __forceinline__ void p0_convert_strided(const Args& a, LAS unsigned char* scr, int lane, int first, int stride, int n_items) {
    if (first >= n_items) return;
    P0Item cur = EXPERT ? p0_expert_item(a, first) : p0_dense_item(a, first), nxt = cur; f32x4 va[16], vb[16];
    p0_item_load(cur, lane, va);
    for (int it = first; it < n_items; it += 2 * stride) {
        const bool h1 = it + stride < n_items;
        if (h1) { nxt = EXPERT ? p0_expert_item(a, it + stride) : p0_dense_item(a, it + stride); p0_item_load(nxt, lane, vb); }
        p0_item_finish(cur, scr, lane, va);
        if (!h1) break;
        const bool h2 = it + 2 * stride < n_items;
        if (h2) { cur = EXPERT ? p0_expert_item(a, it + 2 * stride) : p0_dense_item(a, it + 2 * stride); p0_item_load(cur, lane, va); }
        p0_item_finish(nxt, scr, lane, vb);
        if (!h2) break;
    }
}
__device__ __forceinline__ void p0_prologue(const Args& a, LAS unsigned char* lds, int c, int G, int wave, int lane) {
    unsigned char* ws = a.ws;
    LAS unsigned char* scr = lds + wave * CV_SCR;
    const int gw = c * NWAVES + wave, NGW = G * NWAVES;
    p0_convert_strided<0>(a, scr, lane, gw, NGW, CD5);
    { const float* X = a.in[IN_X]; const f32x4* g4 = (const f32x4*)a.in[IN_GMIX]; bf16_t* H1 = (bf16_t*)(ws + WS_H1);
      for (int m = gw; m < SEQ; m += NGW) { const f32x4* xr = (const f32x4*)(X + (size_t)m * DM) + lane; f32x4 v[8]; float s = 0.f;
#pragma unroll
          for (int j = 0; j < 8; ++j) { v[j] = xr[64 * j]; s += (v[j].x * v[j].x + v[j].y * v[j].y) + (v[j].z * v[j].z + v[j].w * v[j].w); }
          const float rstd = rsqrtf(wave_sum(s) * (1.f / DM) + EPS);
          unsigned long long* o8 = (unsigned long long*)(H1 + (size_t)m * DM) + lane;
#pragma unroll
          for (int j = 0; j < 8; ++j) { const f32x4 g = g4[lane + 64 * j];
              o8[64 * j] = (unsigned long long)pk2(v[j].x * rstd * g.x, v[j].y * rstd * g.y) | ((unsigned long long)pk2(v[j].z * rstd * g.z, v[j].w * rstd * g.w) << 32); } } }
    { const f32x4* P4 = (const f32x4*)a.in[IN_P]; unsigned long long* o8 = (unsigned long long*)(ws + WS_PB);
      for (int i = gw * 64 + lane; i < SEQ * PLED / 4; i += NGW * 64) { const f32x4 v = P4[i]; o8[i] = (unsigned long long)pk2(v.x, v.y) | ((unsigned long long)pk2(v.z, v.w) << 32); } }
    { float* RA = (float*)(ws + WS_ROPEA); float* RI = (float*)(ws + WS_ROPEI);
      for (int i = gw * 64 + lane; i < SEQ * 24; i += NGW * 64) { const int pos = i / 24, j = i % 24;
          const double ex = (j < 16) ? (double)j / 16.0 : (double)(j - 16) / 8.0;
          const float inv = (float)(1.0 / pow(500000.0, ex)); const float ang = (float)pos * inv;
          const float cv = (float)cos((double)ang), sv = (float)sin((double)ang);
          if (j < 16) { RA[((size_t)pos * 16 + j) * 2] = cv; RA[((size_t)pos * 16 + j) * 2 + 1] = sv; } else { RI[((size_t)pos * 8 + (j - 16)) * 2] = cv; RI[((size_t)pos * 8 + (j - 16)) * 2 + 1] = sv; } } }
}

__device__ __forceinline__ int cv_ticket(volatile LAS unsigned* ctr, int lane) {
    unsigned t = 0; if (lane == 0) t = __hip_atomic_fetch_add((LAS unsigned*)ctr, 1u, __ATOMIC_RELAXED, __HIP_MEMORY_SCOPE_WORKGROUP);
    return (int)__builtin_amdgcn_readfirstlane(t);
}
__device__ __forceinline__ void p2_convert_experts(const Args& a, LAS unsigned char* scr, volatile LAS unsigned* ctr, int c, int G, int lane, volatile LAS unsigned* flag, unsigned stop_at) {
    const int n_cu = (CE_ALL - c + G - 1) / G;
    const bool adj = (CE_ALL % (6 * G)) == 0;
#define CV_ITEM(j) (adj ? ((tk / 6) * G + c) * 6 + (j) : (tk + (j)) * G + c)
    for (;;) {
        if (stop_at != 0xffffffffu && (unsigned)__builtin_amdgcn_readfirstlane((int)*flag) >= stop_at) return;
        unsigned t0 = 0; if (lane == 0) t0 = __hip_atomic_fetch_add((LAS unsigned*)ctr, 6u, __ATOMIC_RELAXED, __HIP_MEMORY_SCOPE_WORKGROUP);
        const int tk = (int)__builtin_amdgcn_readfirstlane(t0);
        if (tk >= n_cu) return;
        if (tk + 6 <= n_cu) {
            f32x4 va[16], vb[16], vc[16];
            const P0Item i0 = p0_expert_item(a, CV_ITEM(0)), i1 = p0_expert_item(a, CV_ITEM(1)), i2 = p0_expert_item(a, CV_ITEM(2));
            p0_item_load(i0, lane, va); p0_item_load(i1, lane, vb); p0_item_load(i2, lane, vc);
            p0_item_finish(i0, scr, lane, va);
            const P0Item i3 = p0_expert_item(a, CV_ITEM(3)); p0_item_load(i3, lane, va);
            p0_item_finish(i1, scr, lane, vb);
            const P0Item i4 = p0_expert_item(a, CV_ITEM(4)); p0_item_load(i4, lane, vb);
            p0_item_finish(i2, scr, lane, vc);
            const P0Item i5 = p0_expert_item(a, CV_ITEM(5)); p0_item_load(i5, lane, vc);
            p0_item_finish(i3, scr, lane, va); p0_item_finish(i4, scr, lane, vb); p0_item_finish(i5, scr, lane, vc);
        } else {
            for (int k = tk; k < n_cu; ++k) { f32x4 v[16]; const P0Item it = p0_expert_item(a, k * G + c); p0_item_load(it, lane, v); p0_item_finish(it, scr, lane, v); }
        }
    }
#undef CV_ITEM
}
#ifndef REPEAT_MASK
#define REPEAT_MASK 0
#endif
#define P2_NREP(k) ((((REPEAT_MASK) >> (k)) & 1) ? 2 : 1)
#ifndef P2_NIDX
#define P2_NIDX 4
#endif
__device__ __forceinline__ unsigned f2ord(float f) { unsigned b = __float_as_uint(f); if ((b << 1) == 0u) b = 0u; return b ^ ((b >> 31) ? 0xffffffffu : 0x80000000u); }
__device__ __forceinline__ void idx_scores(const Args& a, int q0, int lane_in) {
    unsigned char* ws = a.ws;
    const bf16_t* QI = (const bf16_t*)(ws + WS_QKV7) + (size_t)3 * SEQ * BRW; const bf16_t* KI = (const bf16_t*)(ws + WS_KI); const float* WI = (const float*)(ws + WS_WI);
    float* SC = (float*)(ws + WS_SC);
    int lane = lane_in; asm volatile("" : "+v"(lane));
    const int r = lane & 31, hh = lane >> 5;
    {
        bf16x8 af[2][4]; float wreg[2][16];
#pragma unroll
        for (int t2 = 0; t2 < 2; ++t2) { const int qa = q0 + 2 * t2 + (r >> 4);
#pragma unroll
            for (int s = 0; s < 4; ++s) af[t2][s] = *(const bf16x8*)(QI + (size_t)qa * BRW + (r & 15) * IDXD + 16 * s + 8 * hh);
#pragma unroll
            for (int i = 0; i < 16; ++i) { const int row = (i & 3) + 8 * (i >> 2) + 4 * hh; wreg[t2][i] = WI[(size_t)(q0 + 2 * t2 + (row >> 4)) * IDXH + (row & 15)]; } }
        const int ntile = ((q0 + 3) >> 5) + 1;
#define IDX_LOADB(dst, tile) do { const int tl_ = (tile) < 256 ? (tile) : 255; _Pragma("unroll") for (int s = 0; s < 4; ++s) dst[s] = *(const bf16x8*)(KI + (size_t)(32 * tl_ + r) * IDXD + 16 * s + 8 * hh); } while (0)
#define IDX_TILE(bc, jt_) do { _Pragma("unroll") for (int t2 = 0; t2 < 2; ++t2) { \
            f32x16 ac = {}; \
            _Pragma("unroll") for (int s = 0; s < 4; ++s) ac = __builtin_amdgcn_mfma_f32_32x32x16_bf16(af[t2][s], bc[s], ac, 0, 0, 0); \
            float s0 = 0.f, s1 = 0.f; \
            _Pragma("unroll") for (int i = 0; i < 8; ++i) { s0 += wreg[t2][i] * __builtin_amdgcn_fmed3f(ac[i], 0.f, 3.0e38f); s1 += wreg[t2][8 + i] * __builtin_amdgcn_fmed3f(ac[8 + i], 0.f, 3.0e38f); }     \
            const float send = hh ? s0 : s1, keep = hh ? s1 : s0; \
            const float tot = keep + __shfl_xor(send, 32); \
            SC[(size_t)(q0 + 2 * t2 + hh) * SEQ + 32 * (jt_) + r] = tot; } } while (0)
        bf16x8 b0[4], b1[4], b2[4], b3[4];
        IDX_LOADB(b0, 0); IDX_LOADB(b1, 1); IDX_LOADB(b2, 2); IDX_LOADB(b3, 3);
        for (int jt = 0; jt < ntile; jt += 4) {
            { bf16x8 bc[4]; _Pragma("unroll") for (int s = 0; s < 4; ++s) bc[s] = b0[s]; IDX_LOADB(b0, jt + 4); IDX_TILE(bc, jt); }
            if (jt + 1 < ntile) { bf16x8 bc[4]; _Pragma("unroll") for (int s = 0; s < 4; ++s) bc[s] = b1[s]; IDX_LOADB(b1, jt + 5); IDX_TILE(bc, jt + 1); }
            if (jt + 2 < ntile) { bf16x8 bc[4]; _Pragma("unroll") for (int s = 0; s < 4; ++s) bc[s] = b2[s]; IDX_LOADB(b2, jt + 6); IDX_TILE(bc, jt + 2); }
            if (jt + 3 < ntile) { bf16x8 bc[4]; _Pragma("unroll") for (int s = 0; s < 4; ++s) bc[s] = b3[s]; IDX_LOADB(b3, jt + 7); IDX_TILE(bc, jt + 3); }
        }
#undef IDX_LOADB
#undef IDX_TILE
    }
}
__device__ __forceinline__ void idx_select_rows(const Args& a, int q0, int nrows, int lane_in) {
    unsigned char* ws = a.ws;
    float* SC = (float*)(ws + WS_SC); unsigned long long* BM = (unsigned long long*)(ws + WS_BM);
    int lane = lane_in;
    {
        for (int qq = 0; qq < nrows; ++qq) {
            asm volatile("" : "+v"(lane));
            const int t = q0 + qq;
            unsigned long long* brow = BM + (size_t)t * (SEQ / 64);
            if (t < DSA_TOPK) {
#pragma unroll
                for (int w2 = 0; w2 < 2; ++w2) { const int j = lane + 64 * w2, lo = 64 * j;
                    brow[j] = (t >= lo + 63) ? ~0ull : (t < lo ? 0ull : ((2ull << (t - lo)) - 1ull)); }
                continue;
            }
            const int nj = (t >> 6) + 1;
            unsigned u[128];
            const float* srow = SC + (size_t)t * SEQ;
#pragma unroll
            for (int ch = 0; ch < 8; ++ch) {
                const float* cb = (ch * 16 < nj) ? srow : srow - 1024 * ch;
#pragma unroll
                for (int jj = 0; jj < 16; ++jj) { const int j = ch * 16 + jj;
                    u[j] = __float_as_uint(__builtin_nontemporal_load(cb + lane + 64 * j)); }
            }
#pragma unroll
            for (int ch = 0; ch < 8; ++ch) {
                if (ch * 16 < nj) {
#pragma unroll
                    for (int jj = 0; jj < 16; ++jj) { const int j = ch * 16 + jj, key = 64 * j + lane; const int neg = (t - key) >> 31;
                        u[j] = f2ord(__uint_as_float(u[j])) & ~(unsigned)neg; }
                } else {
#pragma unroll
                    for (int jj = 0; jj < 16; ++jj) u[ch * 16 + jj] = 0u;
                }
            }
            unsigned T = 0u; int Ti = 0; bool exact = false;
            for (int b = 31; b >= 0; --b) {
                const unsigned Tc = T | (1u << b); int cnt = 0;
#pragma unroll
                for (int ch = 0; ch < 8; ++ch) {
                    if (ch * 16 < nj) {
#pragma unroll
                        for (int jj = 0; jj < 16; ++jj) { cnt += __popcll(__ballot(u[ch * 16 + jj] >= Tc)); if ((jj & 3) == 3) __builtin_amdgcn_sched_barrier(0); }
                    }
                }
                if (cnt >= DSA_TOPK) T = Tc;
                if (cnt == DSA_TOPK) { exact = true; break; }
            }
            if (!exact) {
                for (int b = 12; b >= 0; --b) {
                    const int Tic = Ti | (1 << b); int cnt = 0; unsigned Tl = T; asm volatile("" : "+s"(Tl));
#pragma unroll
                    for (int ch = 0; ch < 8; ++ch) {
                        if (ch * 16 < nj) {
#pragma unroll
                            for (int jj = 0; jj < 16; ++jj) { const int j = ch * 16 + jj;
                                cnt += __popcll(__ballot((u[j] > Tl) || (u[j] == Tl && lane <= (SEQ - 1 - 64 * j) - Tic))); if ((jj & 3) == 3) __builtin_amdgcn_sched_barrier(0); }
                        }
                    }
                    if (cnt >= DSA_TOPK) Ti = Tic;
                    if (cnt == DSA_TOPK) break;
                }
            }
            int w0l = 0, w0h = 0, w1l = 0, w1h = 0; asm volatile("" : "+s"(T), "+s"(Ti));
#pragma unroll
            for (int ch = 0; ch < 8; ++ch) {
                if (ch * 16 < nj) {
#pragma unroll
                    for (int jj = 0; jj < 16; ++jj) { const int j = ch * 16 + jj;
                        const unsigned long long word = __ballot((u[j] > T) || (u[j] == T && lane <= (SEQ - 1 - 64 * j) - Ti));
                        const int lo = (int)(unsigned)word, hi = (int)(unsigned)(word >> 32);
                        if (j < 64) { w0l = (lane == (j & 63)) ? lo : w0l; w0h = (lane == (j & 63)) ? hi : w0h; }
                        else { w1l = (lane == (j & 63)) ? lo : w1l; w1h = (lane == (j & 63)) ? hi : w1h; }
                        if ((jj & 3) == 3) __builtin_amdgcn_sched_barrier(0); }
                }
            }
            brow[lane] = ((unsigned long long)(unsigned)w0h << 32) | (unsigned)w0l;
            brow[64 + lane] = ((unsigned long long)(unsigned)w1h << 32) | (unsigned)w1l;
        }
    }
}
__device__ __forceinline__ void p2_indexer_and_convert(const Args& a, LAS unsigned char* lds, volatile LAS unsigned* MISC, int c, int G, int wave, int lane) {
    const int w = wave & 3; volatile LAS unsigned* flag = MISC + 24 + w; volatile LAS unsigned* ctr = MISC + 16;
    LAS unsigned char* scr = lds + wave * CV_SCR;
    if (wave < 4) {
        for (int p = c; p < 256; p += G) {
            const int qh = (511 - p) * 16 + w * 4, ql = p * 16 + w * 4;
            for (int rep_s = 0; rep_s < P2_NREP(12); ++rep_s) { idx_scores(a, qh, lane); idx_scores(a, ql, lane); }
        }
        VM_WAIT();
    }
    p2_convert_experts(a, scr, ctr, c, G, lane, flag, 0xffffffffu);
    __syncthreads();
    for (int p = c; p < 256; p += G) {
        for (int rep_q = 0; rep_q < P2_NREP(13); ++rep_q) { idx_select_rows(a, p * 16 + 2 * wave, 2, lane); idx_select_rows(a, (511 - p) * 16 + 2 * wave, 2, lane); }
    }
}
__device__ __forceinline__ void p2_moba_gate(const Args& a, LAS unsigned char* lds, int c, int G, int wave, int lane) {
    unsigned char* ws = a.ws;
    const bf16_t* QBp = (const bf16_t*)(ws + WS_QKV7) + (size_t)4 * SEQ * BRW; const float* KM = (const float*)(ws + WS_CTL + CTL_KMEAN); unsigned* SELB = (unsigned*)(ws + WS_SELB);
    const int r = lane & 31, hh = lane >> 5;
    LAS float* scr = (LAS float*)(lds + wave * 4352);
    for (int base = c * 256; base < SEQ * NHEAD; base += G * 256) {
        const int h = base >> 13, t0 = (base & (SEQ - 1)) + 32 * wave, own = t0 >> 8;
        if (own > 0) {
            f32x16 acc = {};
#pragma unroll
            for (int s8 = 0; s8 < 8; ++s8) {
                const bf16x8 af = *(const bf16x8*)(QBp + (size_t)(t0 + r) * BRW + h * HD + 16 * s8 + 8 * hh);
                const f32x4 k0 = *(const f32x4*)(KM + (size_t)r * BRW + h * HD + 16 * s8 + 8 * hh), k1 = *(const f32x4*)(KM + (size_t)r * BRW + h * HD + 16 * s8 + 8 * hh + 4);
                float kv[8];
#pragma unroll
                for (int i = 0; i < 4; ++i) { kv[i] = k0[i] * (1.f / MOBA_BLK); kv[4 + i] = k1[i] * (1.f / MOBA_BLK); }
                unsigned bh[4], bl[4];
#pragma unroll
                for (int i = 0; i < 4; ++i) { bh[i] = cvt_pk_bf16(kv[2 * i], kv[2 * i + 1]); bl[i] = cvt_pk_bf16(kv[2 * i] - bf_lo(bh[i]), kv[2 * i + 1] - bf_hi(bh[i])); }
                u32x4 BH = {bh[0], bh[1], bh[2], bh[3]}, BL = {bl[0], bl[1], bl[2], bl[3]};
                acc = __builtin_amdgcn_mfma_f32_32x32x16_bf16(af, *(bf16x8*)&BH, acc, 0, 0, 0);
                acc = __builtin_amdgcn_mfma_f32_32x32x16_bf16(af, *(bf16x8*)&BL, acc, 0, 0, 0);
            }
#pragma unroll
            for (int i = 0; i < 16; ++i) scr[((i & 3) + 8 * (i >> 2) + 4 * hh) * 33 + r] = acc[i];
            LDS_WAIT(); asm volatile("" ::: "memory");
            float v[32];
#pragma unroll
            for (int m = 0; m < 32; ++m) v[m] = scr[r * 33 + m];
            unsigned selw = 0u;
#pragma unroll
            for (int rd = 0; rd < 3; ++rd) { float best = -__builtin_inff(); int bi = -1;
#pragma unroll
                for (int m = 0; m < 32; ++m) { if (m < own && v[m] > best) { best = v[m]; bi = m; } }
                if (bi >= 0) selw |= 1u << bi;
#pragma unroll
                for (int m = 0; m < 32; ++m) v[m] = (m == bi) ? -__builtin_inff() : v[m]; }
            if (lane < 32) SELB[(size_t)(t0 + r) * NHEAD + h] = selw;
            LDS_WAIT(); asm volatile("" ::: "memory");
        } else { if (lane < 32) SELB[(size_t)(t0 + r) * NHEAD + h] = 0u; }
    }
}

__device__ __forceinline__ void p6_route(const Args& a, LAS unsigned char* lds, int c, int G, int wave, int lane) {
    unsigned char* ws = a.ws;
    const float* X1 = (const float*)(ws + WS_X1); const float* gf = a.in[IN_GFFN]; const float* WR = a.in[IN_WROUTER]; const float* BR = a.in[IN_BROUTER];
    bf16_t* H2U = (bf16_t*)(ws + WS_H2U); float* RSTD = (float*)(ws + WS_RSTD); int* LIST = (int*)(ws + WS_LIST); float* GATES = (float*)(ws + WS_GATES);
    float* RSL = (float*)(ws + WS_RSL); float* GTL = (float*)(ws + WS_GTL);
    unsigned* CNT = (unsigned*)(ws + WS_CTL) + CW_CNT;
    LAS float* part = (LAS float*)lds;
    LAS float* ssp = (LAS float*)(lds + 32768);
    LAS int* hist = (LAS int*)(lds + 32768 + 2048);
    LAS int* hbase = hist + 32;
    const int r = lane & 31, hh = lane >> 5;
    for (int un = c; un < SEQ / 32; un += G) {
        const int t0 = un * 32;
        f32x16 acc = {}; float ss = 0.f;
        const int kbase = wave * 256;
        for (int ks = 0; ks < 16; ++ks) {
            const int k0 = kbase + ks * 16 + 8 * hh;
            const f32x4 xa = *(const f32x4*)(X1 + (size_t)(t0 + r) * DM + k0), xb = *(const f32x4*)(X1 + (size_t)(t0 + r) * DM + k0 + 4);
            const f32x4 ga = *(const f32x4*)(gf + k0), gb = *(const f32x4*)(gf + k0 + 4);
            float av[8], bv[8];
#pragma unroll
            for (int i = 0; i < 4; ++i) { ss += xa[i] * xa[i] + xb[i] * xb[i]; av[i] = xa[i] * ga[i]; av[4 + i] = xb[i] * gb[i]; }
#pragma unroll
            for (int i = 0; i < 8; ++i) bv[i] = WR[(size_t)(k0 + i) * NEXP + r];
            unsigned ahi[4], alo[4], bhi[4], blo[4];
#pragma unroll
            for (int i = 0; i < 4; ++i) { ahi[i] = cvt_pk_bf16(av[2 * i], av[2 * i + 1]); alo[i] = cvt_pk_bf16(av[2 * i] - bf_lo(ahi[i]), av[2 * i + 1] - bf_hi(ahi[i]));
                                          bhi[i] = cvt_pk_bf16(bv[2 * i], bv[2 * i + 1]); blo[i] = cvt_pk_bf16(bv[2 * i] - bf_lo(bhi[i]), bv[2 * i + 1] - bf_hi(bhi[i])); }
            u32x4 AH = {ahi[0], ahi[1], ahi[2], ahi[3]}, AL = {alo[0], alo[1], alo[2], alo[3]}, BH = {bhi[0], bhi[1], bhi[2], bhi[3]}, BL = {blo[0], blo[1], blo[2], blo[3]};
            *(u32x4*)(H2U + (size_t)(t0 + r) * DM + k0) = AH;
            acc = __builtin_amdgcn_mfma_f32_32x32x16_bf16(*(bf16x8*)&AH, *(bf16x8*)&BH, acc, 0, 0, 0);
            acc = __builtin_amdgcn_mfma_f32_32x32x16_bf16(*(bf16x8*)&AH, *(bf16x8*)&BL, acc, 0, 0, 0);
            acc = __builtin_amdgcn_mfma_f32_32x32x16_bf16(*(bf16x8*)&AL, *(bf16x8*)&BH, acc, 0, 0, 0);
        }
#pragma unroll
        for (int i = 0; i < 16; ++i) part[(wave * 32 + (i & 3) + 8 * (i >> 2) + 4 * hh) * 32 + r] = acc[i];
        ssp[(wave * 32 + r) * 2 + hh] = ss;
        const bool w0 = (wave == 0) && (lane < 32);
        if (w0) hist[lane] = 0;
        __syncthreads();
        int ek[4]; int pl[4]; float gk[4]; float rstd = 0.f;
        if (w0) {
            const int tk = lane; float lg[32]; float s2 = 0.f;
#pragma unroll
            for (int w = 0; w < 8; ++w) s2 += ssp[(w * 32 + tk) * 2] + ssp[(w * 32 + tk) * 2 + 1];
            rstd = rsqrtf(s2 * (1.f / DM) + EPS);
#pragma unroll
            for (int e = 0; e < 32; ++e) { float s = 0.f;
#pragma unroll
                for (int w = 0; w < 8; ++w) s += part[(w * 32 + tk) * 32 + e];
                lg[e] = s * rstd + BR[e]; }
            float tv[4];
#pragma unroll
            for (int k = 0; k < 4; ++k) { float best = -__builtin_inff(); int bi = 0;
#pragma unroll
                for (int e = 0; e < 32; ++e) { if (lg[e] > best) { best = lg[e]; bi = e; } }
                tv[k] = best; ek[k] = bi;
#pragma unroll
                for (int e = 0; e < 32; ++e) lg[e] = (e == bi) ? -__builtin_inff() : lg[e]; }
            float den = 0.f;
#pragma unroll
            for (int k = 0; k < 4; ++k) { gk[k] = __expf(tv[k] - tv[0]); den += gk[k]; }
            const float rden = 1.f / den;
#pragma unroll
            for (int k = 0; k < 4; ++k) { gk[k] *= rden; pl[k] = __hip_atomic_fetch_add(&hist[ek[k]], 1, __ATOMIC_RELAXED, __HIP_MEMORY_SCOPE_WORKGROUP); }
        }
        __syncthreads();
        if (w0) { const int hc = hist[lane]; hbase[lane] = hc > 0 ? (int)atomicAdd(&CNT[lane], (unsigned)hc) : 0; }
        __syncthreads();
        if (w0) { const int tok = t0 + lane; RSTD[tok] = rstd;
#pragma unroll
            for (int k = 0; k < 4; ++k) { const int pos = hbase[ek[k]] + pl[k]; if (pos < SEQ) { LIST[(size_t)ek[k] * SEQ + pos] = tok * 4 + k; RSL[(size_t)ek[k] * SEQ + pos] = rstd; GTL[(size_t)ek[k] * SEQ + pos] = gk[k]; } GATES[tok * 4 + k] = gk[k]; } }
        __syncthreads();
    }
}

__device__ __forceinline__ void p9_x2(const Args& a, int c, int G, int wave, int lane) {
    unsigned char* ws = a.ws; const float* X1 = (const float*)(ws + WS_X1); const bf16_t* YS = (const bf16_t*)(ws + WS_YS); bf16_t* X2B = (bf16_t*)(ws + WS_X2B);
    const int gw = c * NWAVES + wave, NGW = G * NWAVES;
    for (int m = gw; m < SEQ; m += NGW) {
#pragma unroll
        for (int j = 0; j < 4; ++j) { const int col = (j * 64 + lane) * 8; const size_t o = (size_t)m * DM + col;
            f32x4 v0 = *(const f32x4*)(X1 + o), v1 = *(const f32x4*)(X1 + o + 4);
#pragma unroll
            for (int k = 0; k < 4; ++k) { float y[8]; unpack8bf(*(const u32x4*)(YS + ((size_t)m * 4 + k) * DM + col), y);
#pragma unroll
                for (int i = 0; i < 4; ++i) { v0[i] += y[i]; v1[i] += y[4 + i]; } }
            *(u32x4*)(X2B + o) = pack8bf(v0, v1); }
    }
}
__device__ __forceinline__ void p11_final(const Args& a, int c, int G, int wave, int lane) {
    unsigned char* ws = a.ws; const bf16_t* X2B = (const bf16_t*)(ws + WS_X2B); const bf16_t* T = (const bf16_t*)(ws + WS_T); const float* TSS = (const float*)(ws + WS_TSS);
    const float* gp = a.in[IN_GPLE]; const float* gfin = a.in[IN_GFINAL]; float* out = a.out;
    const int gw = c * NWAVES + wave, NGW = G * NWAVES;
    for (int m = gw; m < SEQ; m += NGW) {
        float ts = (lane < 32) ? TSS[(size_t)m * 32 + lane] : 0.f; ts = wave_sum(ts);
        const float rt = rsqrtf(ts * (1.f / DM) + EPS);
        f32x4 v[8]; float s = 0.f;
#pragma unroll
        for (int j = 0; j < 8; ++j) { const size_t o = (size_t)m * DM + (j * 64 + lane) * 4; const u32x2 xw = *(const u32x2*)(X2B + o), tw = *(const u32x2*)(T + o); const f32x4 g = *(const f32x4*)(gp + (j * 64 + lane) * 4);
            const f32x4 x = {bf_lo(xw.x), bf_hi(xw.x), bf_lo(xw.y), bf_hi(xw.y)}, t = {bf_lo(tw.x), bf_hi(tw.x), bf_lo(tw.y), bf_hi(tw.y)};
            v[j] = x + t * rt * g; s += (v[j].x * v[j].x + v[j].y * v[j].y) + (v[j].z * v[j].z + v[j].w * v[j].w); }
        const float r3 = rsqrtf(wave_sum(s) * (1.f / DM) + EPS);
#pragma unroll
        for (int j = 0; j < 8; ++j) { const f32x4 g = *(const f32x4*)(gfin + (j * 64 + lane) * 4); *(f32x4*)(out + (size_t)m * DM + (j * 64 + lane) * 4) = v[j] * r3 * g; }
    }
}
constexpr int N_PHASES = 12;
__global__ void __launch_bounds__(NWAVES * 64, 2) hybrid_fwd(Args args) {
    extern __shared__ __attribute__((aligned(16))) unsigned char lds_raw[];
    LAS unsigned char* lds = (LAS unsigned char*)lds_raw;
    volatile LAS unsigned* MISC = (volatile LAS unsigned*)(lds + MISC_OFF);
    const int wave = __builtin_amdgcn_readfirstlane(threadIdx.x >> 6);
    const int G = gridDim.x, c = blockIdx.x;
    unsigned char* ws = args.ws;
    unsigned* ctl = (unsigned*)(ws + WS_CTL);
    for (int u = wave * 64 + lane_id_v(); u < (LDS_BYTES - MISC_OFF) / 4; u += NWAVES * 64) ((LAS unsigned*)(lds + MISC_OFF))[u] = 0u;
    __syncthreads();
    const int lo = args.ph_lo, hi = args.ph_hi;
    XcdBarrier bar; bar.bar = ctl + CW_BAR; bar.x = 0; bar.st = nullptr; bar.wave = wave;
    if (hi - lo > 1) bar = xcd_barrier_post(ctl + CW_BAR, MISC + 8, wave);
#ifndef PH_MASK
#define PH_MASK 0xFFF
#endif
#define IN(k) ((((PH_MASK) >> (k)) & 1) && lo <= (k) && (k) < hi)
#define BOTH(k) (IN(k) && IN((k) + 1))
#define SEAM(k) do { if (BOTH(k)) xcd_barrier(bar); } while (0)
#ifndef REPEAT_MASK
#define REPEAT_MASK 0
#endif
#define NREP(k) ((((REPEAT_MASK) >> (k)) & 1) ? 2 : 1)
#define REP_BEGIN(k) for (int rep_ = 0; rep_ < NREP(k); ++rep_) { if (rep_) xcd_barrier(bar);
#define REP_END }

    bf16_t* QKV7 = (bf16_t*)(ws + WS_QKV7);
    if (IN(0)) { REP_BEGIN(0) p0_prologue(args, lds, c, G, wave, lane_id_v()); REP_END SEAM(0); }

    if (IN(1)) {
        REP_BEGIN(1)
        { pg8::DenseOrder S; S.init(SEQ, NPRJ, G, c);
          EpiInProj E{0, QKV7, (bf16_t*)(ws + WS_SG), (bf16_t*)(ws + WS_KI), (float*)(ws + WS_WI), (float*)(ws + WS_CTL + CTL_KMEAN), (const float*)(ws + WS_ROPEA), (const float*)(ws + WS_ROPEI), args.in[IN_GIDX], args.in[IN_BIDX]};
          pg8::gemm_phase<EpiInProj, pg8::DenseOrder, false, true>(lds, (const bf16_t*)(ws + WS_H1), (const bf16_t*)(ws + WS_WIN), DM, S, E, wave); }
        { constexpr int NU_IN = (SEQ / 256) * (NPRJ / 256); const int rem = NU_IN % G;
          pg8::DenseOrder S; if (rem == 0) S.init(SEQ, DM, G, c); else S.init(SEQ, DM, G - rem, c >= rem ? c - rem : (1 << 30));
          EpiBf16Plain E{0, (bf16_t*)(ws + WS_PLEB), DM};
          pg8::gemm_phase<EpiBf16Plain, pg8::DenseOrder, false, true>(lds, (const bf16_t*)(ws + WS_PB), (const bf16_t*)(ws + WS_WPP), PLED, S, E, wave); }
        REP_END
        SEAM(1);
    }
    if (IN(2)) { REP_BEGIN(2)
        if (rep_) { if (wave == 0 && lane_id_v() == 0) MISC[16] = 0u; __syncthreads(); }
        for (int rg_ = 0; rg_ < P2_NREP(14); ++rg_) p2_moba_gate(args, lds, c, G, wave, lane_id_v());
        __syncthreads();
        p2_indexer_and_convert(args, lds, MISC, c, G, wave, lane_id_v());
        REP_END SEAM(2); }

    if (IN(3)) {
        const unsigned long long* BM = (const unsigned long long*)(ws + WS_BM); const unsigned* SELB = (const unsigned*)(ws + WS_SELB); bf16_t* OAB = (bf16_t*)(ws + WS_OAB);
        REP_BEGIN(3)
        int L = c;
#ifdef ATT_PROBE_BRANCH
        if (rep_ == 1 && (L >> 7) != ATT_PROBE_BRANCH) L = 1 << 20;
#endif
        if (L < 256) {
#define ATT_REF(R, L_, pass_) do { const int bh_ = (L_) >> 4, x_ = (L_) & 15, br_ = bh_ >> 3, h_ = bh_ & 7, qb_ = (pass_) ? 31 - x_ : x_, P0_ = qb_ * 256; \
            const bf16_t* qt_ = QKV7 + (size_t)(br_ ? 4 : 0) * SEQ * BRW; \
            R.Q = qt_ + (size_t)P0_ * BRW + h_ * HD; R.K = qt_ + (size_t)SEQ * BRW + h_ * HD; R.V = qt_ + (size_t)2 * SEQ * BRW + h_ * HD; \
            R.O = OAB + (size_t)P0_ * DM + br_ * BRW + h_ * HD; R.P0 = P0_; R.mode = br_; R.bm = BM + (size_t)P0_ * (SEQ / 64); R.selw = SELB + (size_t)P0_ * NHEAD + h_; } while (0)
            att::BlockRef cur, nxt; int pass = 0; ATT_REF(cur, L, 0);
            att::Seam S;
            att::attn_prime(cur, (char*)lds_raw, S, wave);
            for (;;) {
                const bool more_pass = (pass == 0), more_item = (L + G < 256), last = !more_pass && !more_item;
                int Ln = L, passn = pass + 1;
                if (!more_pass) { passn = 0; Ln = more_item ? L + G : L; }
                if (last) nxt = cur; else ATT_REF(nxt, Ln, passn);
                att::attn_block(cur, nxt, (char*)lds_raw, S, wave);
                if (last) break;
                cur = nxt; pass = passn; L = Ln;
            }
#undef ATT_REF
        }
        REP_END
        SEAM(3);
    }
    if (IN(4)) {
        pg8::DenseOrder S; S.init(SEQ, DM, G, c);
        EpiMerged E{16, (const bf16_t*)(ws + WS_SG), (bf16_t*)(ws + WS_MERGED)};
        REP_BEGIN(4)
        pg8::gemm_phase<EpiMerged, pg8::DenseOrder, false, true>(lds, (const bf16_t*)(ws + WS_OAB), (const bf16_t*)(ws + WS_WBR), DM, S, E, wave);
        REP_END
        SEAM(4);
    }
    if (IN(5)) {
        pg8::DenseOrder S; S.init(SEQ, DM, G, c);
        EpiResF32 E{0, args.in[IN_X], (float*)(ws + WS_X1)};
        REP_BEGIN(5)
        pg8::gemm_phase<EpiResF32, pg8::DenseOrder, false, true>(lds, (const bf16_t*)(ws + WS_MERGED), (const bf16_t*)(ws + WS_WOUT), DM, S, E, wave);
        REP_END
        SEAM(5);
    }
    if (IN(6)) { p6_route(args, lds, c, G, wave, lane_id_v()); SEAM(6); }
    if (IN(7)) {
        const int vcu = (G % 8 == 0) ? (c % 8) * (G / 8) + c / 8 : c;
        MoeOrder S; S.init((const int*)(ctl + CW_CNT), (const int*)(ws + WS_LIST), 16, G, vcu);
        EpiGateUp E{0, (const int*)(ws + WS_LIST), (const float*)(ws + WS_RSL), args.in[IN_BGU], (bf16_t*)(ws + WS_ACT)};
        REP_BEGIN(7)
        pg8::gemm_phase<EpiGateUp, MoeOrder, true, true, true>(lds, (const bf16_t*)(ws + WS_H2U), (const bf16_t*)(ws + WS_WGU), DM, S, E, wave);
        REP_END
        SEAM(7);
    }
    if (IN(8)) {
        const int vcu = (G % 8 == 0) ? (c % 8) * (G / 8) + c / 8 : c;
        MoeOrder S; S.init((const int*)(ctl + CW_CNT), (const int*)(ws + WS_LIST), 8, G, vcu);
        EpiDown E{0, (const int*)(ws + WS_LIST), (const float*)(ws + WS_GTL), args.in[IN_BDOWN], (bf16_t*)(ws + WS_YS)};
        REP_BEGIN(8)
        pg8::gemm_phase<EpiDown, MoeOrder, false, true, true>(lds, (const bf16_t*)(ws + WS_ACT), (const bf16_t*)(ws + WS_WD), DFF, S, E, wave);
        REP_END
        SEAM(8);
    }
    if (IN(9)) { REP_BEGIN(9) p9_x2(args, c, G, wave, lane_id_v()); REP_END SEAM(9); }
    if (IN(10)) {
        pg8::DenseOrder S; S.init(SEQ, DM, G, c);
        EpiPleGate E{0, (const bf16_t*)(ws + WS_PLEB), (bf16_t*)(ws + WS_T), (float*)(ws + WS_TSS)};
        REP_BEGIN(10)
        pg8::gemm_phase<EpiPleGate, pg8::DenseOrder, false, true>(lds, (const bf16_t*)(ws + WS_X2B), (const bf16_t*)(ws + WS_WPG), DM, S, E, wave);
        REP_END
        SEAM(10);
    }
    if (IN(11)) { REP_BEGIN(11) p11_final(args, c, G, wave, lane_id_v()); REP_END }
#undef IN
#undef BOTH
#undef SEAM
#undef NREP
#undef REP_BEGIN
#undef REP_END
}

#ifndef MK_N_LAUNCHES
#define MK_N_LAUNCHES 1
#endif
extern "C" void kernel_launch(void* const* d_in, const int* in_sizes, int n_in, void* d_out, int out_size, void* d_ws, size_t ws_size, hipStream_t stream) {
    static int grid = 0;
    if (grid == 0) {
        if (n_in != 20 || in_sizes[0] != SEQ * DM || out_size != SEQ * DM || ws_size < WS_END) { fprintf(stderr, "kernel_launch: unexpected shapes (n_in %d, in0 %d, out %d, ws %zu)\n", n_in, n_in > 0 ? in_sizes[0] : -1, out_size, ws_size); grid = -1; return; }
        int dev = 0, cus = 0, per_cu = 0;
        if (hipGetDevice(&dev) != hipSuccess || hipDeviceGetAttribute(&cus, hipDeviceAttributeMultiprocessorCount, dev) != hipSuccess) { grid = -1; return; }
        if (hipFuncSetAttribute((const void*)hybrid_fwd, hipFuncAttributeMaxDynamicSharedMemorySize, LDS_BYTES) != hipSuccess) { fprintf(stderr, "kernel_launch: hipFuncSetAttribute failed\n"); grid = -1; return; }
        if (hipOccupancyMaxActiveBlocksPerMultiprocessor(&per_cu, (const void*)hybrid_fwd, NWAVES * 64, LDS_BYTES) != hipSuccess || per_cu < 1) { fprintf(stderr, "kernel_launch: occupancy query says %d blocks per CU\n", per_cu); }
        (void)hipGetLastError();
        grid = cus > 0 ? cus : 256;
    }
    if (grid < 0) return;
    if (hipMemsetAsync((char*)d_ws + WS_CTL, 0, CTL_ZERO_BYTES, stream) != hipSuccess) return;
    Args a{};
    for (int i = 0; i < 20; ++i) a.in[i] = (const float*)d_in[i];
    a.out = (float*)d_out; a.ws = (unsigned char*)d_ws;
    if (MK_N_LAUNCHES == 1) { a.ph_lo = 0; a.ph_hi = N_PHASES; hipLaunchKernelGGL(hybrid_fwd, dim3(grid), dim3(NWAVES * 64), LDS_BYTES, stream, a); }
    else { for (int p = 0; p < N_PHASES; ++p) { a.ph_lo = p; a.ph_hi = p + 1; hipLaunchKernelGGL(hybrid_fwd, dim3(grid), dim3(NWAVES * 64), LDS_BYTES, stream, a); } }
    const hipError_t le = hipPeekAtLastError();
    if (le != hipSuccess) fprintf(stderr, "kernel_launch: launch failed: %s\n", hipGetErrorName(le));
}
```

```cpp
#include <hip/hip_runtime.h>
#include <hip/hip_bf16.h>
#include <cstdio>
#include <cstdint>

#define GAS __attribute__((address_space(1)))
#define LAS __attribute__((address_space(3)))
typedef unsigned short bf16_t;
typedef short bf16x8 __attribute__((ext_vector_type(8)));
typedef short s16x4 __attribute__((ext_vector_type(4)));
typedef float f32x4 __attribute__((ext_vector_type(4)));
typedef float f32x2 __attribute__((ext_vector_type(2)));
typedef float f32x16 __attribute__((ext_vector_type(16)));
typedef unsigned u32x4 __attribute__((ext_vector_type(4)));
typedef unsigned u32x2 __attribute__((ext_vector_type(2)));

typedef __bf16 bf16x2_n __attribute__((ext_vector_type(2)));
__device__ __forceinline__ unsigned cvt_pk_bf16(float lo, float hi) { const f32x2 v = {lo, hi}; return __builtin_bit_cast(unsigned, __builtin_convertvector(v, bf16x2_n)); }
__device__ __forceinline__ float bf_lo(unsigned w) { return __uint_as_float(w << 16); }
__device__ __forceinline__ float bf_hi(unsigned w) { return __uint_as_float(w & 0xffff0000u); }
__device__ __forceinline__ float sigmoidf_(float x) { return __builtin_amdgcn_rcpf(1.0f + __builtin_amdgcn_exp2f(x * -1.4426950408889634f)); }
__device__ __forceinline__ float sigmoid_fast(float x) { return sigmoidf_(x); }
__device__ __forceinline__ int lane_id_v() { int l; asm volatile("v_mbcnt_lo_u32_b32 %0, -1, 0\n\tv_mbcnt_hi_u32_b32 %0, -1, %0" : "=v"(l)); return l; }

namespace pg8 {
constexpr int BM = 256, BK = 64, HALF = 128, HTB = HALF * BK * 2, STAGE_BYTES = 8 * HTB, NXCD = 8, WGM = 8;
__host__ __device__ __forceinline__ int lds_byte(int r, int c) { const int st = (r >> 4) * 2 + (c >> 5), rr = r & 15, cc = c & 31, ob = rr * 64 + cc * 2; return st * 1024 + (ob ^ (((ob >> 9) & 1) << 5)); }
__host__ __device__ __forceinline__ void stage_rc(int b, int& R, int& C) { const int st = b / 1024, sb = b % 1024, swz = sb ^ (((sb >> 9) & 1) << 5); R = (st >> 1) * 16 + swz / 64; C = (st & 1) * 32 + (swz % 64) / 2; }
__host__ __device__ __forceinline__ int perm32(int rho) { const int n = rho >> 4, i = rho & 15; return 8 * (i >> 2) + 4 * n + (i & 3); }

struct Unit { int pm, pn, e, b, rows, rb; };

struct DenseOrder {
    int nM, nN, nwg, G, c;
    __device__ void init(int M, int N, int G_, int c_) { nM = M / BM; nN = N / BM; nwg = nM * nN; G = G_; c = c_; }
    __device__ bool next(int i, Unit& u) const {
        const long L = (long)i * G + c; if (L >= nwg) return false;
        int wgid = (int)L; { const int q = nwg / NXCD, r = nwg % NXCD, xcd = wgid % NXCD, off = wgid / NXCD; wgid = (xcd < r ? xcd * (q + 1) : r * (q + 1) + (xcd - r) * q) + off; }
        const int nig = WGM * nN, gid = wgid / nig, fm = gid * WGM, gsz = (nM - fm) < WGM ? (nM - fm) : WGM;
        u.pm = fm + ((wgid % nig) % gsz); u.pn = (wgid % nig) / gsz; u.e = 0; u.b = 0; u.rows = 256; u.rb = u.pm; return true;
    }
    __device__ __forceinline__ size_t a_row0(const Unit& u) const { return (size_t)u.pm * BM; }
    __device__ __forceinline__ size_t b_row0(const Unit& u) const { return (size_t)u.pn * BM; }
    __device__ __forceinline__ int a_row(const Unit&, int) const { return 0; }
    static constexpr bool PARTIAL = false;
};

template <class Epi, class Sched, bool GATHER, bool ALIGN_EPI, bool BBLK = false>
__device__ __forceinline__ void gemm_phase(LAS unsigned char* lds, const bf16_t* A, const bf16_t* Bt, const int K, const Sched& S, const Epi& E, const int wid) {
    const int lane = lane_id_v(), tid = wid * 64 + lane, wr = wid >> 2, wc = wid & 3, fr = lane & 15, fq = lane >> 4;
    const int nt = K / BK;
    int Rr[2], Cc[2]; unsigned voffB[2], vC[2][2], vN[2][2];
#pragma unroll
    for (int i = 0; i < 2; ++i) { stage_rc(tid * 16 + i * 8192, Rr[i], Cc[i]); const int Rb = (Rr[i] & ~31) + perm32(Rr[i] & 31);
        voffB[i] = BBLK ? (unsigned)((Rb >> 6) * (K >> 6)) * 8192u + (unsigned)((Rb & 63) * 128 + Cc[i] * 2) : (unsigned)(Rb * K + Cc[i]) * 2u; }
    const size_t kstep = (size_t)(BK * 2), kstepB = BBLK ? (size_t)8192 : kstep;
    const size_t hstep = (size_t)HALF * K * 2;
    const unsigned ldsw = (unsigned)wid * 1024u;
    const int aoff = lds_byte(wr * 64 + fr, fq * 8), boff = lds_byte(wc * 32 + fr, fq * 8);
    const unsigned lbase = (unsigned)(unsigned long long)lds;
#define PG8_SA(b, h) (((b) * 2 + (h)) * HTB)
#define PG8_SB(b, h) ((4 + (b) * 2 + (h)) * HTB)
#define PG8_STAGE(bufoff, gbase, voff) do { _Pragma("unroll") for (int _i = 0; _i < 2; ++_i) \
        __builtin_amdgcn_global_load_lds((const unsigned*)((const char*)(gbase) + (voff)[_i]), (LAS unsigned*)(lds + (bufoff) + ldsw + _i * 8192), 16, 0, 0); } while (0)
#define PG8_STAGEA(bufoff, gbase, VO, h) PG8_STAGE(bufoff, (gbase) + (GATHER ? (size_t)0 : (size_t)(h) * hstep), (VO)[GATHER ? (h) : 0])
#define PG8_LDA(dst, b, h) do { _Pragma("unroll") for (int m = 0; m < 4; ++m) _Pragma("unroll") for (int k = 0; k < 2; ++k) dst[m][k] = *(const LAS bf16x8*)(lds + PG8_SA(b, h) + aoff + m * 2048 + k * 1024); } while (0)
#define PG8_LDB(dst, b, h) do { _Pragma("unroll") for (int n = 0; n < 2; ++n) _Pragma("unroll") for (int k = 0; k < 2; ++k) dst[n][k] = *(const LAS bf16x8*)(lds + PG8_SB(b, h) + boff + n * 2048 + k * 1024); } while (0)
#define PG8_MMA(ai, bj, At, Bt_) do { __builtin_amdgcn_s_setprio(1); _Pragma("unroll") for (int m = 0; m < 4; ++m) _Pragma("unroll") for (int n = 0; n < 2; ++n) _Pragma("unroll") for (int k = 0; k < 2; ++k) \
        acc[ai][bj][m][n] = __builtin_amdgcn_mfma_f32_16x16x32_bf16(Bt_[n][k], At[m][k], acc[ai][bj][m][n], 0, 0, 0); __builtin_amdgcn_s_setprio(0); } while (0)
#define PG8_WAIT_V(n) asm volatile("s_waitcnt vmcnt(" #n ")" ::: "memory")
#define PG8_WAIT_L(n) asm volatile("s_waitcnt lgkmcnt(" #n ")" ::: "memory")
#define PG8_BAR __builtin_amdgcn_s_barrier()
#define PG8_SCHED __builtin_amdgcn_sched_barrier(0)
#define PG8_VOFF(dst, u) do { _Pragma("unroll") for (int _h = 0; _h < 2; ++_h) _Pragma("unroll") for (int _i = 0; _i < 2; ++_i) { \
        const int _r = GATHER ? S.a_row(u, _h * HALF + Rr[_i]) : (_h * HALF + Rr[_i]); dst[_h][_i] = (unsigned)(_r * K + Cc[_i]) * 2u; } \
        if (GATHER) { asm volatile("s_waitcnt vmcnt(0)" ::: "memory"); } } while (0)
#define PG8_DSR(dst, base, off) asm volatile("ds_read_b128 %0, %1 offset:" #off : "=v"(dst) : "v"(base))
#define PG8_LDA_ASM(dst, b, h) do { const unsigned _ab = lbase + (unsigned)(PG8_SA(b, h) + aoff); PG8_DSR(dst[0][0], _ab, 0); PG8_DSR(dst[0][1], _ab, 1024); PG8_DSR(dst[1][0], _ab, 2048); PG8_DSR(dst[1][1], _ab, 3072); \
        PG8_DSR(dst[2][0], _ab, 4096); PG8_DSR(dst[2][1], _ab, 5120); PG8_DSR(dst[3][0], _ab, 6144); PG8_DSR(dst[3][1], _ab, 7168); } while (0)
#define PG8_LDB_ASM(dst, b, h) do { const unsigned _bb = lbase + (unsigned)(PG8_SB(b, h) + boff); PG8_DSR(dst[0][0], _bb, 0); PG8_DSR(dst[0][1], _bb, 1024); PG8_DSR(dst[1][0], _bb, 2048); PG8_DSR(dst[1][1], _bb, 3072); } while (0)
#define PG8_UNDEF_A(dst) do { _Pragma("unroll") for (int m = 0; m < 4; ++m) _Pragma("unroll") for (int k = 0; k < 2; ++k) asm volatile("" : "=v"(dst[m][k])); } while (0)
#define PG8_UNDEF_B(dst) do { _Pragma("unroll") for (int n = 0; n < 2; ++n) _Pragma("unroll") for (int k = 0; k < 2; ++k) asm volatile("" : "=v"(dst[n][k])); } while (0)
#define PG8_KLOOP(D0, D1, LDA_, LDB_) \
        _Pragma("unroll 1") for (int t = 0; t < nt; t += 2) { \
            const bool last = (t == nt - 2); \
            if constexpr (Epi::HAS_MID) { if (t == E.mid_t) E.mid(acc, cur, wr, wc, fr, fq); } \
            const char* a1 = cA + (size_t)(t + 1) * kstep; \
            const char* a2 = last ? nA : cA + (size_t)(t + 2) * kstep; const char* b2 = last ? nB : cB + (size_t)(t + 2) * kstepB; \
            const char* a3 = a2 + kstep; const char* b3 = b2 + kstepB; \
            unsigned o2[2][2]; \
            _Pragma("unroll") for (int h = 0; h < 2; ++h) _Pragma("unroll") for (int i = 0; i < 2; ++i) o2[h][i] = (GATHER && last) ? vN[h][i] : vC[h][i]; \
            if (D0) { LDB_(B0, 0, 0); LDB_(B1, 0, 1); PG8_SCHED; LDA_(At, 0, 0); } else { PG8_UNDEF_B(B0); PG8_UNDEF_B(B1); PG8_UNDEF_A(At); } PG8_STAGEA(PG8_SA(1, 1), a1, vC, 1); \
            PG8_WAIT_V(8); PG8_WAIT_L(0); PG8_BAR; if (D0) { PG8_MMA(0, 0, At, B0); PG8_MMA(0, 1, At, B1); } PG8_BAR; PG8_SCHED; \
            if (D1) { LDA_(At, 0, 1); } else { PG8_UNDEF_A(At); } PG8_STAGE(PG8_SB(0, 0), b2, voffB); PG8_STAGE(PG8_SB(0, 1), b2 + hstep, voffB); PG8_STAGEA(PG8_SA(0, 0), a2, o2, 0); \
            PG8_WAIT_V(8); PG8_WAIT_L(0); PG8_BAR; if (D1) { PG8_MMA(1, 0, At, B0); PG8_MMA(1, 1, At, B1); } PG8_BAR; PG8_SCHED; \
            if (D0) { LDB_(B0, 1, 0); LDB_(B1, 1, 1); PG8_SCHED; LDA_(At, 1, 0); } else { PG8_UNDEF_B(B0); PG8_UNDEF_B(B1); PG8_UNDEF_A(At); } PG8_STAGEA(PG8_SA(0, 1), a2, o2, 1); \
            PG8_WAIT_V(8); PG8_WAIT_L(0); PG8_BAR; if (D0) { PG8_MMA(0, 0, At, B0); PG8_MMA(0, 1, At, B1); } PG8_BAR; PG8_SCHED; \
            if (D1) { LDA_(At, 1, 1); } else { PG8_UNDEF_A(At); } PG8_STAGE(PG8_SB(1, 0), b3, voffB); PG8_STAGE(PG8_SB(1, 1), b3 + hstep, voffB); PG8_STAGEA(PG8_SA(1, 0), a3, o2, 0); \
            PG8_WAIT_V(8); PG8_WAIT_L(0); PG8_BAR; if (D1) { PG8_MMA(1, 0, At, B0); PG8_MMA(1, 1, At, B1); } PG8_BAR; PG8_SCHED; \
        }
    Unit cur, nxt; int ui = 0;
    if (!S.next(0, cur)) return;
    f32x4 acc[2][2][4][2];
#pragma unroll
    for (int a = 0; a < 2; ++a)
#pragma unroll
        for (int b = 0; b < 2; ++b)
#pragma unroll
            for (int m = 0; m < 4; ++m)
#pragma unroll
                for (int n = 0; n < 2; ++n) acc[a][b][m][n] = (f32x4){0.f, 0.f, 0.f, 0.f};
    bf16x8 At[4][2], B0[2][2], B1[2][2];
    PG8_VOFF(vC, cur);
#pragma unroll
    for (int h = 0; h < 2; ++h)
#pragma unroll
        for (int i = 0; i < 2; ++i) vN[h][i] = vC[h][i];
    const char* cA = (const char*)A + (GATHER ? (size_t)0 : S.a_row0(cur) * (size_t)K * 2); const char* cB = (const char*)Bt + S.b_row0(cur) * (size_t)K * 2;
    PG8_STAGE(PG8_SB(0, 0), cB, voffB); PG8_STAGE(PG8_SB(0, 1), cB + hstep, voffB); PG8_STAGEA(PG8_SA(0, 0), cA, vC, 0); PG8_STAGEA(PG8_SA(0, 1), cA, vC, 1);
    if (wr == 1) PG8_BAR;
    PG8_WAIT_V(2); PG8_BAR;
    PG8_STAGE(PG8_SB(1, 0), cB + kstepB, voffB); PG8_STAGEA(PG8_SA(1, 0), cA + kstep, vC, 0); PG8_STAGE(PG8_SB(1, 1), cB + hstep + kstepB, voffB);
    PG8_WAIT_V(6); PG8_BAR;
    for (;;) {
        bool do0 = true, do1 = true;
        if constexpr (Sched::PARTIAL) { do0 = wr * 64 < cur.rows; do1 = HALF + wr * 64 < cur.rows; }
        const bool has_next = S.next(ui + 1, nxt);
        const char* nA = (has_next && !GATHER) ? (const char*)A + S.a_row0(nxt) * (size_t)K * 2 : cA; const char* nB = has_next ? (const char*)Bt + S.b_row0(nxt) * (size_t)K * 2 : cB;
        if (GATHER && has_next) { PG8_VOFF(vN, nxt); }
        if (do1) { PG8_KLOOP(true, true, PG8_LDA, PG8_LDB) } else if (do0) { PG8_KLOOP(true, false, PG8_LDA, PG8_LDB) } else { PG8_KLOOP(false, false, PG8_LDA, PG8_LDB) }
        if constexpr (ALIGN_EPI) { if (wr == 0) PG8_BAR; }
        E(acc, cur, wr, wc, fr, fq);
        if (!has_next) break;
#pragma unroll
        for (int a = 0; a < 2; ++a)
#pragma unroll
            for (int b = 0; b < 2; ++b)
#pragma unroll
                for (int m = 0; m < 4; ++m)
#pragma unroll
                    for (int n = 0; n < 2; ++n) acc[a][b][m][n] = (f32x4){0.f, 0.f, 0.f, 0.f};
        cur = nxt; cA = nA; cB = nB; ++ui;
#pragma unroll
        for (int h = 0; h < 2; ++h)
#pragma unroll
            for (int i = 0; i < 2; ++i) vC[h][i] = vN[h][i];
        if constexpr (ALIGN_EPI) { if (wr == 1) PG8_BAR; }
    }
    PG8_WAIT_V(0);
    if constexpr (!ALIGN_EPI) { if (wr == 0) PG8_BAR; }
    PG8_BAR;
#undef PG8_SA
#undef PG8_SB
#undef PG8_STAGE
#undef PG8_STAGEA
#undef PG8_LDA
#undef PG8_LDB
#undef PG8_MMA
#undef PG8_WAIT_V
#undef PG8_WAIT_L
#undef PG8_BAR
#undef PG8_SCHED
#undef PG8_VOFF
#undef PG8_KLOOP
#undef PG8_UNDEF_A
#undef PG8_UNDEF_B
#undef PG8_DSR
#undef PG8_LDA_ASM
#undef PG8_LDB_ASM
}
}
constexpr int SEQ = 8192, DM = 2048, HD = 128, NHEAD = 8, BRW = 1024, IDXH = 16, IDXD = 64, NEXP = 32, TOPK = 4, DFF = 2048, PLED = 256;
constexpr int INW = 11344, NPRJ = 11520;
constexpr int DSA_TOPK = 256, MOBA_BLK = 256, NKB = SEQ / MOBA_BLK;
constexpr float EPS = 1e-6f, SWI_LIMIT = 7.0f, SWI_ALPHA = 1.702f, IDX_W_SCALE = 0.03125f;

#define ACC_T f32x4 (&acc)[2][2][4][2]
#define CACC_T const f32x4 (&acc)[2][2][4][2]
__device__ __forceinline__ u32x4 pack8bf(const f32x4 a, const f32x4 b) { u32x4 w; w.x = cvt_pk_bf16(a[0], a[1]); w.y = cvt_pk_bf16(a[2], a[3]); w.z = cvt_pk_bf16(b[0], b[1]); w.w = cvt_pk_bf16(b[2], b[3]); return w; }
__device__ __forceinline__ void unpack8bf(const u32x4 w, float (&o)[8]) { o[0] = bf_lo(w.x); o[1] = bf_hi(w.x); o[2] = bf_lo(w.y); o[3] = bf_hi(w.y); o[4] = bf_lo(w.z); o[5] = bf_hi(w.z); o[6] = bf_lo(w.w); o[7] = bf_hi(w.w); }

struct EpiInProj {
    static constexpr bool HAS_MID = false; int mid_t;
    bf16_t* qkv7; bf16_t* sg; bf16_t* ki; float* wi; float* kmean; const float* ropeA; const float* ropeI; const float* g_idx; const float* b_idx;
    __device__ __forceinline__ void mid(ACC_T, const pg8::Unit&, int, int, int, int) const {}
    __device__ __forceinline__ void operator()(CACC_T, const pg8::Unit& u, int wr, int wc, int fr_in, int fq_in) const {
        int fr = fr_in, fq = fq_in; asm volatile("" : "+v"(fr), "+v"(fq));
        const int pn = u.pn, row0 = u.pm * 256 + wr * 64 + fr;
        if (pn < 28) {
            const int tsr = pn >> 2, colt = (pn & 3) * 256;
            bf16_t* dst = qkv7 + (size_t)tsr * ((size_t)SEQ * BRW);
            const bool rope32 = (tsr == 0 || tsr == 1 || tsr == 4 || tsr == 5) && (wc == 0);
            const bool rope16 = (tsr == 3) && ((wc & 1) == 0);
            const bool km = (tsr == 5);
#pragma unroll
            for (int bj = 0; bj < 2; ++bj) {
                float ks[8];
#pragma unroll
                for (int i = 0; i < 8; ++i) ks[i] = 0.f;
#pragma unroll
                for (int ai = 0; ai < 2; ++ai)
#pragma unroll
                    for (int m = 0; m < 4; ++m) {
                        const int row = row0 + ai * 128 + m * 16;
                        f32x4 cs[4];
                        if (rope32) { const f32x4* tp = (const f32x4*)(ropeA + ((size_t)row * 16 + 8 * (fq & 1)) * 2);
#pragma unroll
                            for (int q = 0; q < 4; ++q) cs[q] = tp[q]; }
                        else if (rope16) { const f32x4* tp = (const f32x4*)(ropeI + (size_t)row * 16);
#pragma unroll
                            for (int q = 0; q < 4; ++q) cs[q] = tp[q]; }
                        float v[8];
#pragma unroll
                        for (int i = 0; i < 4; ++i) { v[i] = acc[ai][bj][m][0][i]; v[4 + i] = acc[ai][bj][m][1][i]; }
                        if (rope32) {
#pragma unroll
                            for (int i = 0; i < 8; ++i) { const float p = __shfl_xor(v[i], 32); const float c = cs[i >> 1][(i & 1) * 2], s = cs[i >> 1][(i & 1) * 2 + 1];
                                v[i] = v[i] * c + (fq < 2 ? -p : p) * s; }
                        } else if (rope16) {
#pragma unroll
                            for (int i = 0; i < 8; ++i) { const float p = __shfl_xor(v[i], 16); const float c = cs[i >> 1][(i & 1) * 2], s = cs[i >> 1][(i & 1) * 2 + 1];
                                const float r = v[i] * c + (fq == 0 ? -p : p) * s; v[i] = (fq < 2) ? r : v[i]; }
                        }
                        if (km) {
#pragma unroll
                            for (int i = 0; i < 8; ++i) ks[i] += v[i];
                        }
                        u32x4 w; w.x = cvt_pk_bf16(v[0], v[1]); w.y = cvt_pk_bf16(v[2], v[3]); w.z = cvt_pk_bf16(v[4], v[5]); w.w = cvt_pk_bf16(v[6], v[7]);
                        *(u32x4*)(dst + (size_t)row * BRW + colt + bj * 128 + wc * 32 + fq * 8) = w;
                        asm volatile("" ::: "memory");
                    }
                if (km) {
#pragma unroll
                    for (int i = 0; i < 8; ++i) { float s = ks[i]; s += __shfl_xor(s, 1); s += __shfl_xor(s, 2); s += __shfl_xor(s, 4); s += __shfl_xor(s, 8);
                        if (fr == 0) atomicAdd(kmean + (size_t)u.pm * BRW + colt + bj * 128 + wc * 32 + fq * 8 + i, s); }
                }
            }
        } else if (pn < 44) {
            const int colt = (pn - 28) * 256;
#pragma unroll
            for (int ai = 0; ai < 2; ++ai)
#pragma unroll
                for (int m = 0; m < 4; ++m) {
                    const int row = row0 + ai * 128 + m * 16;
#pragma unroll
                    for (int bj = 0; bj < 2; ++bj) {
                        float v[8];
#pragma unroll
                        for (int i = 0; i < 4; ++i) { v[i] = sigmoid_fast(acc[ai][bj][m][0][i]); v[4 + i] = sigmoid_fast(acc[ai][bj][m][1][i]); }
                        u32x4 w; w.x = cvt_pk_bf16(v[0], v[1]); w.y = cvt_pk_bf16(v[2], v[3]); w.z = cvt_pk_bf16(v[4], v[5]); w.w = cvt_pk_bf16(v[6], v[7]);
                        *(u32x4*)(sg + (size_t)row * 4096 + colt + bj * 128 + wc * 32 + fq * 8) = w;
                    }
                    asm volatile("" ::: "memory");
                }
        } else {
            if (wc == 0) {
#pragma unroll 1
                for (int am = 0; am < 8; ++am) {
                    const int ai = am >> 2, m = am & 3;
                    const int row = row0 + ai * 128 + m * 16;
                    float v[2][8]; float s = 0.f;
#pragma unroll
                    for (int bj = 0; bj < 2; ++bj)
#pragma unroll
                        for (int i = 0; i < 4; ++i) {
                            float x0, x1;
                            x0 = acc[0][bj][0][0][i]; x1 = acc[0][bj][0][1][i];
#pragma unroll
                            for (int q = 1; q < 8; ++q) { x0 = (am == q) ? acc[q >> 2][bj][q & 3][0][i] : x0; x1 = (am == q) ? acc[q >> 2][bj][q & 3][1][i] : x1; }
                            v[bj][i] = x0; v[bj][4 + i] = x1; s += x0 + x1; }
                    s += __shfl_xor(s, 16); s += __shfl_xor(s, 32);
                    const float mu = s * (1.f / 64.f); float q2 = 0.f;
#pragma unroll
                    for (int bj = 0; bj < 2; ++bj)
#pragma unroll
                        for (int i = 0; i < 8; ++i) { v[bj][i] -= mu; q2 += v[bj][i] * v[bj][i]; }
                    q2 += __shfl_xor(q2, 16); q2 += __shfl_xor(q2, 32);
                    const float rstd = rsqrtf(q2 * (1.f / 64.f) + EPS);
#pragma unroll
                    for (int bj = 0; bj < 2; ++bj)
#pragma unroll
                        for (int i = 0; i < 8; ++i) v[bj][i] = v[bj][i] * rstd * g_idx[bj * 32 + fq * 8 + i] + b_idx[bj * 32 + fq * 8 + i];
                    const float* tp = ropeI + (size_t)row * 16;
#pragma unroll
                    for (int i = 0; i < 8; ++i) { const float p = __shfl_xor(v[0][i], 16); const float c = tp[2 * i], sn = tp[2 * i + 1];
                        const float r = v[0][i] * c + (fq == 0 ? -p : p) * sn; v[0][i] = (fq < 2) ? r : v[0][i]; }
#pragma unroll
                    for (int bj = 0; bj < 2; ++bj) { u32x4 w; w.x = cvt_pk_bf16(v[bj][0], v[bj][1]); w.y = cvt_pk_bf16(v[bj][2], v[bj][3]); w.z = cvt_pk_bf16(v[bj][4], v[bj][5]); w.w = cvt_pk_bf16(v[bj][6], v[bj][7]);
                        *(u32x4*)(ki + (size_t)row * IDXD + bj * 32 + fq * 8) = w; }
                    asm volatile("" ::: "memory");
                }
            } else if (wc == 1) {
                if (fq < 2) {
#pragma unroll
                    for (int ai = 0; ai < 2; ++ai)
#pragma unroll
                        for (int m = 0; m < 4; ++m) { const int row = row0 + ai * 128 + m * 16;
                            *(f32x4*)(wi + (size_t)row * IDXH + fq * 8) = acc[ai][0][m][0] * IDX_W_SCALE; *(f32x4*)(wi + (size_t)row * IDXH + fq * 8 + 4) = acc[ai][0][m][1] * IDX_W_SCALE; }
                }
            }
        }
    }
};

struct EpiBf16Plain {
    static constexpr bool HAS_MID = false; int mid_t;
    bf16_t* O; int ldc;
    __device__ __forceinline__ void mid(ACC_T, const pg8::Unit&, int, int, int, int) const {}
    __device__ __forceinline__ void operator()(CACC_T, const pg8::Unit& u, int wr, int wc, int fr_in, int fq_in) const {
        int fr = fr_in, fq = fq_in; asm volatile("" : "+v"(fr), "+v"(fq));
        const int row0 = u.pm * 256 + wr * 64 + fr, col0 = u.pn * 256 + wc * 32 + fq * 8;
#pragma unroll
        for (int ai = 0; ai < 2; ++ai)
#pragma unroll
            for (int m = 0; m < 4; ++m)
#pragma unroll
                for (int bj = 0; bj < 2; ++bj)
                    *(u32x4*)(O + (size_t)(row0 + ai * 128 + m * 16) * ldc + col0 + bj * 128) = pack8bf(acc[ai][bj][m][0], acc[ai][bj][m][1]);
    }
};

struct EpiMerged {
    static constexpr bool HAS_MID = true; int mid_t;
    const bf16_t* sg; bf16_t* O;
    __device__ __forceinline__ void mid(ACC_T, const pg8::Unit& u, int wr, int wc, int fr_in, int fq_in) const {
        int fr = fr_in, fq = fq_in; asm volatile("" : "+v"(fr), "+v"(fq));
        const int row0 = u.pm * 256 + wr * 64 + fr, col0 = u.pn * 256 + wc * 32 + fq * 8;
#pragma unroll
        for (int ai = 0; ai < 2; ++ai)
#pragma unroll
            for (int m = 0; m < 4; ++m)
#pragma unroll
                for (int bj = 0; bj < 2; ++bj) { const bf16_t* gp = sg + (size_t)(row0 + ai * 128 + m * 16) * 4096 + col0 + bj * 128;
                    float a[8], b[8]; unpack8bf(*(const u32x4*)gp, a); unpack8bf(*(const u32x4*)(gp + 2048), b);
#pragma unroll
                    for (int i = 0; i < 4; ++i) { acc[ai][bj][m][0][i] *= a[i] * __builtin_amdgcn_rcpf(b[i]); acc[ai][bj][m][1][i] *= a[4 + i] * __builtin_amdgcn_rcpf(b[4 + i]); }
                    asm volatile("" : "+v"(acc[ai][bj][m][0]), "+v"(acc[ai][bj][m][1]) :: "memory"); }
    }
    __device__ __forceinline__ void operator()(CACC_T, const pg8::Unit& u, int wr, int wc, int fr_in, int fq_in) const {
        int fr = fr_in, fq = fq_in; asm volatile("" : "+v"(fr), "+v"(fq));
        const int row0 = u.pm * 256 + wr * 64 + fr, col0 = u.pn * 256 + wc * 32 + fq * 8;
#pragma unroll
        for (int ai = 0; ai < 2; ++ai)
#pragma unroll
            for (int m = 0; m < 4; ++m)
#pragma unroll
                for (int bj = 0; bj < 2; ++bj) { const size_t ro = (size_t)(row0 + ai * 128 + m * 16);
                    float b[8]; unpack8bf(*(const u32x4*)(sg + ro * 4096 + 2048 + col0 + bj * 128), b);
                    f32x4 v0 = acc[ai][bj][m][0], v1 = acc[ai][bj][m][1];
#pragma unroll
                    for (int i = 0; i < 4; ++i) { v0[i] *= b[i]; v1[i] *= b[4 + i]; }
                    *(u32x4*)(O + ro * DM + col0 + bj * 128) = pack8bf(v0, v1); asm volatile("" ::: "memory"); }
    }
};

struct EpiResF32 {
    static constexpr bool HAS_MID = false; int mid_t;
    const float* X; float* O;
    __device__ __forceinline__ void mid(ACC_T, const pg8::Unit&, int, int, int, int) const {}
    __device__ __forceinline__ void operator()(CACC_T, const pg8::Unit& u, int wr, int wc, int fr_in, int fq_in) const {
        int fr = fr_in, fq = fq_in; asm volatile("" : "+v"(fr), "+v"(fq));
        const int row0 = u.pm * 256 + wr * 64 + fr, col0 = u.pn * 256 + wc * 32 + fq * 8;
#pragma unroll
        for (int ai = 0; ai < 2; ++ai)
#pragma unroll
            for (int m = 0; m < 4; ++m)
#pragma unroll
                for (int bj = 0; bj < 2; ++bj) { const size_t o = (size_t)(row0 + ai * 128 + m * 16) * DM + col0 + bj * 128;
                    const f32x4 x0 = *(const f32x4*)(X + o), x1 = *(const f32x4*)(X + o + 4);
                    *(f32x4*)(O + o) = x0 + acc[ai][bj][m][0]; *(f32x4*)(O + o + 4) = x1 + acc[ai][bj][m][1]; }
    }
};

struct MoeOrder {
    static constexpr bool PARTIAL = true;
    int cnt_l, nb_l, rbx_l, pin_l, pex_l, total, NT, G, c; const int* list;
    __device__ void init(const int* cnt, const int* list_, int NT_, int G_, int c_) {
        const int lane = lane_id_v(), e = lane & 31; NT = NT_; G = G_; c = c_; list = list_;
        cnt_l = cnt[e]; if (cnt_l > SEQ) cnt_l = SEQ; if (cnt_l < 0) cnt_l = 0;
        nb_l = (cnt_l + 255) >> 8;
        int p = nb_l;
#pragma unroll
        for (int o = 1; o < 32; o <<= 1) { const int q = __shfl_up(p, o, 32); if (e >= o) p += q; }
        rbx_l = p - nb_l; pin_l = p * NT; pex_l = (p - nb_l) * NT;
        total = __builtin_amdgcn_readlane(pin_l, 31);
    }
    __device__ bool next(int i, pg8::Unit& u) const {
        const long L = (long)i * G + c; if (L >= total) return false;
        const unsigned long long mk = __ballot(pin_l > (int)L); const int e = __builtin_ctz((unsigned)mk);
        const int base = __builtin_amdgcn_readlane(pex_l, e), nb = __builtin_amdgcn_readlane(nb_l, e), cn = __builtin_amdgcn_readlane(cnt_l, e), rbx = __builtin_amdgcn_readlane(rbx_l, e);
        const int idx = (int)L - base; u.e = e; u.b = idx % nb; u.pn = idx / nb; u.pm = 0; u.rb = rbx + u.b; const int rem = cn - u.b * 256; u.rows = rem < 256 ? rem : 256; return true;
    }
    __device__ __forceinline__ size_t a_row0(const pg8::Unit& u) const { return (size_t)u.rb * 256; }
    __device__ __forceinline__ size_t b_row0(const pg8::Unit& u) const { return (size_t)u.e * ((size_t)NT * 256) + (size_t)u.pn * 256; }
    __device__ __forceinline__ int a_row(const pg8::Unit& u, int r) const { const int rr = r < u.rows ? r : 0; return list[u.e * SEQ + u.b * 256 + rr] >> 2; }
};

struct EpiGateUp {
    static constexpr bool HAS_MID = false; int mid_t;
    const int* list; const float* rstd; const float* bias; bf16_t* act;
    __device__ __forceinline__ void mid(ACC_T, const pg8::Unit&, int, int, int, int) const {}
    __device__ __forceinline__ void operator()(CACC_T, const pg8::Unit& u, int wr, int wc, int fr_in, int fq_in) const {
        int fr = fr_in, fq = fq_in; asm volatile("" : "+v"(fr), "+v"(fq));
        const int jj0 = u.pn * 128 + wc * 32 + fq * 8;
        const f32x4* bp = (const f32x4*)(bias + (size_t)u.e * (2 * DFF) + 2 * jj0);
        const f32x4 b0 = bp[0], b1 = bp[1], b2 = bp[2], b3 = bp[3];
        const float bg[8] = {b0[0], b0[2], b1[0], b1[2], b2[0], b2[2], b3[0], b3[2]}, bl[8] = {b0[1], b0[3], b1[1], b1[3], b2[1], b2[3], b3[1], b3[3]};
#pragma unroll
        for (int ai = 0; ai < 2; ++ai)
#pragma unroll
            for (int m = 0; m < 4; ++m) {
                const int r = ai * 128 + wr * 64 + m * 16 + fr;
                if (r < u.rows) {
                    const float rs = rstd[u.e * SEQ + u.b * 256 + r];
                    float o[8];
#pragma unroll
                    for (int i = 0; i < 8; ++i) { const float g0 = acc[ai][0][m][i >> 2][i & 3] * rs + bg[i], l0 = acc[ai][1][m][i >> 2][i & 3] * rs + bl[i];
                        const float g = fminf(g0, SWI_LIMIT), l = fminf(fmaxf(l0, -SWI_LIMIT), SWI_LIMIT);
                        o[i] = (l + 1.0f) * (g * sigmoid_fast(g * SWI_ALPHA)); }
                    u32x4 w; w.x = cvt_pk_bf16(o[0], o[1]); w.y = cvt_pk_bf16(o[2], o[3]); w.z = cvt_pk_bf16(o[4], o[5]); w.w = cvt_pk_bf16(o[6], o[7]);
                    *(u32x4*)(act + ((size_t)u.rb * 256 + r) * DFF + jj0) = w;
                }
                asm volatile("" ::: "memory");
            }
    }
};

struct EpiDown {
    static constexpr bool HAS_MID = false; int mid_t;
    const int* list; const float* gates; const float* bias; bf16_t* ys;
    __device__ __forceinline__ void mid(ACC_T, const pg8::Unit&, int, int, int, int) const {}
    __device__ __forceinline__ void operator()(CACC_T, const pg8::Unit& u, int wr, int wc, int fr_in, int fq_in) const {
        int fr = fr_in, fq = fq_in; asm volatile("" : "+v"(fr), "+v"(fq));
        const int col0 = u.pn * 256 + wc * 32 + fq * 8;
        f32x4 bv[2][2];
#pragma unroll
        for (int bj = 0; bj < 2; ++bj) { bv[bj][0] = *(const f32x4*)(bias + (size_t)u.e * DM + col0 + bj * 128); bv[bj][1] = *(const f32x4*)(bias + (size_t)u.e * DM + col0 + bj * 128 + 4); }
        asm volatile("" :: "v"(bv[0][0]), "v"(bv[0][1]), "v"(bv[1][0]), "v"(bv[1][1]));
#pragma unroll
        for (int ai = 0; ai < 2; ++ai)
#pragma unroll
            for (int m = 0; m < 4; ++m) {
                const int r = ai * 128 + wr * 64 + m * 16 + fr;
                if (r < u.rows) {
                    const int slot = list[u.e * SEQ + u.b * 256 + r]; const float g = gates[u.e * SEQ + u.b * 256 + r];
#pragma unroll
                    for (int bj = 0; bj < 2; ++bj)
                        *(u32x4*)(ys + (size_t)slot * DM + col0 + bj * 128) = pack8bf((acc[ai][bj][m][0] + bv[bj][0]) * g, (acc[ai][bj][m][1] + bv[bj][1]) * g);
                }
            }
    }
};

struct EpiPleGate {
    static constexpr bool HAS_MID = false; int mid_t;
    const bf16_t* ple; bf16_t* T; float* tss;
    __device__ __forceinline__ void mid(ACC_T, const pg8::Unit&, int, int, int, int) const {}
    __device__ __forceinline__ void operator()(CACC_T, const pg8::Unit& u, int wr, int wc, int fr_in, int fq_in) const {
        int fr = fr_in, fq = fq_in; asm volatile("" : "+v"(fr), "+v"(fq));
        const int row0 = u.pm * 256 + wr * 64 + fr, col0 = u.pn * 256 + wc * 32 + fq * 8;
#pragma unroll
        for (int ai = 0; ai < 2; ++ai)
#pragma unroll
            for (int m = 0; m < 4; ++m) { const size_t ro = (size_t)(row0 + ai * 128 + m * 16); float ss = 0.f;
#pragma unroll
                for (int bj = 0; bj < 2; ++bj) { float pv[8]; unpack8bf(*(const u32x4*)(ple + ro * DM + col0 + bj * 128), pv);
                    f32x4 t0, t1;
#pragma unroll
                    for (int i = 0; i < 4; ++i) { t0[i] = sigmoidf_(acc[ai][bj][m][0][i]) * pv[i]; t1[i] = sigmoidf_(acc[ai][bj][m][1][i]) * pv[4 + i]; ss += t0[i] * t0[i] + t1[i] * t1[i]; }
                    *(u32x4*)(T + ro * DM + col0 + bj * 128) = pack8bf(t0, t1); }
                ss += __shfl_xor(ss, 16); ss += __shfl_xor(ss, 32);
                if (fq == 0) tss[ro * 32 + u.pn * 4 + wc] = ss; }
    }
};
namespace att {
constexpr int D = 128, NW = 8, QBLK = 32, KVBLK = 64, QB = NW * QBLK;
constexpr int SHM_V = KVBLK * D * 2, SHM_K = KVBLK * D * 2;
constexpr int LDS_BYTES = 2 * SHM_V + 2 * SHM_K + NW * 64 * 4;
constexpr float SCALE = 0.08838834764831845f, THR = 8.f;
constexpr int QP = 1024, KP = 1024, OP = 2048;
#define KSWZ(row, colB) ((row) * 256 + ((colB) ^ (((row) & 7) << 4)))
#define SBAR() __builtin_amdgcn_sched_barrier(0)
__device__ __forceinline__ int v_st(int k, int c) { const int kk = (k & ~0xC) | ((k & 4) << 1) | ((k & 8) >> 1); return ((kk >> 3) * 4 + (c >> 5)) * 512 + ((kk & 7) * 32 + (c & 31)) * 2; }
__device__ __forceinline__ int v_rd_base(int lane) { return ((lane & 3) << 3) | (((lane >> 2) & 3) << 6) | (((lane >> 4) & 1) << 5) | (((lane >> 5) & 1) << 8); }
constexpr int v_rd_off(int d0, int ks, int half) { return d0 * 512 + ks * 4096 + half * 2048; }
__device__ __forceinline__ int crow(int r, int hi) { return (r & 3) + 8 * (r >> 2) + 4 * hi; }
__device__ __forceinline__ bf16x8 load8(const bf16_t* p) { return *reinterpret_cast<const bf16x8*>(p); }

__device__ __forceinline__ void mask_causal(f32x16& p0, f32x16& p1, int dq) {
    const float NEG = -__builtin_inff();
#pragma unroll
    for (int r = 0; r < 16; ++r) { const int c = (r & 3) + 8 * (r >> 2); if (dq - c < 0) p0[r] = NEG; if (dq - c - 32 < 0) p1[r] = NEG; }
}
__device__ __forceinline__ void mask_bits(f32x16& p0, f32x16& p1, unsigned lo, unsigned hi32, int hi) {
    const float NEG = -__builtin_inff(); lo >>= 4 * hi; hi32 >>= 4 * hi;
#pragma unroll
    for (int r = 0; r < 16; ++r) { const int c = (r & 3) + 8 * (r >> 2); if (!((lo >> c) & 1u)) p0[r] = NEG; if (!((hi32 >> c) & 1u)) p1[r] = NEG; }
}
__device__ __forceinline__ void mask_all(f32x16& p0, f32x16& p1, bool keep) {
    const float NEG = -__builtin_inff();
#pragma unroll
    for (int r = 0; r < 16; ++r) { p0[r] = keep ? p0[r] : NEG; p1[r] = keep ? p1[r] : NEG; }
}
__device__ __forceinline__ void partialSM(f32x16& p0, f32x16& p1, float& m_reg, float& mn, float& alpha) {
    float pmax = p0[0]; for (int r = 1; r < 16; ++r) pmax = fmaxf(pmax, p0[r]); for (int r = 0; r < 16; ++r) pmax = fmaxf(pmax, p1[r]);
    { auto rr = __builtin_amdgcn_permlane32_swap(__float_as_uint(pmax), __float_as_uint(pmax), false, false);
      pmax = fmaxf(__uint_as_float(rr[0]), __uint_as_float(rr[1])); }
    constexpr float C2 = 1.4426950408889634f * SCALE;
    if (__builtin_expect(__all((pmax - m_reg) * SCALE <= THR), 1)) { mn = m_reg; alpha = 1.f; }
    else { mn = fmaxf(m_reg, pmax); alpha = __builtin_amdgcn_exp2f((m_reg - mn) * C2); m_reg = mn; }
    const float mnL = -mn * C2;
    for (int r = 0; r < 16; ++r) p0[r] = fmaf(p0[r], C2, mnL); for (int r = 0; r < 16; ++r) p1[r] = fmaf(p1[r], C2, mnL);
    for (int r = 0; r < 16; ++r) p0[r] = __builtin_amdgcn_exp2f(p0[r]);
}
__device__ __forceinline__ void finishSM(f32x16& p0, f32x16& p1, float alpha, float& l_reg, bf16x8& pa0, bf16x8& pa1, bf16x8& pa2, bf16x8& pa3) {
    for (int r = 0; r < 16; ++r) p1[r] = __builtin_amdgcn_exp2f(p1[r]);
    float ps = 0; for (int r = 0; r < 16; ++r) ps += p0[r]; for (int r = 0; r < 16; ++r) ps += p1[r];
    { auto rr = __builtin_amdgcn_permlane32_swap(__float_as_uint(ps), __float_as_uint(ps), false, false);
      ps = __uint_as_float(rr[0]) + __uint_as_float(rr[1]); }
    l_reg = l_reg * alpha + ps;
#define PK4(P, B_, OUT) do { unsigned a0 = cvt_pk_bf16(P[B_+0], P[B_+1]), a1 = cvt_pk_bf16(P[B_+2], P[B_+3]);                          \
        unsigned b0 = cvt_pk_bf16(P[B_+4], P[B_+5]), b1 = cvt_pk_bf16(P[B_+6], P[B_+7]);                                             \
        auto r0 = __builtin_amdgcn_permlane32_swap(a0, b0, false, false); auto r1 = __builtin_amdgcn_permlane32_swap(a1, b1, false, false); \
        u32x4 w = {r0[0], r1[0], r0[1], r1[1]}; OUT = *reinterpret_cast<bf16x8*>(&w); } while (0)
    PK4(p0, 0, pa0); PK4(p0, 8, pa1); PK4(p1, 0, pa2); PK4(p1, 8, pa3);
#undef PK4
}
template <int KB>
__device__ __forceinline__ void qkt(f32x16& p0, f32x16& p1, const char* K_lds, int r32, int hi, const bf16x8* qr) {
    p0 = f32x16{}; p1 = f32x16{};
    const char* kb[4];
#pragma unroll
    for (int dd = 0; dd < 4; ++dd) kb[dd] = K_lds + KB * SHM_K + KSWZ(r32, (dd * 16 + hi * 8) * 2);
#pragma unroll
    for (int d0 = 0; d0 < 8; ++d0) { const char* a = kb[d0 & 3] + (d0 >> 2) * 128;
        bf16x8 b0 = *reinterpret_cast<const bf16x8*>(a);
        bf16x8 b1 = *reinterpret_cast<const bf16x8*>(a + 32 * 256);
        p0 = __builtin_amdgcn_mfma_f32_32x32x16_bf16(b0, qr[d0], p0, 0, 0, 0);
        p1 = __builtin_amdgcn_mfma_f32_32x32x16_bf16(b1, qr[d0], p1, 0, 0, 0); }
}
template <int VB>
__device__ __forceinline__ void pv_tile(f32x16* o, int vb0, bf16x8 pa0, bf16x8 pa1, bf16x8 pa2, bf16x8 pa3) {
#define TRRD(dst, off) asm volatile("ds_read_b64_tr_b16 %0, %1 offset:%2" : "=&v"(dst) : "v"(vb0), "i"(off) : "memory")
#define PV_D0(d0) do { s16x4 l0, l1, l2, l3, h0, h1, h2, h3; constexpr int b_ = VB * SHM_V + v_rd_off(d0, 0, 0); \
        TRRD(l0, b_); TRRD(h0, b_ + 2048); TRRD(l1, b_ + 4096); TRRD(h1, b_ + 6144); TRRD(l2, b_ + 8192); TRRD(h2, b_ + 10240); TRRD(l3, b_ + 12288); TRRD(h3, b_ + 14336); \
        asm volatile("s_waitcnt lgkmcnt(0)" ::: "memory"); SBAR();   \
        o[d0] = __builtin_amdgcn_mfma_f32_32x32x16_bf16(pa0, (bf16x8){l0[0], l0[1], l0[2], l0[3], h0[0], h0[1], h0[2], h0[3]}, o[d0], 0, 0, 0);   \
        o[d0] = __builtin_amdgcn_mfma_f32_32x32x16_bf16(pa1, (bf16x8){l1[0], l1[1], l1[2], l1[3], h1[0], h1[1], h1[2], h1[3]}, o[d0], 0, 0, 0);   \
        o[d0] = __builtin_amdgcn_mfma_f32_32x32x16_bf16(pa2, (bf16x8){l2[0], l2[1], l2[2], l2[3], h2[0], h2[1], h2[2], h2[3]}, o[d0], 0, 0, 0);   \
        o[d0] = __builtin_amdgcn_mfma_f32_32x32x16_bf16(pa3, (bf16x8){l3[0], l3[1], l3[2], l3[3], h3[0], h3[1], h3[2], h3[3]}, o[d0], 0, 0, 0); } while (0)
    PV_D0(0); PV_D0(1); PV_D0(2); PV_D0(3);
#undef PV_D0
#undef TRRD
}

struct BlockRef { const bf16_t* Q; const bf16_t* K; const bf16_t* V; bf16_t* O; int P0; int mode; const unsigned long long* bm; const unsigned* selw; };
struct Seam { bf16x8 qr[8]; bf16x8 st_v0, st_v1, st_k0, st_k1; };
#define ROWK(p, k0, rr) ((p) + (size_t)((k0) + (rr)) * KP + sc)
#define VMW() asm volatile("s_waitcnt vmcnt(0)" ::: "memory")
#define VMWN(n) asm volatile("s_waitcnt vmcnt(%0)" :: "i"(n) : "memory")
#define SLOAD_H(Kp, Vp, k0) do { S.st_v0 = load8(ROWK(Vp, k0, sr)); S.st_v1 = load8(ROWK(Vp, k0, 32 + sr));              \
                         S.st_k0 = load8(ROWK(Kp, k0, sr)); S.st_k1 = load8(ROWK(Kp, k0, 32 + sr)); } while (0)
#define SWRITE_HK(bf) do { *(bf16x8*)(K_lds + (bf) * SHM_K + kws) = S.st_k0; *(bf16x8*)(K_lds + (bf) * SHM_K + kws + 32 * 256) = S.st_k1; } while (0)
#define SWRITE_HV(bf) do { *(bf16x8*)(V_lds + (bf) * SHM_V + vst0) = S.st_v0; *(bf16x8*)(V_lds + (bf) * SHM_V + vst1) = S.st_v1; } while (0)
#define SWRITE_H(bf) do { SWRITE_HV(bf); SWRITE_HK(bf); } while (0)
__device__ __forceinline__ void attn_prime(const BlockRef& cur, char* lds, Seam& S, const int wid) {
    const int lane = lane_id_v(), tid = wid * 64 + lane, r32 = lane & 31, hi = lane >> 5;
    const int sr = tid >> 4, sc = (tid & 15) * 8, kws = KSWZ(sr, sc * 2); char* K_lds = lds + 2 * SHM_V;
    for (int d0 = 0; d0 < 8; ++d0) S.qr[d0] = load8(cur.Q + (size_t)(wid * QBLK + r32) * QP + d0 * 16 + hi * 8);
    SLOAD_H(cur.K, cur.V, 0); VMW(); SWRITE_HK(0);
    __syncthreads();
}
__device__ __forceinline__ void attn_block(const BlockRef& cur, const BlockRef& nxt, char* lds, Seam& S, const int wid) {
    const int lane = lane_id_v(), tid = wid * 64 + lane, r32 = lane & 31, hi = lane >> 5;
    const int NT = cur.P0 / KVBLK + 4;
    const int qlo = cur.P0 + wid * QBLK, qm = qlo + r32 - 4 * hi;
    char* V_lds = lds; char* K_lds = lds + 2 * SHM_V;
    float* ws = (float*)(lds + 2 * SHM_V + 2 * SHM_K) + wid * 64; float* li_l = ws, * al_l = ws + 32;
    float m_reg = -1e30f, l_reg = 0; f32x16 o[4] = {};
    const int sr = tid >> 4, sc = (tid & 15) * 8, vst0 = v_st(sr, sc), vst1 = v_st(32 + sr, sc), kws = KSWZ(sr, sc * 2);
    const int vb0 = (int)(uintptr_t)V_lds + v_rd_base(lane);
    const bf16_t* Kh = cur.K; const bf16_t* Vh = cur.V;
    const int mode = cur.mode, own = cur.P0 >> 8;
    unsigned mlo = 0u, mhi = 0u;
    if (mode == 1) mlo = cur.selw[(size_t)(wid * QBLK + r32) * NHEAD];
#define RESC(a) do { if (__any((a) < 1.f)) { if (hi == 0) al_l[r32] = (a); asm volatile("s_waitcnt lgkmcnt(0)" ::: "memory");              \
                     for (int d_ = 0; d_ < 4; ++d_) for (int r = 0; r < 16; ++r) o[d_][r] *= al_l[crow(r, hi)]; } } while (0)
#define KBASE(t) ((t) * KVBLK)
#define MLOAD(t) do { if (mode == 0) { unsigned r_ = (unsigned)r32; asm volatile("" : "+v"(r_));   \
        const u32x2 w_ = *(const u32x2*)(cur.bm + ((unsigned)(wid * QBLK) + r_) * (unsigned)(SEQ / 64) + (unsigned)(t)); mlo = w_.x; mhi = w_.y; } } while (0)
#define MASKT(P0_, P1_, t) do { const int kb_ = KBASE(t); \
        if (mode == 0) { mask_bits(P0_, P1_, mlo, mhi, hi); } \
        else { const int n_ = (t) >> 2; if (n_ == own) { if (kb_ + KVBLK - 1 > qlo) mask_causal(P0_, P1_, qm - kb_); } else mask_all(P0_, P1_, ((mlo >> n_) & 1u) != 0u); } } while (0)
    f32x16 pA0, pA1, pB0, pB1; float mnA, mnB, alA, alB; bf16x8 pa0, pa1, pa2, pa3;
    SWRITE_HV(0); SBAR();
    MLOAD(0);
    if (NT > 1) { SLOAD_H(Kh, Vh, KBASE(1)); }
    SBAR(); qkt<0>(pA0, pA1, K_lds, r32, hi, S.qr);
    MASKT(pA0, pA1, 0); partialSM(pA0, pA1, m_reg, mnA, alA);
    if (NT > 1) { VMW(); SWRITE_H(1); }
    __syncthreads();
#define HALF_STEP(PX0, PX1, mnX, alX, PY0, PY1, alY, t, KB, VB, SB) do {                                                      \
        SBAR(); MLOAD(t); qkt<KB>(PX0, PX1, K_lds, r32, hi, S.qr);                                             \
        finishSM(PY0, PY1, alY, l_reg, pa0, pa1, pa2, pa3); SBAR();                                                           \
        if ((t) + 1 < NT) { SLOAD_H(Kh, Vh, KBASE((t) + 1)); SBAR(); }                                               \
        pv_tile<VB>(o, vb0, pa0, pa1, pa2, pa3); MASKT(PX0, PX1, (t)); partialSM(PX0, PX1, m_reg, mnX, alX);                                        \
        __syncthreads();                                                                                                      \
        if ((t) + 1 < NT) { VMW(); SWRITE_H(SB); }                                                                          \
        RESC(alX); __syncthreads(); } while (0)
    for (int t = 1; t + 1 < NT; t += 2) {
        HALF_STEP(pB0, pB1, mnB, alB, pA0, pA1, alA, t, 1, 0, 0);
        HALF_STEP(pA0, pA1, mnA, alA, pB0, pB1, alB, t + 1, 0, 1, 1);
    }
    SBAR(); MLOAD(NT - 1); qkt<1>(pB0, pB1, K_lds, r32, hi, S.qr); SBAR();
    SLOAD_H(nxt.K, nxt.V, 0); SBAR();
#pragma unroll
    for (int d0 = 0; d0 < 8; ++d0) S.qr[d0] = load8(nxt.Q + (size_t)(wid * QBLK + r32) * QP + d0 * 16 + hi * 8);
    SBAR();
    finishSM(pA0, pA1, alA, l_reg, pa0, pa1, pa2, pa3); SBAR();
    pv_tile<0>(o, vb0, pa0, pa1, pa2, pa3);
    MASKT(pB0, pB1, NT - 1); partialSM(pB0, pB1, m_reg, mnB, alB); __syncthreads(); RESC(alB);
    finishSM(pB0, pB1, alB, l_reg, pa0, pa1, pa2, pa3); SBAR(); pv_tile<1>(o, vb0, pa0, pa1, pa2, pa3);
    SBAR(); VMWN(8); SWRITE_HK(0); SBAR();
    if (hi == 0) li_l[r32] = l_reg; asm volatile("s_waitcnt lgkmcnt(0)" ::: "memory");
    float rli[16];
#pragma unroll
    for (int r = 0; r < 16; ++r) rli[r] = __builtin_amdgcn_rcpf(li_l[crow(r, hi)]);
    bf16_t* Ow = cur.O + (size_t)(wid * QBLK) * OP;
    int r32e = r32, hie = hi; asm volatile("" : "+v"(r32e), "+v"(hie));
#pragma unroll
    for (int r = 0; r < 16; ++r) { const int orow = crow(r, hie);
#pragma unroll
        for (int d0 = 0; d0 < 4; ++d0) { const float v = o[d0][r] * rli[r];
            const float vn = __shfl_xor(v, 1);
            if ((r32e & 1) == 0) *(unsigned*)(Ow + (unsigned)(orow * OP + d0 * 32 + r32e)) = cvt_pk_bf16(v, vn); } }
    __syncthreads();
#undef RESC
#undef KBASE
#undef MLOAD
#undef MASKT
#undef HALF_STEP
}
#undef ROWK
#undef VMW
#undef VMWN
#undef SLOAD_H
#undef SWRITE_HK
#undef SWRITE_HV
#undef SWRITE_H
}
constexpr size_t MiB = 1u << 20;
constexpr size_t WS_CTL = 0, CTL_ZERO_BYTES = 1 * MiB;
constexpr int CW_TMO = 0, CW_BAR = 4096, CW_CNT = 16384;
constexpr size_t CTL_KMEAN = 512 * 1024;
constexpr size_t WS_ROPEA = 1 * MiB, WS_ROPEI = 2 * MiB;
constexpr size_t WS_WIN = 3 * MiB;
constexpr size_t WS_WBR = 48 * MiB, WS_WOUT = 56 * MiB, WS_WPG = 64 * MiB, WS_WPP = 72 * MiB;
constexpr size_t WS_WGU = 73 * MiB, WS_WD = 585 * MiB;
constexpr size_t WS_H1 = 841 * MiB, WS_PB = 873 * MiB;
constexpr size_t WS_QKV7 = 877 * MiB;
constexpr size_t WS_SG = 989 * MiB;
constexpr size_t WS_KI = 1053 * MiB, WS_WI = 1054 * MiB;
constexpr size_t WS_PLEB = 1055 * MiB;
constexpr size_t WS_SC = 1087 * MiB;
constexpr size_t WS_BM = 1343 * MiB, WS_SELB = 1351 * MiB;
constexpr size_t WS_OAB = 1352 * MiB, WS_MERGED = 1384 * MiB;
constexpr size_t WS_X1 = 1416 * MiB, WS_H2U = 1480 * MiB, WS_RSTD = 1512 * MiB;
constexpr size_t WS_LIST = 1513 * MiB, WS_GATES = 1514 * MiB;
constexpr size_t WS_ACT = 1515 * MiB;
constexpr size_t WS_YS = 1675 * MiB;
constexpr size_t WS_X2 = 1803 * MiB, WS_X2B = 1867 * MiB;
constexpr size_t WS_T = 1899 * MiB, WS_TSS = 1963 * MiB;
constexpr size_t WS_RSL = 1964 * MiB, WS_GTL = 1965 * MiB;
constexpr size_t WS_END = 1966 * MiB;

constexpr int NWAVES = 8;
constexpr int RING_BYTES = 131072, MISC_OFF = RING_BYTES, LDS_BYTES = RING_BYTES + 1024;
static_assert(att::LDS_BYTES <= RING_BYTES && pg8::STAGE_BYTES <= RING_BYTES, "LDS map");

typedef GAS unsigned gu32;
#define RLX_AGENT __ATOMIC_RELAXED, __HIP_MEMORY_SCOPE_AGENT
#define LDS_WAIT() asm volatile("s_waitcnt lgkmcnt(0)" ::: "memory")
#define VM_WAIT() asm volatile("s_waitcnt vmcnt(0)" ::: "memory")

#define XB_TMO      128
#define XB_XCNT(j)  (256  + 64 * (j))
#define XB_XSUB(j)  (1280 + 64 * (j))
#define XB_XGEN(j)  (2304 + 64 * (j))
#define XB_TOP      3328
#define XB_TOPGEN   3392
#define XCD_BAR_WORDS 3456
#define XB_SPIN_CAP (1u << 20)
__device__ __forceinline__ unsigned xb_ld(unsigned* p)              { return __hip_atomic_load(p, __ATOMIC_RELAXED, __HIP_MEMORY_SCOPE_AGENT); }
__device__ __forceinline__ unsigned xb_add(unsigned* p, unsigned v) { return __hip_atomic_fetch_add(p, v, __ATOMIC_RELAXED, __HIP_MEMORY_SCOPE_AGENT); }
__device__ __forceinline__ unsigned xb_xcc_id() { return (unsigned)__builtin_amdgcn_s_getreg((3 << 11) | 20) & 0xFu; }
#define XB_SPIN(cond, bar) do { unsigned _sp = 0; while (cond) { __builtin_amdgcn_s_sleep(1); \
    if ((++_sp & 255u) == 0u) { if (xb_ld(&(bar)[XB_TMO])) break; if (_sp > XB_SPIN_CAP) { atomicAdd(&(bar)[XB_TMO], 1u); break; } } } } while (0)
struct XcdBarrier { unsigned* bar; unsigned x; volatile LAS unsigned* st; int wave; };
__device__ __forceinline__ XcdBarrier xcd_barrier_post(unsigned* bar, volatile LAS unsigned* st, int wave) {
    XcdBarrier b; b.bar = bar; b.x = xb_xcc_id(); b.st = st; b.wave = wave;
    if (wave == 0 && lane_id_v() == 0) (void)xb_add(&bar[XB_XCNT(b.x)], 1u);
    return b;
}
__device__ __forceinline__ void xcd_barrier_complete(unsigned* bar, unsigned x, unsigned& nloc, unsigned& nx) {
    const unsigned G = gridDim.x * gridDim.y * gridDim.z;
    unsigned sum, cnt, mine, sp = 0u;
    for (;;) {
        sum = 0u; cnt = 0u; mine = 0u;
#pragma unroll
        for (unsigned j = 0; j < 16; ++j) { const unsigned c = xb_ld(&bar[XB_XCNT(j)]); sum += c; cnt += (c > 0u) ? 1u : 0u; mine = (j == x) ? c : mine; }
        if (sum == G) break;
        __builtin_amdgcn_s_sleep(1);
        if ((++sp & 255u) == 0u) { if (xb_ld(&bar[XB_TMO])) break; if (sp > XB_SPIN_CAP) { atomicAdd(&bar[XB_TMO], 1u); break; } }
    }
    nloc = mine > 0u ? mine : 1u; nx = cnt > 0u ? cnt : 1u;
}
__device__ __forceinline__ void xcd_barrier(const XcdBarrier& b) {
    asm volatile("s_waitcnt vmcnt(0)" ::: "memory");
    __syncthreads();
    if (b.wave == 0 && lane_id_v() == 0) {
        unsigned* bar = b.bar;
        __builtin_amdgcn_s_waitcnt(0);
        unsigned nloc = b.st[0], nx = b.st[1];
        if (nloc == 0u) { xcd_barrier_complete(bar, b.x, nloc, nx); b.st[0] = nloc; b.st[1] = nx; }
        const unsigned old = xb_add(&bar[XB_XSUB(b.x)], 1u);
        const unsigned gen = old / nloc;
        if (old + 1u == (gen + 1u) * nloc) {
            __builtin_amdgcn_fence(__ATOMIC_RELEASE, "agent");
            asm volatile("s_waitcnt vmcnt(0)" ::: "memory");
            const unsigned og = xb_add(&bar[XB_TOP], 1u);
            const unsigned tg = og / nx;
            if (og + 1u == (tg + 1u) * nx) xb_add(&bar[XB_TOPGEN], 1u);
            else XB_SPIN(xb_ld(&bar[XB_TOPGEN]) == tg, bar);
            __builtin_amdgcn_fence(__ATOMIC_ACQUIRE, "agent");
            xb_add(&bar[XB_XGEN(b.x)], 1u);
            asm volatile("s_waitcnt vmcnt(0)" ::: "memory");
        } else {
            XB_SPIN(xb_ld(&bar[XB_XGEN(b.x)]) == gen, bar);
            __builtin_amdgcn_fence(__ATOMIC_ACQUIRE, "agent");
            asm volatile("s_waitcnt vmcnt(0)" ::: "memory");
        }
    }
    __syncthreads();
}

__device__ __forceinline__ float wave_sum(float v) {
#pragma unroll
    for (int o = 1; o < 64; o <<= 1) v += __shfl_xor(v, o);
    return v;
}
__device__ __forceinline__ unsigned f2bf(float f) { unsigned u = __float_as_uint(f); return (u + 0x7fffu + ((u >> 16) & 1u)) >> 16; }
__device__ __forceinline__ unsigned pk2(float lo, float hi) { return f2bf(lo) | (f2bf(hi) << 16); }

struct MapId { __device__ __forceinline__ int operator()(int n) const { return n; } };
struct MapIn { __device__ __forceinline__ int operator()(int s) const {
    if (s < 4096) return s; if (s >= 4176) return s - 80;
    if (s < 4160) { const int j = s - 4096; return 11264 + (j < 32 ? j : 128 + (j - 32)); }
    return 11264 + 32 + (s - 4160); } };
struct MapGu { __device__ __forceinline__ int operator()(int s) const { return (s & ~255) + ((s & 1) << 7) + ((s & 255) >> 1); } };
constexpr int CV_PITCH = 128, CV_SCR = 12288;
struct P0Item { const float* W; int N; bf16_t* WT; int dpitch, koff, k0, n0, map; };
__device__ __forceinline__ void p0_item_load(const P0Item& it, int lane, f32x4 (&v)[16]) {
    int col = it.n0 + (lane & 15) * 4; if (col > it.N - 4) col = it.N - 4;
    const float* src = it.W + (size_t)(it.k0 + 2 * (lane >> 4)) * it.N + col;
#pragma unroll
    for (int i = 0; i < 8; ++i) { v[2 * i] = *(const f32x4*)(src + (size_t)(8 * i) * it.N); v[2 * i + 1] = *(const f32x4*)(src + (size_t)(8 * i + 1) * it.N); }
}
__device__ __forceinline__ void p0_item_load3(const P0Item& ia, const P0Item& ib, const P0Item& ic, int lane, f32x4 (&va)[16], f32x4 (&vb)[16], f32x4 (&vc)[16]) {
    int ca = ia.n0 + (lane & 15) * 4; if (ca > ia.N - 4) ca = ia.N - 4;
    int cb = ib.n0 + (lane & 15) * 4; if (cb > ib.N - 4) cb = ib.N - 4;
    int cc = ic.n0 + (lane & 15) * 4; if (cc > ic.N - 4) cc = ic.N - 4;
    const float* sa = ia.W + (size_t)(ia.k0 + 2 * (lane >> 4)) * ia.N + ca;
    const float* sb = ib.W + (size_t)(ib.k0 + 2 * (lane >> 4)) * ib.N + cb;
    const float* sc = ic.W + (size_t)(ic.k0 + 2 * (lane >> 4)) * ic.N + cc;
#pragma unroll
    for (int j = 0; j < 16; ++j) { const int ro = 8 * (j >> 1) + (j & 1);
        va[j] = *(const f32x4*)(sa + (size_t)ro * ia.N); vb[j] = *(const f32x4*)(sb + (size_t)ro * ib.N); vc[j] = *(const f32x4*)(sc + (size_t)ro * ic.N);
        __builtin_amdgcn_sched_barrier(0); }
}
__device__ __forceinline__ void p0_item_finish(const P0Item& it, LAS unsigned char* scr, int lane, const f32x4 (&v)[16]) {
    const int nq = lane & 15, q = lane >> 4;
    LAS unsigned char* wb = scr + nq * 512 + 4 * q;
#pragma unroll
    for (int i = 0; i < 8; ++i) { LAS unsigned char* wp = wb + ((i ^ (nq & 7)) << 4);
#pragma unroll
        for (int e = 0; e < 4; ++e) *(LAS unsigned*)(wp + e * 128) = cvt_pk_bf16(v[2 * i][e], v[2 * i + 1][e]); }
    LDS_WAIT(); asm volatile("" ::: "memory");
    const int ar = lane >> 3, kc = lane & 7;
    bf16x8 pc[8];
#pragma unroll
    for (int s8 = 0; s8 < 8; ++s8) pc[s8] = *(const LAS bf16x8*)(scr + (8 * s8 + ar) * 128 + ((kc ^ ((2 * s8 + (ar >> 2)) & 7)) << 4));
    LDS_WAIT(); asm volatile("" ::: "memory");
#pragma unroll
    for (int s8 = 0; s8 < 8; ++s8) { const int sn = it.n0 + 8 * s8 + ar;
        const int dr = (it.map == 0 || it.map == 3) ? MapId()(sn) : (it.map == 1 ? MapIn()(sn) : MapGu()(sn));
        bf16_t* dst = (it.map >= 2) ? it.WT + ((size_t)(dr >> 6) * (it.dpitch >> 6) + (it.k0 >> 6)) * 4096 + (dr & 63) * 64
                                     : it.WT + (size_t)dr * it.dpitch + it.koff + it.k0;
        if (sn < it.N) *(bf16x8*)(dst + 8 * kc) = pc[s8]; }
}
struct Args { const float* in[20]; float* out; unsigned char* ws; int ph_lo, ph_hi; };
enum { IN_X = 0, IN_P, IN_GMIX, IN_WIN, IN_GIDX, IN_BIDX, IN_WBRA, IN_WBRB, IN_WOUT, IN_GFFN, IN_WROUTER, IN_BROUTER, IN_WGU, IN_BGU, IN_WDOWN, IN_BDOWN, IN_WPP, IN_WPG, IN_GPLE, IN_GFINAL };

constexpr int NB_IN = (INW + 63) / 64;
constexpr int CI_IN = 32 * NB_IN, CI_BR = 16 * 32, CI_SQ = 32 * 32, CI_PP = 4 * 32, CI_GU1 = 32 * 64, CI_D1 = 32 * 32;
constexpr int CD0 = CI_IN, CD1 = CD0 + CI_BR, CD2 = CD1 + CI_BR, CD3 = CD2 + CI_SQ, CD4 = CD3 + CI_SQ, CD5 = CD4 + CI_PP;
constexpr int CE_GU = NEXP * CI_GU1, CE_ALL = CE_GU + NEXP * CI_D1;
__device__ __forceinline__ P0Item p0_dense_item(const Args& a, int it) {
    unsigned char* ws = a.ws;
    if (it < CD0) return P0Item{a.in[IN_WIN], INW, (bf16_t*)(ws + WS_WIN), DM, 0, 64 * (it / NB_IN), 64 * (it % NB_IN), 1};
    if (it < CD1) { const int r = it - CD0; return P0Item{a.in[IN_WBRA], DM, (bf16_t*)(ws + WS_WBR), DM, 0, 64 * (r / 32), 64 * (r % 32), 0}; }
    if (it < CD2) { const int r = it - CD1; return P0Item{a.in[IN_WBRB], DM, (bf16_t*)(ws + WS_WBR), DM, BRW, 64 * (r / 32), 64 * (r % 32), 0}; }
    if (it < CD3) { const int r = it - CD2; return P0Item{a.in[IN_WOUT], DM, (bf16_t*)(ws + WS_WOUT), DM, 0, 64 * (r / 32), 64 * (r % 32), 0}; }
    if (it < CD4) { const int r = it - CD3; return P0Item{a.in[IN_WPG], DM, (bf16_t*)(ws + WS_WPG), DM, 0, 64 * (r / 32), 64 * (r % 32), 0}; }
    { const int r = it - CD4; return P0Item{a.in[IN_WPP], DM, (bf16_t*)(ws + WS_WPP), PLED, 0, 64 * (r / 32), 64 * (r % 32), 0}; }
}
__device__ __forceinline__ P0Item p0_expert_item(const Args& a, int it) {
    unsigned char* ws = a.ws;
    if (it < CE_GU) { const int e = it / CI_GU1, r = it % CI_GU1; return P0Item{a.in[IN_WGU] + (size_t)e * DM * (2 * DFF), 2 * DFF, (bf16_t*)(ws + WS_WGU) + (size_t)e * (2 * DFF) * DM, DM, 0, 64 * (r / 64), 64 * (r % 64), 2}; }
    { const int r2 = it - CE_GU, e = r2 / CI_D1, r = r2 % CI_D1; return P0Item{a.in[IN_WDOWN] + (size_t)e * DFF * DM, DM, (bf16_t*)(ws + WS_WD) + (size_t)e * DM * DFF, DFF, 0, 64 * (r / 32), 64 * (r % 32), 3}; }
}
template <int EXPERT>
__device__ __forceinline__ void p0_convert_strided(const Args& a, LAS unsigned char* scr, int lane, int first, int stride, int n_items) {
    if (first >= n_items) return;
    P0Item cur = EXPERT ? p0_expert_item(a, first) : p0_dense_item(a, first), nxt = cur; f32x4 va[16], vb[16];
    p0_item_load(cur, lane, va);
    for (int it = first; it < n_items; it += 2 * stride) {
        const bool h1 = it + stride < n_items;
        if (h1) { nxt = EXPERT ? p0_expert_item(a, it + stride) : p0_dense_item(a, it + stride); p0_item_load(nxt, lane, vb); }
        p0_item_finish(cur, scr, lane, va);
        if (!h1) break;
        const bool h2 = it + 2 * stride < n_items;
        if (h2) { cur = EXPERT ? p0_expert_item(a, it + 2 * stride) : p0_dense_item(a, it + 2 * stride); p0_item_load(cur, lane, va); }
        p0_item_finish(nxt, scr, lane, vb);
        if (!h2) break;
    }
}
__device__ __forceinline__ void p0_prologue(const Args& a, LAS unsigned char* lds, int c, int G, int wave, int lane) {
    unsigned char* ws = a.ws;
    LAS unsigned char* scr = lds + wave * CV_SCR;
    const int gw = c * NWAVES + wave, NGW = G * NWAVES;
    p0_convert_strided<0>(a, scr, lane, gw, NGW, CD5);
    { const float* X = a.in[IN_X]; const f32x4* g4 = (const f32x4*)a.in[IN_GMIX]; bf16_t* H1 = (bf16_t*)(ws + WS_H1);
      for (int m = gw; m < SEQ; m += NGW) { const f32x4* xr = (const f32x4*)(X + (size_t)m * DM) + lane; f32x4 v[8]; float s = 0.f;
#pragma unroll
          for (int j = 0; j < 8; ++j) { v[j] = xr[64 * j]; s += (v[j].x * v[j].x + v[j].y * v[j].y) + (v[j].z * v[j].z + v[j].w * v[j].w); }
          const float rstd = rsqrtf(wave_sum(s) * (1.f / DM) + EPS);
          unsigned long long* o8 = (unsigned long long*)(H1 + (size_t)m * DM) + lane;
#pragma unroll
          for (int j = 0; j < 8; ++j) { const f32x4 g = g4[lane + 64 * j];
              o8[64 * j] = (unsigned long long)pk2(v[j].x * rstd * g.x, v[j].y * rstd * g.y) | ((unsigned long long)pk2(v[j].z * rstd * g.z, v[j].w * rstd * g.w) << 32); } } }
    { const f32x4* P4 = (const f32x4*)a.in[IN_P]; unsigned long long* o8 = (unsigned long long*)(ws + WS_PB);
      for (int i = gw * 64 + lane; i < SEQ * PLED / 4; i += NGW * 64) { const f32x4 v = P4[i]; o8[i] = (unsigned long long)pk2(v.x, v.y) | ((unsigned long long)pk2(v.z, v.w) << 32); } }
    { float* RA = (float*)(ws + WS_ROPEA); float* RI = (float*)(ws + WS_ROPEI);
      for (int i = gw * 64 + lane; i < SEQ * 24; i += NGW * 64) { const int pos = i / 24, j = i % 24;
          const double ex = (j < 16) ? (double)j / 16.0 : (double)(j - 16) / 8.0;
          const float inv = (float)(1.0 / pow(500000.0, ex)); const float ang = (float)pos * inv;
          const float cv = (float)cos((double)ang), sv = (float)sin((double)ang);
          if (j < 16) { RA[((size_t)pos * 16 + j) * 2] = cv; RA[((size_t)pos * 16 + j) * 2 + 1] = sv; } else { RI[((size_t)pos * 8 + (j - 16)) * 2] = cv; RI[((size_t)pos * 8 + (j - 16)) * 2 + 1] = sv; } } }
}

__device__ __forceinline__ int cv_ticket(volatile LAS unsigned* ctr, int lane) {
    unsigned t = 0; if (lane == 0) t = __hip_atomic_fetch_add((LAS unsigned*)ctr, 1u, __ATOMIC_RELAXED, __HIP_MEMORY_SCOPE_WORKGROUP);
    return (int)__builtin_amdgcn_readfirstlane(t);
}
__device__ __forceinline__ void p2_convert_experts(const Args& a, LAS unsigned char* scr, volatile LAS unsigned* ctr, int c, int G, int lane, volatile LAS unsigned* flag, unsigned stop_at) {
    const int n_cu = (CE_ALL - c + G - 1) / G;
    const bool adj = (CE_ALL % (6 * G)) == 0;
#define CV_ITEM(j) (adj ? ((tk / 6) * G + c) * 6 + (j) : (tk + (j)) * G + c)
    for (;;) {
        if (stop_at != 0xffffffffu && (unsigned)__builtin_amdgcn_readfirstlane((int)*flag) >= stop_at) return;
        unsigned t0 = 0; if (lane == 0) t0 = __hip_atomic_fetch_add((LAS unsigned*)ctr, 6u, __ATOMIC_RELAXED, __HIP_MEMORY_SCOPE_WORKGROUP);
        const int tk = (int)__builtin_amdgcn_readfirstlane(t0);
        if (tk >= n_cu) return;
        if (tk + 6 <= n_cu) {
            f32x4 va[16], vb[16], vc[16];
#pragma unroll 1
            for (int h = 0; h < 2; ++h) {
                const P0Item i0 = p0_expert_item(a, CV_ITEM(3 * h + 0)), i1 = p0_expert_item(a, CV_ITEM(3 * h + 1)), i2 = p0_expert_item(a, CV_ITEM(3 * h + 2));
                p0_item_load3(i0, i1, i2, lane, va, vb, vc);
                p0_item_finish(i0, scr, lane, va); p0_item_finish(i1, scr, lane, vb); p0_item_finish(i2, scr, lane, vc);
            }
        } else {
            for (int k = tk; k < n_cu; ++k) { f32x4 v[16]; const P0Item it = p0_expert_item(a, k * G + c); p0_item_load(it, lane, v); p0_item_finish(it, scr, lane, v); }
        }
    }
#undef CV_ITEM
}
#ifndef REPEAT_MASK
#define REPEAT_MASK 0
#endif
#define P2_NREP(k) ((((REPEAT_MASK) >> (k)) & 1) ? 2 : 1)
#ifndef P2_NIDX
#define P2_NIDX 4
#endif
__device__ __forceinline__ unsigned f2ord(float f) { unsigned b = __float_as_uint(f); if ((b << 1) == 0u) b = 0u; return b ^ ((b >> 31) ? 0xffffffffu : 0x80000000u); }
__device__ __forceinline__ void idx_scores(const Args& a, int q0, int lane_in) {
    unsigned char* ws = a.ws;
    const bf16_t* QI = (const bf16_t*)(ws + WS_QKV7) + (size_t)3 * SEQ * BRW; const bf16_t* KI = (const bf16_t*)(ws + WS_KI); const float* WI = (const float*)(ws + WS_WI);
    float* SC = (float*)(ws + WS_SC);
    int lane = lane_in; asm volatile("" : "+v"(lane));
    const int r = lane & 31, hh = lane >> 5;
    {
        bf16x8 af[2][4]; float wreg[2][16];
#pragma unroll
        for (int t2 = 0; t2 < 2; ++t2) { const int qa = q0 + 2 * t2 + (r >> 4);
#pragma unroll
            for (int s = 0; s < 4; ++s) af[t2][s] = *(const bf16x8*)(QI + (size_t)qa * BRW + (r & 15) * IDXD + 16 * s + 8 * hh);
#pragma unroll
            for (int i = 0; i < 16; ++i) { const int row = (i & 3) + 8 * (i >> 2) + 4 * hh; wreg[t2][i] = WI[(size_t)(q0 + 2 * t2 + (row >> 4)) * IDXH + (row & 15)]; } }
        const int ntile = ((q0 + 3) >> 5) + 1;
#define IDX_LOADB(dst, tile) do { const int tl_ = (tile) < 256 ? (tile) : 255; _Pragma("unroll") for (int s = 0; s < 4; ++s) dst[s] = *(const bf16x8*)(KI + (size_t)(32 * tl_ + r) * IDXD + 16 * s + 8 * hh); } while (0)
#define IDX_TILE(bc, jt_) do { _Pragma("unroll") for (int t2 = 0; t2 < 2; ++t2) { \
            f32x16 ac = {}; \
            _Pragma("unroll") for (int s = 0; s < 4; ++s) ac = __builtin_amdgcn_mfma_f32_32x32x16_bf16(af[t2][s], bc[s], ac, 0, 0, 0); \
            float s0 = 0.f, s1 = 0.f; \
            _Pragma("unroll") for (int i = 0; i < 8; ++i) { s0 += wreg[t2][i] * __builtin_amdgcn_fmed3f(ac[i], 0.f, 3.0e38f); s1 += wreg[t2][8 + i] * __builtin_amdgcn_fmed3f(ac[8 + i], 0.f, 3.0e38f); }     \
            const float send = hh ? s0 : s1, keep = hh ? s1 : s0; \
            const float tot = keep + __shfl_xor(send, 32); \
            SC[(size_t)(q0 + 2 * t2 + hh) * SEQ + 32 * (jt_) + r] = tot; } } while (0)
        bf16x8 b0[4], b1[4], b2[4], b3[4];
        IDX_LOADB(b0, 0); IDX_LOADB(b1, 1); IDX_LOADB(b2, 2); IDX_LOADB(b3, 3);
        for (int jt = 0; jt < ntile; jt += 4) {
            { bf16x8 bc[4]; _Pragma("unroll") for (int s = 0; s < 4; ++s) bc[s] = b0[s]; IDX_LOADB(b0, jt + 4); IDX_TILE(bc, jt); }
            if (jt + 1 < ntile) { bf16x8 bc[4]; _Pragma("unroll") for (int s = 0; s < 4; ++s) bc[s] = b1[s]; IDX_LOADB(b1, jt + 5); IDX_TILE(bc, jt + 1); }
            if (jt + 2 < ntile) { bf16x8 bc[4]; _Pragma("unroll") for (int s = 0; s < 4; ++s) bc[s] = b2[s]; IDX_LOADB(b2, jt + 6); IDX_TILE(bc, jt + 2); }
            if (jt + 3 < ntile) { bf16x8 bc[4]; _Pragma("unroll") for (int s = 0; s < 4; ++s) bc[s] = b3[s]; IDX_LOADB(b3, jt + 7); IDX_TILE(bc, jt + 3); }
        }
#undef IDX_LOADB
#undef IDX_TILE
    }
}
__device__ __forceinline__ void idx_select_rows(const Args& a, int q0, int nrows, int lane_in) {
    unsigned char* ws = a.ws;
    float* SC = (float*)(ws + WS_SC); unsigned long long* BM = (unsigned long long*)(ws + WS_BM);
    int lane = lane_in;
    {
        for (int qq = 0; qq < nrows; ++qq) {
            asm volatile("" : "+v"(lane));
            const int t = q0 + qq;
            unsigned long long* brow = BM + (size_t)t * (SEQ / 64);
            if (t < DSA_TOPK) {
#pragma unroll
                for (int w2 = 0; w2 < 2; ++w2) { const int j = lane + 64 * w2, lo = 64 * j;
                    brow[j] = (t >= lo + 63) ? ~0ull : (t < lo ? 0ull : ((2ull << (t - lo)) - 1ull)); }
                continue;
            }
            const int nj = (t >> 6) + 1;
            unsigned u[128];
            const float* srow = SC + (size_t)t * SEQ;
#pragma unroll
            for (int ch = 0; ch < 8; ++ch) {
                const float* cb = (ch * 16 < nj) ? srow : srow - 1024 * ch;
#pragma unroll
                for (int jj = 0; jj < 16; ++jj) { const int j = ch * 16 + jj;
                    u[j] = __float_as_uint(__builtin_nontemporal_load(cb + lane + 64 * j)); }
            }
#pragma unroll
            for (int ch = 0; ch < 8; ++ch) {
                if (ch * 16 < nj) {
#pragma unroll
                    for (int jj = 0; jj < 16; ++jj) { const int j = ch * 16 + jj, key = 64 * j + lane; const int neg = (t - key) >> 31;
                        u[j] = f2ord(__uint_as_float(u[j])) & ~(unsigned)neg; }
                } else {
#pragma unroll
                    for (int jj = 0; jj < 16; ++jj) u[ch * 16 + jj] = 0u;
                }
            }
            unsigned T = 0u; int Ti = 0; bool exact = false;
            for (int b = 31; b >= 0; --b) {
                const unsigned Tc = T | (1u << b); int cnt = 0;
#pragma unroll
                for (int ch = 0; ch < 8; ++ch) {
                    if (ch * 16 < nj) {
#pragma unroll
                        for (int jj = 0; jj < 16; ++jj) { cnt += __popcll(__ballot(u[ch * 16 + jj] >= Tc)); if ((jj & 3) == 3) __builtin_amdgcn_sched_barrier(0); }
                    }
                }
                if (cnt >= DSA_TOPK) T = Tc;
                if (cnt == DSA_TOPK) { exact = true; break; }
            }
            if (!exact) {
                for (int b = 12; b >= 0; --b) {
                    const int Tic = Ti | (1 << b); int cnt = 0; unsigned Tl = T; asm volatile("" : "+s"(Tl));
#pragma unroll
                    for (int ch = 0; ch < 8; ++ch) {
                        if (ch * 16 < nj) {
#pragma unroll
                            for (int jj = 0; jj < 16; ++jj) { const int j = ch * 16 + jj;
                                cnt += __popcll(__ballot((u[j] > Tl) || (u[j] == Tl && lane <= (SEQ - 1 - 64 * j) - Tic))); if ((jj & 3) == 3) __builtin_amdgcn_sched_barrier(0); }
                        }
                    }
                    if (cnt >= DSA_TOPK) Ti = Tic;
                    if (cnt == DSA_TOPK) break;
                }
            }
            int w0l = 0, w0h = 0, w1l = 0, w1h = 0; asm volatile("" : "+s"(T), "+s"(Ti));
#pragma unroll
            for (int ch = 0; ch < 8; ++ch) {
                if (ch * 16 < nj) {
#pragma unroll
                    for (int jj = 0; jj < 16; ++jj) { const int j = ch * 16 + jj;
                        const unsigned long long word = __ballot((u[j] > T) || (u[j] == T && lane <= (SEQ - 1 - 64 * j) - Ti));
                        const int lo = (int)(unsigned)word, hi = (int)(unsigned)(word >> 32);
                        if (j < 64) { w0l = (lane == (j & 63)) ? lo : w0l; w0h = (lane == (j & 63)) ? hi : w0h; }
                        else { w1l = (lane == (j & 63)) ? lo : w1l; w1h = (lane == (j & 63)) ? hi : w1h; }
                        if ((jj & 3) == 3) __builtin_amdgcn_sched_barrier(0); }
                }
            }
            brow[lane] = ((unsigned long long)(unsigned)w0h << 32) | (unsigned)w0l;
            brow[64 + lane] = ((unsigned long long)(unsigned)w1h << 32) | (unsigned)w1l;
        }
    }
}
__device__ __forceinline__ void p2_indexer_and_convert(const Args& a, LAS unsigned char* lds, volatile LAS unsigned* MISC, int c, int G, int wave, int lane) {
    const int w = wave & 3; volatile LAS unsigned* flag = MISC + 24 + w; volatile LAS unsigned* ctr = MISC + 16;
    LAS unsigned char* scr = lds + wave * CV_SCR;
    if (wave < 4) {
        for (int p = c; p < 256; p += G) {
            const int qh = (511 - p) * 16 + w * 4, ql = p * 16 + w * 4;
            for (int rep_s = 0; rep_s < P2_NREP(12); ++rep_s) { idx_scores(a, qh, lane); idx_scores(a, ql, lane); }
        }
        VM_WAIT();
    }
    p2_convert_experts(a, scr, ctr, c, G, lane, flag, 0xffffffffu);
    __syncthreads();
    for (int p = c; p < 256; p += G) {
        for (int rep_q = 0; rep_q < P2_NREP(13); ++rep_q) { idx_select_rows(a, p * 16 + 2 * wave, 2, lane); idx_select_rows(a, (511 - p) * 16 + 2 * wave, 2, lane); }
    }
}
__device__ __forceinline__ void p2_moba_gate(const Args& a, LAS unsigned char* lds, int c, int G, int wave, int lane) {
    unsigned char* ws = a.ws;
    const bf16_t* QBp = (const bf16_t*)(ws + WS_QKV7) + (size_t)4 * SEQ * BRW; const float* KM = (const float*)(ws + WS_CTL + CTL_KMEAN); unsigned* SELB = (unsigned*)(ws + WS_SELB);
    const int r = lane & 31, hh = lane >> 5;
    LAS float* scr = (LAS float*)(lds + wave * 4352);
    for (int base = c * 256; base < SEQ * NHEAD; base += G * 256) {
        const int h = base >> 13, t0 = (base & (SEQ - 1)) + 32 * wave, own = t0 >> 8;
        if (own > 0) {
            f32x16 acc = {};
#pragma unroll
            for (int s8 = 0; s8 < 8; ++s8) {
                const bf16x8 af = *(const bf16x8*)(QBp + (size_t)(t0 + r) * BRW + h * HD + 16 * s8 + 8 * hh);
                const f32x4 k0 = *(const f32x4*)(KM + (size_t)r * BRW + h * HD + 16 * s8 + 8 * hh), k1 = *(const f32x4*)(KM + (size_t)r * BRW + h * HD + 16 * s8 + 8 * hh + 4);
                float kv[8];
#pragma unroll
                for (int i = 0; i < 4; ++i) { kv[i] = k0[i] * (1.f / MOBA_BLK); kv[4 + i] = k1[i] * (1.f / MOBA_BLK); }
                unsigned bh[4], bl[4];
#pragma unroll
                for (int i = 0; i < 4; ++i) { bh[i] = cvt_pk_bf16(kv[2 * i], kv[2 * i + 1]); bl[i] = cvt_pk_bf16(kv[2 * i] - bf_lo(bh[i]), kv[2 * i + 1] - bf_hi(bh[i])); }
                u32x4 BH = {bh[0], bh[1], bh[2], bh[3]}, BL = {bl[0], bl[1], bl[2], bl[3]};
                acc = __builtin_amdgcn_mfma_f32_32x32x16_bf16(af, *(bf16x8*)&BH, acc, 0, 0, 0);
                acc = __builtin_amdgcn_mfma_f32_32x32x16_bf16(af, *(bf16x8*)&BL, acc, 0, 0, 0);
            }
#pragma unroll
            for (int i = 0; i < 16; ++i) scr[((i & 3) + 8 * (i >> 2) + 4 * hh) * 33 + r] = acc[i];
            LDS_WAIT(); asm volatile("" ::: "memory");
            float v[32];
#pragma unroll
            for (int m = 0; m < 32; ++m) v[m] = scr[r * 33 + m];
            unsigned selw = 0u;
#pragma unroll
            for (int rd = 0; rd < 3; ++rd) { float best = -__builtin_inff(); int bi = -1;
#pragma unroll
                for (int m = 0; m < 32; ++m) { if (m < own && v[m] > best) { best = v[m]; bi = m; } }
                if (bi >= 0) selw |= 1u << bi;
#pragma unroll
                for (int m = 0; m < 32; ++m) v[m] = (m == bi) ? -__builtin_inff() : v[m]; }
            if (lane < 32) SELB[(size_t)(t0 + r) * NHEAD + h] = selw;
            LDS_WAIT(); asm volatile("" ::: "memory");
        } else { if (lane < 32) SELB[(size_t)(t0 + r) * NHEAD + h] = 0u; }
    }
}

__device__ __forceinline__ void p6_route(const Args& a, LAS unsigned char* lds, int c, int G, int wave, int lane) {
    unsigned char* ws = a.ws;
    const float* X1 = (const float*)(ws + WS_X1); const float* gf = a.in[IN_GFFN]; const float* WR = a.in[IN_WROUTER]; const float* BR = a.in[IN_BROUTER];
    bf16_t* H2U = (bf16_t*)(ws + WS_H2U); float* RSTD = (float*)(ws + WS_RSTD); int* LIST = (int*)(ws + WS_LIST); float* GATES = (float*)(ws + WS_GATES);
    float* RSL = (float*)(ws + WS_RSL); float* GTL = (float*)(ws + WS_GTL);
    unsigned* CNT = (unsigned*)(ws + WS_CTL) + CW_CNT;
    LAS float* part = (LAS float*)lds;
    LAS float* ssp = (LAS float*)(lds + 32768);
    LAS int* hist = (LAS int*)(lds + 32768 + 2048);
    LAS int* hbase = hist + 32;
    const int r = lane & 31, hh = lane >> 5;
    for (int un = c; un < SEQ / 32; un += G) {
        const int t0 = un * 32;
        f32x16 acc = {}; float ss = 0.f;
        const int kbase = wave * 256;
        for (int ks = 0; ks < 16; ++ks) {
            const int k0 = kbase + ks * 16 + 8 * hh;
            const f32x4 xa = *(const f32x4*)(X1 + (size_t)(t0 + r) * DM + k0), xb = *(const f32x4*)(X1 + (size_t)(t0 + r) * DM + k0 + 4);
            const f32x4 ga = *(const f32x4*)(gf + k0), gb = *(const f32x4*)(gf + k0 + 4);
            float av[8], bv[8];
#pragma unroll
            for (int i = 0; i < 4; ++i) { ss += xa[i] * xa[i] + xb[i] * xb[i]; av[i] = xa[i] * ga[i]; av[4 + i] = xb[i] * gb[i]; }
#pragma unroll
            for (int i = 0; i < 8; ++i) bv[i] = WR[(size_t)(k0 + i) * NEXP + r];
            unsigned ahi[4], alo[4], bhi[4], blo[4];
#pragma unroll
            for (int i = 0; i < 4; ++i) { ahi[i] = cvt_pk_bf16(av[2 * i], av[2 * i + 1]); alo[i] = cvt_pk_bf16(av[2 * i] - bf_lo(ahi[i]), av[2 * i + 1] - bf_hi(ahi[i]));
                                          bhi[i] = cvt_pk_bf16(bv[2 * i], bv[2 * i + 1]); blo[i] = cvt_pk_bf16(bv[2 * i] - bf_lo(bhi[i]), bv[2 * i + 1] - bf_hi(bhi[i])); }
            u32x4 AH = {ahi[0], ahi[1], ahi[2], ahi[3]}, AL = {alo[0], alo[1], alo[2], alo[3]}, BH = {bhi[0], bhi[1], bhi[2], bhi[3]}, BL = {blo[0], blo[1], blo[2], blo[3]};
            *(u32x4*)(H2U + (size_t)(t0 + r) * DM + k0) = AH;
            acc = __builtin_amdgcn_mfma_f32_32x32x16_bf16(*(bf16x8*)&AH, *(bf16x8*)&BH, acc, 0, 0, 0);
            acc = __builtin_amdgcn_mfma_f32_32x32x16_bf16(*(bf16x8*)&AH, *(bf16x8*)&BL, acc, 0, 0, 0);
            acc = __builtin_amdgcn_mfma_f32_32x32x16_bf16(*(bf16x8*)&AL, *(bf16x8*)&BH, acc, 0, 0, 0);
        }
#pragma unroll
        for (int i = 0; i < 16; ++i) part[(wave * 32 + (i & 3) + 8 * (i >> 2) + 4 * hh) * 32 + r] = acc[i];
        ssp[(wave * 32 + r) * 2 + hh] = ss;
        const bool w0 = (wave == 0) && (lane < 32);
        if (w0) hist[lane] = 0;
        __syncthreads();
        int ek[4]; int pl[4]; float gk[4]; float rstd = 0.f;
        if (w0) {
            const int tk = lane; float lg[32]; float s2 = 0.f;
#pragma unroll
            for (int w = 0; w < 8; ++w) s2 += ssp[(w * 32 + tk) * 2] + ssp[(w * 32 + tk) * 2 + 1];
            rstd = rsqrtf(s2 * (1.f / DM) + EPS);
#pragma unroll
            for (int e = 0; e < 32; ++e) { float s = 0.f;
#pragma unroll
                for (int w = 0; w < 8; ++w) s += part[(w * 32 + tk) * 32 + e];
                lg[e] = s * rstd + BR[e]; }
            float tv[4];
#pragma unroll
            for (int k = 0; k < 4; ++k) { float best = -__builtin_inff(); int bi = 0;
#pragma unroll
                for (int e = 0; e < 32; ++e) { if (lg[e] > best) { best = lg[e]; bi = e; } }
                tv[k] = best; ek[k] = bi;
#pragma unroll
                for (int e = 0; e < 32; ++e) lg[e] = (e == bi) ? -__builtin_inff() : lg[e]; }
            float den = 0.f;
#pragma unroll
            for (int k = 0; k < 4; ++k) { gk[k] = __expf(tv[k] - tv[0]); den += gk[k]; }
            const float rden = 1.f / den;
#pragma unroll
            for (int k = 0; k < 4; ++k) { gk[k] *= rden; pl[k] = __hip_atomic_fetch_add(&hist[ek[k]], 1, __ATOMIC_RELAXED, __HIP_MEMORY_SCOPE_WORKGROUP); }
        }
        __syncthreads();
        if (w0) { const int hc = hist[lane]; hbase[lane] = hc > 0 ? (int)atomicAdd(&CNT[lane], (unsigned)hc) : 0; }
        __syncthreads();
        if (w0) { const int tok = t0 + lane; RSTD[tok] = rstd;
#pragma unroll
            for (int k = 0; k < 4; ++k) { const int pos = hbase[ek[k]] + pl[k]; if (pos < SEQ) { LIST[(size_t)ek[k] * SEQ + pos] = tok * 4 + k; RSL[(size_t)ek[k] * SEQ + pos] = rstd; GTL[(size_t)ek[k] * SEQ + pos] = gk[k]; } GATES[tok * 4 + k] = gk[k]; } }
        __syncthreads();
    }
}

__device__ __forceinline__ void p9_x2(const Args& a, int c, int G, int wave, int lane) {
    unsigned char* ws = a.ws; const float* X1 = (const float*)(ws + WS_X1); const bf16_t* YS = (const bf16_t*)(ws + WS_YS); bf16_t* X2B = (bf16_t*)(ws + WS_X2B);
    const int gw = c * NWAVES + wave, NGW = G * NWAVES;
    for (int m = gw; m < SEQ; m += NGW) {
#pragma unroll
        for (int j = 0; j < 4; ++j) { const int col = (j * 64 + lane) * 8; const size_t o = (size_t)m * DM + col;
            f32x4 v0 = *(const f32x4*)(X1 + o), v1 = *(const f32x4*)(X1 + o + 4);
#pragma unroll
            for (int k = 0; k < 4; ++k) { float y[8]; unpack8bf(*(const u32x4*)(YS + ((size_t)m * 4 + k) * DM + col), y);
#pragma unroll
                for (int i = 0; i < 4; ++i) { v0[i] += y[i]; v1[i] += y[4 + i]; } }
            *(u32x4*)(X2B + o) = pack8bf(v0, v1); }
    }
}
__device__ __forceinline__ void p11_final(const Args& a, int c, int G, int wave, int lane) {
    unsigned char* ws = a.ws; const bf16_t* X2B = (const bf16_t*)(ws + WS_X2B); const bf16_t* T = (const bf16_t*)(ws + WS_T); const float* TSS = (const float*)(ws + WS_TSS);
    const float* gp = a.in[IN_GPLE]; const float* gfin = a.in[IN_GFINAL]; float* out = a.out;
    const int gw = c * NWAVES + wave, NGW = G * NWAVES;
    for (int m = gw; m < SEQ; m += NGW) {
        float ts = (lane < 32) ? TSS[(size_t)m * 32 + lane] : 0.f; ts = wave_sum(ts);
        const float rt = rsqrtf(ts * (1.f / DM) + EPS);
        f32x4 v[8]; float s = 0.f;
#pragma unroll
        for (int j = 0; j < 8; ++j) { const size_t o = (size_t)m * DM + (j * 64 + lane) * 4; const u32x2 xw = *(const u32x2*)(X2B + o), tw = *(const u32x2*)(T + o); const f32x4 g = *(const f32x4*)(gp + (j * 64 + lane) * 4);
            const f32x4 x = {bf_lo(xw.x), bf_hi(xw.x), bf_lo(xw.y), bf_hi(xw.y)}, t = {bf_lo(tw.x), bf_hi(tw.x), bf_lo(tw.y), bf_hi(tw.y)};
            v[j] = x + t * rt * g; s += (v[j].x * v[j].x + v[j].y * v[j].y) + (v[j].z * v[j].z + v[j].w * v[j].w); }
        const float r3 = rsqrtf(wave_sum(s) * (1.f / DM) + EPS);
#pragma unroll
        for (int j = 0; j < 8; ++j) { const f32x4 g = *(const f32x4*)(gfin + (j * 64 + lane) * 4); *(f32x4*)(out + (size_t)m * DM + (j * 64 + lane) * 4) = v[j] * r3 * g; }
    }
}
constexpr int N_PHASES = 12;
__global__ void __launch_bounds__(NWAVES * 64, 2) hybrid_fwd(Args args) {
    extern __shared__ __attribute__((aligned(16))) unsigned char lds_raw[];
    LAS unsigned char* lds = (LAS unsigned char*)lds_raw;
    volatile LAS unsigned* MISC = (volatile LAS unsigned*)(lds + MISC_OFF);
    const int wave = __builtin_amdgcn_readfirstlane(threadIdx.x >> 6);
    const int G = gridDim.x, c = blockIdx.x;
    unsigned char* ws = args.ws;
    unsigned* ctl = (unsigned*)(ws + WS_CTL);
    for (int u = wave * 64 + lane_id_v(); u < (LDS_BYTES - MISC_OFF) / 4; u += NWAVES * 64) ((LAS unsigned*)(lds + MISC_OFF))[u] = 0u;
    __syncthreads();
    const int lo = args.ph_lo, hi = args.ph_hi;
    XcdBarrier bar; bar.bar = ctl + CW_BAR; bar.x = 0; bar.st = nullptr; bar.wave = wave;
    if (hi - lo > 1) bar = xcd_barrier_post(ctl + CW_BAR, MISC + 8, wave);
#ifndef PH_MASK
#define PH_MASK 0xFFF
#endif
#define IN(k) ((((PH_MASK) >> (k)) & 1) && lo <= (k) && (k) < hi)
#define BOTH(k) (IN(k) && IN((k) + 1))
#define SEAM(k) do { if (BOTH(k)) xcd_barrier(bar); } while (0)
#ifndef REPEAT_MASK
#define REPEAT_MASK 0
#endif
#define NREP(k) ((((REPEAT_MASK) >> (k)) & 1) ? 2 : 1)
#define REP_BEGIN(k) for (int rep_ = 0; rep_ < NREP(k); ++rep_) { if (rep_) xcd_barrier(bar);
#define REP_END }

    bf16_t* QKV7 = (bf16_t*)(ws + WS_QKV7);
    if (IN(0)) { REP_BEGIN(0) p0_prologue(args, lds, c, G, wave, lane_id_v()); REP_END SEAM(0); }

    if (IN(1)) {
        REP_BEGIN(1)
        { pg8::DenseOrder S; S.init(SEQ, NPRJ, G, c);
          EpiInProj E{0, QKV7, (bf16_t*)(ws + WS_SG), (bf16_t*)(ws + WS_KI), (float*)(ws + WS_WI), (float*)(ws + WS_CTL + CTL_KMEAN), (const float*)(ws + WS_ROPEA), (const float*)(ws + WS_ROPEI), args.in[IN_GIDX], args.in[IN_BIDX]};
          pg8::gemm_phase<EpiInProj, pg8::DenseOrder, false, true>(lds, (const bf16_t*)(ws + WS_H1), (const bf16_t*)(ws + WS_WIN), DM, S, E, wave); }
        { constexpr int NU_IN = (SEQ / 256) * (NPRJ / 256); const int rem = NU_IN % G;
          pg8::DenseOrder S; if (rem == 0) S.init(SEQ, DM, G, c); else S.init(SEQ, DM, G - rem, c >= rem ? c - rem : (1 << 30));
          EpiBf16Plain E{0, (bf16_t*)(ws + WS_PLEB), DM};
          pg8::gemm_phase<EpiBf16Plain, pg8::DenseOrder, false, true>(lds, (const bf16_t*)(ws + WS_PB), (const bf16_t*)(ws + WS_WPP), PLED, S, E, wave); }
        REP_END
        SEAM(1);
    }
    if (IN(2)) { REP_BEGIN(2)
        if (rep_) { if (wave == 0 && lane_id_v() == 0) MISC[16] = 0u; __syncthreads(); }
        for (int rg_ = 0; rg_ < P2_NREP(14); ++rg_) p2_moba_gate(args, lds, c, G, wave, lane_id_v());
        __syncthreads();
        p2_indexer_and_convert(args, lds, MISC, c, G, wave, lane_id_v());
        REP_END SEAM(2); }

    if (IN(3)) {
        const unsigned long long* BM = (const unsigned long long*)(ws + WS_BM); const unsigned* SELB = (const unsigned*)(ws + WS_SELB); bf16_t* OAB = (bf16_t*)(ws + WS_OAB);
        REP_BEGIN(3)
        int L = c;
        if (L < 256) {
#define ATT_REF(R, L_, pass_) do { const int bh_ = (L_) >> 4, x_ = (L_) & 15, br_ = bh_ >> 3, h_ = bh_ & 7, qb_ = (pass_) ? 31 - x_ : x_, P0_ = qb_ * 256; \
            const bf16_t* qt_ = QKV7 + (size_t)(br_ ? 4 : 0) * SEQ * BRW; \
            R.Q = qt_ + (size_t)P0_ * BRW + h_ * HD; R.K = qt_ + (size_t)SEQ * BRW + h_ * HD; R.V = qt_ + (size_t)2 * SEQ * BRW + h_ * HD; \
            R.O = OAB + (size_t)P0_ * DM + br_ * BRW + h_ * HD; R.P0 = P0_; R.mode = br_; R.bm = BM + (size_t)P0_ * (SEQ / 64); R.selw = SELB + (size_t)P0_ * NHEAD + h_; } while (0)
            att::BlockRef cur, nxt; int pass = 0; ATT_REF(cur, L, 0);
            att::Seam S;
            att::attn_prime(cur, (char*)lds_raw, S, wave);
            for (;;) {
                const bool more_pass = (pass == 0), more_item = (L + G < 256), last = !more_pass && !more_item;
                int Ln = L, passn = pass + 1;
                if (!more_pass) { passn = 0; Ln = more_item ? L + G : L; }
                if (last) nxt = cur; else ATT_REF(nxt, Ln, passn);
                att::attn_block(cur, nxt, (char*)lds_raw, S, wave);
                if (last) break;
                cur = nxt; pass = passn; L = Ln;
            }
#undef ATT_REF
        }
        REP_END
        SEAM(3);
    }
    if (IN(4)) {
        pg8::DenseOrder S; S.init(SEQ, DM, G, c);
        EpiMerged E{16, (const bf16_t*)(ws + WS_SG), (bf16_t*)(ws + WS_MERGED)};
        REP_BEGIN(4)
        pg8::gemm_phase<EpiMerged, pg8::DenseOrder, false, true>(lds, (const bf16_t*)(ws + WS_OAB), (const bf16_t*)(ws + WS_WBR), DM, S, E, wave);
        REP_END
        SEAM(4);
    }
    if (IN(5)) {
        pg8::DenseOrder S; S.init(SEQ, DM, G, c);
        EpiResF32 E{0, args.in[IN_X], (float*)(ws + WS_X1)};
        REP_BEGIN(5)
        pg8::gemm_phase<EpiResF32, pg8::DenseOrder, false, true>(lds, (const bf16_t*)(ws + WS_MERGED), (const bf16_t*)(ws + WS_WOUT), DM, S, E, wave);
        REP_END
        SEAM(5);
    }
    if (IN(6)) { p6_route(args, lds, c, G, wave, lane_id_v()); SEAM(6); }
    if (IN(7)) {
        const int vcu = (G % 8 == 0) ? (c % 8) * (G / 8) + c / 8 : c;
        MoeOrder S; S.init((const int*)(ctl + CW_CNT), (const int*)(ws + WS_LIST), 16, G, vcu);
        EpiGateUp E{0, (const int*)(ws + WS_LIST), (const float*)(ws + WS_RSL), args.in[IN_BGU], (bf16_t*)(ws + WS_ACT)};
        REP_BEGIN(7)
        pg8::gemm_phase<EpiGateUp, MoeOrder, true, true, true>(lds, (const bf16_t*)(ws + WS_H2U), (const bf16_t*)(ws + WS_WGU), DM, S, E, wave);
        REP_END
        SEAM(7);
    }
    if (IN(8)) {
        const int vcu = (G % 8 == 0) ? (c % 8) * (G / 8) + c / 8 : c;
        MoeOrder S; S.init((const int*)(ctl + CW_CNT), (const int*)(ws + WS_LIST), 8, G, vcu);
        EpiDown E{0, (const int*)(ws + WS_LIST), (const float*)(ws + WS_GTL), args.in[IN_BDOWN], (bf16_t*)(ws + WS_YS)};
        REP_BEGIN(8)
        pg8::gemm_phase<EpiDown, MoeOrder, false, true, true>(lds, (const bf16_t*)(ws + WS_ACT), (const bf16_t*)(ws + WS_WD), DFF, S, E, wave);
        REP_END
        SEAM(8);
    }
    if (IN(9)) { REP_BEGIN(9) p9_x2(args, c, G, wave, lane_id_v()); REP_END SEAM(9); }
    if (IN(10)) {
        pg8::DenseOrder S; S.init(SEQ, DM, G, c);
        EpiPleGate E{0, (const bf16_t*)(ws + WS_PLEB), (bf16_t*)(ws + WS_T), (float*)(ws + WS_TSS)};
        REP_BEGIN(10)
        pg8::gemm_phase<EpiPleGate, pg8::DenseOrder, false, true>(lds, (const bf16_t*)(ws + WS_X2B), (const bf16_t*)(ws + WS_WPG), DM, S, E, wave);
        REP_END
        SEAM(10);
    }
    if (IN(11)) { REP_BEGIN(11) p11_final(args, c, G, wave, lane_id_v()); REP_END }
#undef IN
#undef BOTH
#undef SEAM
#undef NREP
#undef REP_BEGIN
#undef REP_END
}

#ifndef MK_N_LAUNCHES
#define MK_N_LAUNCHES 1
#endif
extern "C" void kernel_launch(void* const* d_in, const int* in_sizes, int n_in, void* d_out, int out_size, void* d_ws, size_t ws_size, hipStream_t stream) {
    static int grid = 0;
    if (grid == 0) {
        if (n_in != 20 || in_sizes[0] != SEQ * DM || out_size != SEQ * DM || ws_size < WS_END) { fprintf(stderr, "kernel_launch: unexpected shapes (n_in %d, in0 %d, out %d, ws %zu)\n", n_in, n_in > 0 ? in_sizes[0] : -1, out_size, ws_size); grid = -1; return; }
        int dev = 0, cus = 0, per_cu = 0;
        if (hipGetDevice(&dev) != hipSuccess || hipDeviceGetAttribute(&cus, hipDeviceAttributeMultiprocessorCount, dev) != hipSuccess) { grid = -1; return; }
        if (hipFuncSetAttribute((const void*)hybrid_fwd, hipFuncAttributeMaxDynamicSharedMemorySize, LDS_BYTES) != hipSuccess) { fprintf(stderr, "kernel_launch: hipFuncSetAttribute failed\n"); grid = -1; return; }
        if (hipOccupancyMaxActiveBlocksPerMultiprocessor(&per_cu, (const void*)hybrid_fwd, NWAVES * 64, LDS_BYTES) != hipSuccess || per_cu < 1) { fprintf(stderr, "kernel_launch: occupancy query says %d blocks per CU\n", per_cu); }
        (void)hipGetLastError();
        grid = cus > 0 ? cus : 256;
    }
    if (grid < 0) return;
    if (hipMemsetAsync((char*)d_ws + WS_CTL, 0, CTL_ZERO_BYTES, stream) != hipSuccess) return;
    Args a{};
    for (int i = 0; i < 20; ++i) a.in[i] = (const float*)d_in[i];
    a.out = (float*)d_out; a.ws = (unsigned char*)d_ws;
    if (MK_N_LAUNCHES == 1) { a.ph_lo = 0; a.ph_hi = N_PHASES; hipLaunchKernelGGL(hybrid_fwd, dim3(grid), dim3(NWAVES * 64), LDS_BYTES, stream, a); }
    else { for (int p = 0; p < N_PHASES; ++p) { a.ph_lo = p; a.ph_hi = p + 1; hipLaunchKernelGGL(hybrid_fwd, dim3(grid), dim3(NWAVES * 64), LDS_BYTES, stream, a); } }
    const hipError_t le = hipPeekAtLastError();
    if (le != hipSuccess) fprintf(stderr, "kernel_launch: launch failed: %s\n", hipGetErrorName(le));
}
```

```cpp
#include <hip/hip_runtime.h>
#include <hip/hip_bf16.h>
#include <cstdio>
#include <cstdint>

#define GAS __attribute__((address_space(1)))
#define LAS __attribute__((address_space(3)))
typedef unsigned short bf16_t;
typedef short bf16x8 __attribute__((ext_vector_type(8)));
typedef short s16x4 __attribute__((ext_vector_type(4)));
typedef float f32x4 __attribute__((ext_vector_type(4)));
typedef float f32x2 __attribute__((ext_vector_type(2)));
typedef float f32x16 __attribute__((ext_vector_type(16)));
typedef unsigned u32x4 __attribute__((ext_vector_type(4)));
typedef unsigned u32x2 __attribute__((ext_vector_type(2)));

typedef __bf16 bf16x2_n __attribute__((ext_vector_type(2)));
__device__ __forceinline__ unsigned cvt_pk_bf16(float lo, float hi) { const f32x2 v = {lo, hi}; return __builtin_bit_cast(unsigned, __builtin_convertvector(v, bf16x2_n)); }
__device__ __forceinline__ float bf_lo(unsigned w) { return __uint_as_float(w << 16); }
__device__ __forceinline__ float bf_hi(unsigned w) { return __uint_as_float(w & 0xffff0000u); }
__device__ __forceinline__ float sigmoidf_(float x) { return __builtin_amdgcn_rcpf(1.0f + __builtin_amdgcn_exp2f(x * -1.4426950408889634f)); }
__device__ __forceinline__ float sigmoid_fast(float x) { return sigmoidf_(x); }
__device__ __forceinline__ int lane_id_v() { int l; asm volatile("v_mbcnt_lo_u32_b32 %0, -1, 0\n\tv_mbcnt_hi_u32_b32 %0, -1, %0" : "=v"(l)); return l; }

namespace pg8 {
constexpr int BM = 256, BK = 64, HALF = 128, HTB = HALF * BK * 2, STAGE_BYTES = 8 * HTB, NXCD = 8, WGM = 8;
__host__ __device__ __forceinline__ int lds_byte(int r, int c) { const int st = (r >> 4) * 2 + (c >> 5), rr = r & 15, cc = c & 31, ob = rr * 64 + cc * 2; return st * 1024 + (ob ^ (((ob >> 9) & 1) << 5)); }
__host__ __device__ __forceinline__ void stage_rc(int b, int& R, int& C) { const int st = b / 1024, sb = b % 1024, swz = sb ^ (((sb >> 9) & 1) << 5); R = (st >> 1) * 16 + swz / 64; C = (st & 1) * 32 + (swz % 64) / 2; }
__host__ __device__ __forceinline__ int perm32(int rho) { const int n = rho >> 4, i = rho & 15; return 8 * (i >> 2) + 4 * n + (i & 3); }

struct Unit { int pm, pn, e, b, rows, rb; };

struct DenseOrder {
    int nM, nN, nwg, G, c;
    __device__ void init(int M, int N, int G_, int c_) { nM = M / BM; nN = N / BM; nwg = nM * nN; G = G_; c = c_; }
    __device__ bool next(int i, Unit& u) const {
        const long L = (long)i * G + c; if (L >= nwg) return false;
        int wgid = (int)L; { const int q = nwg / NXCD, r = nwg % NXCD, xcd = wgid % NXCD, off = wgid / NXCD; wgid = (xcd < r ? xcd * (q + 1) : r * (q + 1) + (xcd - r) * q) + off; }
        const int nig = WGM * nN, gid = wgid / nig, fm = gid * WGM, gsz = (nM - fm) < WGM ? (nM - fm) : WGM;
        u.pm = fm + ((wgid % nig) % gsz); u.pn = (wgid % nig) / gsz; u.e = 0; u.b = 0; u.rows = 256; u.rb = u.pm; return true;
    }
    __device__ __forceinline__ size_t a_row0(const Unit& u) const { return (size_t)u.pm * BM; }
    __device__ __forceinline__ size_t b_row0(const Unit& u) const { return (size_t)u.pn * BM; }
    __device__ __forceinline__ int a_row(const Unit&, int) const { return 0; }
    static constexpr bool PARTIAL = false;
};

template <class Epi, class Sched, bool GATHER, bool ALIGN_EPI, bool BBLK = false>
__device__ __forceinline__ void gemm_phase(LAS unsigned char* lds, const bf16_t* A, const bf16_t* Bt, const int K, const Sched& S, const Epi& E, const int wid) {
    const int lane = lane_id_v(), tid = wid * 64 + lane, wr = wid >> 2, wc = wid & 3, fr = lane & 15, fq = lane >> 4;
    const int nt = K / BK;
    int Rr[2], Cc[2]; unsigned voffB[2], vC[2][2], vN[2][2];
#pragma unroll
    for (int i = 0; i < 2; ++i) { stage_rc(tid * 16 + i * 8192, Rr[i], Cc[i]); const int Rb = (Rr[i] & ~31) + perm32(Rr[i] & 31);
        voffB[i] = BBLK ? (unsigned)((Rb >> 6) * (K >> 6)) * 8192u + (unsigned)((Rb & 63) * 128 + Cc[i] * 2) : (unsigned)(Rb * K + Cc[i]) * 2u; }
    const size_t kstep = (size_t)(BK * 2), kstepB = BBLK ? (size_t)8192 : kstep;
    const size_t hstep = (size_t)HALF * K * 2;
    const unsigned ldsw = (unsigned)wid * 1024u;
    const int aoff = lds_byte(wr * 64 + fr, fq * 8), boff = lds_byte(wc * 32 + fr, fq * 8);
    const unsigned lbase = (unsigned)(unsigned long long)lds;
#define PG8_SA(b, h) (((b) * 2 + (h)) * HTB)
#define PG8_SB(b, h) ((4 + (b) * 2 + (h)) * HTB)
#define PG8_STAGE(bufoff, gbase, voff) do { _Pragma("unroll") for (int _i = 0; _i < 2; ++_i) \
        __builtin_amdgcn_global_load_lds((const unsigned*)((const char*)(gbase) + (voff)[_i]), (LAS unsigned*)(lds + (bufoff) + ldsw + _i * 8192), 16, 0, 0); } while (0)
#define PG8_STAGEA(bufoff, gbase, VO, h) PG8_STAGE(bufoff, (gbase) + (GATHER ? (size_t)0 : (size_t)(h) * hstep), (VO)[GATHER ? (h) : 0])
#define PG8_LDA(dst, b, h) do { _Pragma("unroll") for (int m = 0; m < 4; ++m) _Pragma("unroll") for (int k = 0; k < 2; ++k) dst[m][k] = *(const LAS bf16x8*)(lds + PG8_SA(b, h) + aoff + m * 2048 + k * 1024); } while (0)
#define PG8_LDB(dst, b, h) do { _Pragma("unroll") for (int n = 0; n < 2; ++n) _Pragma("unroll") for (int k = 0; k < 2; ++k) dst[n][k] = *(const LAS bf16x8*)(lds + PG8_SB(b, h) + boff + n * 2048 + k * 1024); } while (0)
#define PG8_MMA(ai, bj, At, Bt_) do { __builtin_amdgcn_s_setprio(1); _Pragma("unroll") for (int m = 0; m < 4; ++m) _Pragma("unroll") for (int n = 0; n < 2; ++n) _Pragma("unroll") for (int k = 0; k < 2; ++k) \
        acc[ai][bj][m][n] = __builtin_amdgcn_mfma_f32_16x16x32_bf16(Bt_[n][k], At[m][k], acc[ai][bj][m][n], 0, 0, 0); __builtin_amdgcn_s_setprio(0); } while (0)
#define PG8_WAIT_V(n) asm volatile("s_waitcnt vmcnt(" #n ")" ::: "memory")
#define PG8_WAIT_L(n) asm volatile("s_waitcnt lgkmcnt(" #n ")" ::: "memory")
#define PG8_BAR __builtin_amdgcn_s_barrier()
#define PG8_SCHED __builtin_amdgcn_sched_barrier(0)
#define PG8_VOFF(dst, u) do { _Pragma("unroll") for (int _h = 0; _h < 2; ++_h) _Pragma("unroll") for (int _i = 0; _i < 2; ++_i) { \
        const int _r = GATHER ? S.a_row(u, _h * HALF + Rr[_i]) : (_h * HALF + Rr[_i]); dst[_h][_i] = (unsigned)(_r * K + Cc[_i]) * 2u; } \
        if (GATHER) { asm volatile("s_waitcnt vmcnt(0)" ::: "memory"); } } while (0)
#define PG8_DSR(dst, base, off) asm volatile("ds_read_b128 %0, %1 offset:" #off : "=v"(dst) : "v"(base))
#define PG8_LDA_ASM(dst, b, h) do { const unsigned _ab = lbase + (unsigned)(PG8_SA(b, h) + aoff); PG8_DSR(dst[0][0], _ab, 0); PG8_DSR(dst[0][1], _ab, 1024); PG8_DSR(dst[1][0], _ab, 2048); PG8_DSR(dst[1][1], _ab, 3072); \
        PG8_DSR(dst[2][0], _ab, 4096); PG8_DSR(dst[2][1], _ab, 5120); PG8_DSR(dst[3][0], _ab, 6144); PG8_DSR(dst[3][1], _ab, 7168); } while (0)
#define PG8_LDB_ASM(dst, b, h) do { const unsigned _bb = lbase + (unsigned)(PG8_SB(b, h) + boff); PG8_DSR(dst[0][0], _bb, 0); PG8_DSR(dst[0][1], _bb, 1024); PG8_DSR(dst[1][0], _bb, 2048); PG8_DSR(dst[1][1], _bb, 3072); } while (0)
#define PG8_UNDEF_A(dst) do { _Pragma("unroll") for (int m = 0; m < 4; ++m) _Pragma("unroll") for (int k = 0; k < 2; ++k) asm volatile("" : "=v"(dst[m][k])); } while (0)
#define PG8_UNDEF_B(dst) do { _Pragma("unroll") for (int n = 0; n < 2; ++n) _Pragma("unroll") for (int k = 0; k < 2; ++k) asm volatile("" : "=v"(dst[n][k])); } while (0)
#define PG8_KLOOP(D0, D1, LDA_, LDB_) \
        _Pragma("unroll 1") for (int t = 0; t < nt; t += 2) { \
            const bool last = (t == nt - 2); \
            if constexpr (Epi::HAS_MID) { if (t == E.mid_t) E.mid(acc, cur, wr, wc, fr, fq); } \
            const char* a1 = cA + (size_t)(t + 1) * kstep; \
            const char* a2 = last ? nA : cA + (size_t)(t + 2) * kstep; const char* b2 = last ? nB : cB + (size_t)(t + 2) * kstepB; \
            const char* a3 = a2 + kstep; const char* b3 = b2 + kstepB; \
            unsigned o2[2][2]; \
            _Pragma("unroll") for (int h = 0; h < 2; ++h) _Pragma("unroll") for (int i = 0; i < 2; ++i) o2[h][i] = (GATHER && last) ? vN[h][i] : vC[h][i]; \
            if (D0) { LDB_(B0, 0, 0); LDB_(B1, 0, 1); PG8_SCHED; LDA_(At, 0, 0); } else { PG8_UNDEF_B(B0); PG8_UNDEF_B(B1); PG8_UNDEF_A(At); } PG8_STAGEA(PG8_SA(1, 1), a1, vC, 1); \
            PG8_WAIT_V(8); PG8_WAIT_L(0); PG8_BAR; if (D0) { PG8_MMA(0, 0, At, B0); PG8_MMA(0, 1, At, B1); } PG8_BAR; PG8_SCHED; \
            if (D1) { LDA_(At, 0, 1); } else { PG8_UNDEF_A(At); } PG8_STAGE(PG8_SB(0, 0), b2, voffB); PG8_STAGE(PG8_SB(0, 1), b2 + hstep, voffB); PG8_STAGEA(PG8_SA(0, 0), a2, o2, 0); \
            PG8_WAIT_V(8); PG8_WAIT_L(0); PG8_BAR; if (D1) { PG8_MMA(1, 0, At, B0); PG8_MMA(1, 1, At, B1); } PG8_BAR; PG8_SCHED; \
            if (D0) { LDB_(B0, 1, 0); LDB_(B1, 1, 1); PG8_SCHED; LDA_(At, 1, 0); } else { PG8_UNDEF_B(B0); PG8_UNDEF_B(B1); PG8_UNDEF_A(At); } PG8_STAGEA(PG8_SA(0, 1), a2, o2, 1); \
            PG8_WAIT_V(8); PG8_WAIT_L(0); PG8_BAR; if (D0) { PG8_MMA(0, 0, At, B0); PG8_MMA(0, 1, At, B1); } PG8_BAR; PG8_SCHED; \
            if (D1) { LDA_(At, 1, 1); } else { PG8_UNDEF_A(At); } PG8_STAGE(PG8_SB(1, 0), b3, voffB); PG8_STAGE(PG8_SB(1, 1), b3 + hstep, voffB); PG8_STAGEA(PG8_SA(1, 0), a3, o2, 0); \
            PG8_WAIT_V(8); PG8_WAIT_L(0); PG8_BAR; if (D1) { PG8_MMA(1, 0, At, B0); PG8_MMA(1, 1, At, B1); } PG8_BAR; PG8_SCHED; \
        }
    Unit cur, nxt; int ui = 0;
    if (!S.next(0, cur)) return;
    f32x4 acc[2][2][4][2];
#pragma unroll
    for (int a = 0; a < 2; ++a)
#pragma unroll
        for (int b = 0; b < 2; ++b)
#pragma unroll
            for (int m = 0; m < 4; ++m)
#pragma unroll
                for (int n = 0; n < 2; ++n) acc[a][b][m][n] = (f32x4){0.f, 0.f, 0.f, 0.f};
    bf16x8 At[4][2], B0[2][2], B1[2][2];
    PG8_VOFF(vC, cur);
#pragma unroll
    for (int h = 0; h < 2; ++h)
#pragma unroll
        for (int i = 0; i < 2; ++i) vN[h][i] = vC[h][i];
    const char* cA = (const char*)A + (GATHER ? (size_t)0 : S.a_row0(cur) * (size_t)K * 2); const char* cB = (const char*)Bt + S.b_row0(cur) * (size_t)K * 2;
    PG8_STAGE(PG8_SB(0, 0), cB, voffB); PG8_STAGE(PG8_SB(0, 1), cB + hstep, voffB); PG8_STAGEA(PG8_SA(0, 0), cA, vC, 0); PG8_STAGEA(PG8_SA(0, 1), cA, vC, 1);
    if (wr == 1) PG8_BAR;
    PG8_WAIT_V(2); PG8_BAR;
    PG8_STAGE(PG8_SB(1, 0), cB + kstepB, voffB); PG8_STAGEA(PG8_SA(1, 0), cA + kstep, vC, 0); PG8_STAGE(PG8_SB(1, 1), cB + hstep + kstepB, voffB);
    PG8_WAIT_V(6); PG8_BAR;
    for (;;) {
        bool do0 = true, do1 = true;
        if constexpr (Sched::PARTIAL) { do0 = wr * 64 < cur.rows; do1 = HALF + wr * 64 < cur.rows; }
        const bool has_next = S.next(ui + 1, nxt);
        const char* nA = (has_next && !GATHER) ? (const char*)A + S.a_row0(nxt) * (size_t)K * 2 : cA; const char* nB = has_next ? (const char*)Bt + S.b_row0(nxt) * (size_t)K * 2 : cB;
        if (GATHER && has_next) { PG8_VOFF(vN, nxt); }
        if (do1) { PG8_KLOOP(true, true, PG8_LDA, PG8_LDB) } else if (do0) { PG8_KLOOP(true, false, PG8_LDA, PG8_LDB) } else { PG8_KLOOP(false, false, PG8_LDA, PG8_LDB) }
        if constexpr (ALIGN_EPI) { if (wr == 0) PG8_BAR; }
        E(acc, cur, wr, wc, fr, fq);
        if (!has_next) break;
#pragma unroll
        for (int a = 0; a < 2; ++a)
#pragma unroll
            for (int b = 0; b < 2; ++b)
#pragma unroll
                for (int m = 0; m < 4; ++m)
#pragma unroll
                    for (int n = 0; n < 2; ++n) acc[a][b][m][n] = (f32x4){0.f, 0.f, 0.f, 0.f};
        cur = nxt; cA = nA; cB = nB; ++ui;
#pragma unroll
        for (int h = 0; h < 2; ++h)
#pragma unroll
            for (int i = 0; i < 2; ++i) vC[h][i] = vN[h][i];
        if constexpr (ALIGN_EPI) { if (wr == 1) PG8_BAR; }
    }
    PG8_WAIT_V(0);
    if constexpr (!ALIGN_EPI) { if (wr == 0) PG8_BAR; }
    PG8_BAR;
#undef PG8_SA
#undef PG8_SB
#undef PG8_STAGE
#undef PG8_STAGEA
#undef PG8_LDA
#undef PG8_LDB
#undef PG8_MMA
#undef PG8_WAIT_V
#undef PG8_WAIT_L
#undef PG8_BAR
#undef PG8_SCHED
#undef PG8_VOFF
#undef PG8_KLOOP
#undef PG8_UNDEF_A
#undef PG8_UNDEF_B
#undef PG8_DSR
#undef PG8_LDA_ASM
#undef PG8_LDB_ASM
}
}
constexpr int SEQ = 8192, DM = 2048, HD = 128, NHEAD = 8, BRW = 1024, IDXH = 16, IDXD = 64, NEXP = 32, TOPK = 4, DFF = 2048, PLED = 256;
constexpr int INW = 11344, NPRJ = 11520;
constexpr int DSA_TOPK = 256, MOBA_BLK = 256, NKB = SEQ / MOBA_BLK;
constexpr float EPS = 1e-6f, SWI_LIMIT = 7.0f, SWI_ALPHA = 1.702f, IDX_W_SCALE = 0.03125f;

#define ACC_T f32x4 (&acc)[2][2][4][2]
#define CACC_T const f32x4 (&acc)[2][2][4][2]
__device__ __forceinline__ u32x4 pack8bf(const f32x4 a, const f32x4 b) { u32x4 w; w.x = cvt_pk_bf16(a[0], a[1]); w.y = cvt_pk_bf16(a[2], a[3]); w.z = cvt_pk_bf16(b[0], b[1]); w.w = cvt_pk_bf16(b[2], b[3]); return w; }
__device__ __forceinline__ void unpack8bf(const u32x4 w, float (&o)[8]) { o[0] = bf_lo(w.x); o[1] = bf_hi(w.x); o[2] = bf_lo(w.y); o[3] = bf_hi(w.y); o[4] = bf_lo(w.z); o[5] = bf_hi(w.z); o[6] = bf_lo(w.w); o[7] = bf_hi(w.w); }

struct EpiInProj {
    static constexpr bool HAS_MID = false; int mid_t;
    bf16_t* qkv7; bf16_t* sg; bf16_t* ki; float* wi; float* kmean; const float* ropeA; const float* ropeI; const float* g_idx; const float* b_idx;
    __device__ __forceinline__ void mid(ACC_T, const pg8::Unit&, int, int, int, int) const {}
    __device__ __forceinline__ void operator()(CACC_T, const pg8::Unit& u, int wr, int wc, int fr_in, int fq_in) const {
        int fr = fr_in, fq = fq_in; asm volatile("" : "+v"(fr), "+v"(fq));
        const int pn = u.pn, row0 = u.pm * 256 + wr * 64 + fr;
        if (pn < 28) {
            const int tsr = pn >> 2, colt = (pn & 3) * 256;
            bf16_t* dst = qkv7 + (size_t)tsr * ((size_t)SEQ * BRW);
            const bool rope32 = (tsr == 0 || tsr == 1 || tsr == 4 || tsr == 5) && (wc == 0);
            const bool rope16 = (tsr == 3) && ((wc & 1) == 0);
            const bool km = (tsr == 5);
#pragma unroll
            for (int bj = 0; bj < 2; ++bj) {
                float ks[8];
#pragma unroll
                for (int i = 0; i < 8; ++i) ks[i] = 0.f;
#pragma unroll
                for (int ai = 0; ai < 2; ++ai)
#pragma unroll
                    for (int m = 0; m < 4; ++m) {
                        const int row = row0 + ai * 128 + m * 16;
                        f32x4 cs[4];
                        if (rope32) { const f32x4* tp = (const f32x4*)(ropeA + ((size_t)row * 16 + 8 * (fq & 1)) * 2);
#pragma unroll
                            for (int q = 0; q < 4; ++q) cs[q] = tp[q]; }
                        else if (rope16) { const f32x4* tp = (const f32x4*)(ropeI + (size_t)row * 16);
#pragma unroll
                            for (int q = 0; q < 4; ++q) cs[q] = tp[q]; }
                        float v[8];
#pragma unroll
                        for (int i = 0; i < 4; ++i) { v[i] = acc[ai][bj][m][0][i]; v[4 + i] = acc[ai][bj][m][1][i]; }
                        if (rope32) {
#pragma unroll
                            for (int i = 0; i < 8; ++i) { const float p = __shfl_xor(v[i], 32); const float c = cs[i >> 1][(i & 1) * 2], s = cs[i >> 1][(i & 1) * 2 + 1];
                                v[i] = v[i] * c + (fq < 2 ? -p : p) * s; }
                        } else if (rope16) {
#pragma unroll
                            for (int i = 0; i < 8; ++i) { const float p = __shfl_xor(v[i], 16); const float c = cs[i >> 1][(i & 1) * 2], s = cs[i >> 1][(i & 1) * 2 + 1];
                                const float r = v[i] * c + (fq == 0 ? -p : p) * s; v[i] = (fq < 2) ? r : v[i]; }
                        }
                        if (km) {
#pragma unroll
                            for (int i = 0; i < 8; ++i) ks[i] += v[i];
                        }
                        u32x4 w; w.x = cvt_pk_bf16(v[0], v[1]); w.y = cvt_pk_bf16(v[2], v[3]); w.z = cvt_pk_bf16(v[4], v[5]); w.w = cvt_pk_bf16(v[6], v[7]);
                        *(u32x4*)(dst + (size_t)row * BRW + colt + bj * 128 + wc * 32 + fq * 8) = w;
                        asm volatile("" ::: "memory");
                    }
                if (km) {
#pragma unroll
                    for (int i = 0; i < 8; ++i) { float s = ks[i]; s += __shfl_xor(s, 1); s += __shfl_xor(s, 2); s += __shfl_xor(s, 4); s += __shfl_xor(s, 8);
                        if (fr == 0) atomicAdd(kmean + (size_t)u.pm * BRW + colt + bj * 128 + wc * 32 + fq * 8 + i, s); }
                }
            }
        } else if (pn < 44) {
            const int colt = (pn - 28) * 256;
#pragma unroll
            for (int ai = 0; ai < 2; ++ai)
#pragma unroll
                for (int m = 0; m < 4; ++m) {
                    const int row = row0 + ai * 128 + m * 16;
#pragma unroll
                    for (int bj = 0; bj < 2; ++bj) {
                        float v[8];
#pragma unroll
                        for (int i = 0; i < 4; ++i) { v[i] = sigmoid_fast(acc[ai][bj][m][0][i]); v[4 + i] = sigmoid_fast(acc[ai][bj][m][1][i]); }
                        u32x4 w; w.x = cvt_pk_bf16(v[0], v[1]); w.y = cvt_pk_bf16(v[2], v[3]); w.z = cvt_pk_bf16(v[4], v[5]); w.w = cvt_pk_bf16(v[6], v[7]);
                        *(u32x4*)(sg + (size_t)row * 4096 + colt + bj * 128 + wc * 32 + fq * 8) = w;
                    }
                    asm volatile("" ::: "memory");
                }
        } else {
            if (wc == 0) {
#pragma unroll 1
                for (int am = 0; am < 8; ++am) {
                    const int ai = am >> 2, m = am & 3;
                    const int row = row0 + ai * 128 + m * 16;
                    float v[2][8]; float s = 0.f;
#pragma unroll
                    for (int bj = 0; bj < 2; ++bj)
#pragma unroll
                        for (int i = 0; i < 4; ++i) {
                            float x0, x1;
                            x0 = acc[0][bj][0][0][i]; x1 = acc[0][bj][0][1][i];
#pragma unroll
                            for (int q = 1; q < 8; ++q) { x0 = (am == q) ? acc[q >> 2][bj][q & 3][0][i] : x0; x1 = (am == q) ? acc[q >> 2][bj][q & 3][1][i] : x1; }
                            v[bj][i] = x0; v[bj][4 + i] = x1; s += x0 + x1; }
                    s += __shfl_xor(s, 16); s += __shfl_xor(s, 32);
                    const float mu = s * (1.f / 64.f); float q2 = 0.f;
#pragma unroll
                    for (int bj = 0; bj < 2; ++bj)
#pragma unroll
                        for (int i = 0; i < 8; ++i) { v[bj][i] -= mu; q2 += v[bj][i] * v[bj][i]; }
                    q2 += __shfl_xor(q2, 16); q2 += __shfl_xor(q2, 32);
                    const float rstd = rsqrtf(q2 * (1.f / 64.f) + EPS);
#pragma unroll
                    for (int bj = 0; bj < 2; ++bj)
#pragma unroll
                        for (int i = 0; i < 8; ++i) v[bj][i] = v[bj][i] * rstd * g_idx[bj * 32 + fq * 8 + i] + b_idx[bj * 32 + fq * 8 + i];
                    const float* tp = ropeI + (size_t)row * 16;
#pragma unroll
                    for (int i = 0; i < 8; ++i) { const float p = __shfl_xor(v[0][i], 16); const float c = tp[2 * i], sn = tp[2 * i + 1];
                        const float r = v[0][i] * c + (fq == 0 ? -p : p) * sn; v[0][i] = (fq < 2) ? r : v[0][i]; }
#pragma unroll
                    for (int bj = 0; bj < 2; ++bj) { u32x4 w; w.x = cvt_pk_bf16(v[bj][0], v[bj][1]); w.y = cvt_pk_bf16(v[bj][2], v[bj][3]); w.z = cvt_pk_bf16(v[bj][4], v[bj][5]); w.w = cvt_pk_bf16(v[bj][6], v[bj][7]);
                        *(u32x4*)(ki + (size_t)row * IDXD + bj * 32 + fq * 8) = w; }
                    asm volatile("" ::: "memory");
                }
            } else if (wc == 1) {
                if (fq < 2) {
#pragma unroll
                    for (int ai = 0; ai < 2; ++ai)
#pragma unroll
                        for (int m = 0; m < 4; ++m) { const int row = row0 + ai * 128 + m * 16;
                            *(f32x4*)(wi + (size_t)row * IDXH + fq * 8) = acc[ai][0][m][0] * IDX_W_SCALE; *(f32x4*)(wi + (size_t)row * IDXH + fq * 8 + 4) = acc[ai][0][m][1] * IDX_W_SCALE; }
                }
            }
        }
    }
};

struct EpiBf16Plain {
    static constexpr bool HAS_MID = false; int mid_t;
    bf16_t* O; int ldc;
    __device__ __forceinline__ void mid(ACC_T, const pg8::Unit&, int, int, int, int) const {}
    __device__ __forceinline__ void operator()(CACC_T, const pg8::Unit& u, int wr, int wc, int fr_in, int fq_in) const {
        int fr = fr_in, fq = fq_in; asm volatile("" : "+v"(fr), "+v"(fq));
        const int row0 = u.pm * 256 + wr * 64 + fr, col0 = u.pn * 256 + wc * 32 + fq * 8;
#pragma unroll
        for (int ai = 0; ai < 2; ++ai)
#pragma unroll
            for (int m = 0; m < 4; ++m)
#pragma unroll
                for (int bj = 0; bj < 2; ++bj)
                    *(u32x4*)(O + (size_t)(row0 + ai * 128 + m * 16) * ldc + col0 + bj * 128) = pack8bf(acc[ai][bj][m][0], acc[ai][bj][m][1]);
    }
};

struct EpiMerged {
    static constexpr bool HAS_MID = true; int mid_t;
    const bf16_t* sg; bf16_t* O;
    __device__ __forceinline__ void mid(ACC_T, const pg8::Unit& u, int wr, int wc, int fr_in, int fq_in) const {
        int fr = fr_in, fq = fq_in; asm volatile("" : "+v"(fr), "+v"(fq));
        const int row0 = u.pm * 256 + wr * 64 + fr, col0 = u.pn * 256 + wc * 32 + fq * 8;
#pragma unroll
        for (int ai = 0; ai < 2; ++ai)
#pragma unroll
            for (int m = 0; m < 4; ++m)
#pragma unroll
                for (int bj = 0; bj < 2; ++bj) { const bf16_t* gp = sg + (size_t)(row0 + ai * 128 + m * 16) * 4096 + col0 + bj * 128;
                    float a[8], b[8]; unpack8bf(*(const u32x4*)gp, a); unpack8bf(*(const u32x4*)(gp + 2048), b);
#pragma unroll
                    for (int i = 0; i < 4; ++i) { acc[ai][bj][m][0][i] *= a[i] * __builtin_amdgcn_rcpf(b[i]); acc[ai][bj][m][1][i] *= a[4 + i] * __builtin_amdgcn_rcpf(b[4 + i]); }
                    asm volatile("" : "+v"(acc[ai][bj][m][0]), "+v"(acc[ai][bj][m][1]) :: "memory"); }
    }
    __device__ __forceinline__ void operator()(CACC_T, const pg8::Unit& u, int wr, int wc, int fr_in, int fq_in) const {
        int fr = fr_in, fq = fq_in; asm volatile("" : "+v"(fr), "+v"(fq));
        const int row0 = u.pm * 256 + wr * 64 + fr, col0 = u.pn * 256 + wc * 32 + fq * 8;
#pragma unroll
        for (int ai = 0; ai < 2; ++ai)
#pragma unroll
            for (int m = 0; m < 4; ++m)
#pragma unroll
                for (int bj = 0; bj < 2; ++bj) { const size_t ro = (size_t)(row0 + ai * 128 + m * 16);
                    float b[8]; unpack8bf(*(const u32x4*)(sg + ro * 4096 + 2048 + col0 + bj * 128), b);
                    f32x4 v0 = acc[ai][bj][m][0], v1 = acc[ai][bj][m][1];
#pragma unroll
                    for (int i = 0; i < 4; ++i) { v0[i] *= b[i]; v1[i] *= b[4 + i]; }
                    *(u32x4*)(O + ro * DM + col0 + bj * 128) = pack8bf(v0, v1); asm volatile("" ::: "memory"); }
    }
};

struct EpiResF32 {
    static constexpr bool HAS_MID = false; int mid_t;
    const float* X; float* O;
    __device__ __forceinline__ void mid(ACC_T, const pg8::Unit&, int, int, int, int) const {}
    __device__ __forceinline__ void operator()(CACC_T, const pg8::Unit& u, int wr, int wc, int fr_in, int fq_in) const {
        int fr = fr_in, fq = fq_in; asm volatile("" : "+v"(fr), "+v"(fq));
        const int row0 = u.pm * 256 + wr * 64 + fr, col0 = u.pn * 256 + wc * 32 + fq * 8;
#pragma unroll
        for (int ai = 0; ai < 2; ++ai)
#pragma unroll
            for (int m = 0; m < 4; ++m)
#pragma unroll
                for (int bj = 0; bj < 2; ++bj) { const size_t o = (size_t)(row0 + ai * 128 + m * 16) * DM + col0 + bj * 128;
                    const f32x4 x0 = *(const f32x4*)(X + o), x1 = *(const f32x4*)(X + o + 4);
                    *(f32x4*)(O + o) = x0 + acc[ai][bj][m][0]; *(f32x4*)(O + o + 4) = x1 + acc[ai][bj][m][1]; }
    }
};

struct MoeOrder {
    static constexpr bool PARTIAL = true;
    int cnt_l, nb_l, rbx_l, pin_l, pex_l, total, NT, G, c; const int* list;
    __device__ void init(const int* cnt, const int* list_, int NT_, int G_, int c_) {
        const int lane = lane_id_v(), e = lane & 31; NT = NT_; G = G_; c = c_; list = list_;
        cnt_l = cnt[e]; if (cnt_l > SEQ) cnt_l = SEQ; if (cnt_l < 0) cnt_l = 0;
        nb_l = (cnt_l + 255) >> 8;
        int p = nb_l;
#pragma unroll
        for (int o = 1; o < 32; o <<= 1) { const int q = __shfl_up(p, o, 32); if (e >= o) p += q; }
        rbx_l = p - nb_l; pin_l = p * NT; pex_l = (p - nb_l) * NT;
        total = __builtin_amdgcn_readlane(pin_l, 31);
    }
    __device__ bool next(int i, pg8::Unit& u) const {
        const long L = (long)i * G + c; if (L >= total) return false;
        const unsigned long long mk = __ballot(pin_l > (int)L); const int e = __builtin_ctz((unsigned)mk);
        const int base = __builtin_amdgcn_readlane(pex_l, e), nb = __builtin_amdgcn_readlane(nb_l, e), cn = __builtin_amdgcn_readlane(cnt_l, e), rbx = __builtin_amdgcn_readlane(rbx_l, e);
        const int idx = (int)L - base; u.e = e; u.b = idx % nb; u.pn = idx / nb; u.pm = 0; u.rb = rbx + u.b; const int rem = cn - u.b * 256; u.rows = rem < 256 ? rem : 256; return true;
    }
    __device__ __forceinline__ size_t a_row0(const pg8::Unit& u) const { return (size_t)u.rb * 256; }
    __device__ __forceinline__ size_t b_row0(const pg8::Unit& u) const { return (size_t)u.e * ((size_t)NT * 256) + (size_t)u.pn * 256; }
    __device__ __forceinline__ int a_row(const pg8::Unit& u, int r) const { const int rr = r < u.rows ? r : 0; return list[u.e * SEQ + u.b * 256 + rr] >> 2; }
};

struct EpiGateUp {
    static constexpr bool HAS_MID = false; int mid_t;
    const int* list; const float* rstd; const float* bias; bf16_t* act;
    __device__ __forceinline__ void mid(ACC_T, const pg8::Unit&, int, int, int, int) const {}
    __device__ __forceinline__ void operator()(CACC_T, const pg8::Unit& u, int wr, int wc, int fr_in, int fq_in) const {
        int fr = fr_in, fq = fq_in; asm volatile("" : "+v"(fr), "+v"(fq));
        const int jj0 = u.pn * 128 + wc * 32 + fq * 8;
        const f32x4* bp = (const f32x4*)(bias + (size_t)u.e * (2 * DFF) + 2 * jj0);
        const f32x4 b0 = bp[0], b1 = bp[1], b2 = bp[2], b3 = bp[3];
        const float bg[8] = {b0[0], b0[2], b1[0], b1[2], b2[0], b2[2], b3[0], b3[2]}, bl[8] = {b0[1], b0[3], b1[1], b1[3], b2[1], b2[3], b3[1], b3[3]};
#pragma unroll
        for (int ai = 0; ai < 2; ++ai)
#pragma unroll
            for (int m = 0; m < 4; ++m) {
                const int r = ai * 128 + wr * 64 + m * 16 + fr;
                if (r < u.rows) {
                    const float rs = rstd[u.e * SEQ + u.b * 256 + r];
                    float o[8];
#pragma unroll
                    for (int i = 0; i < 8; ++i) { const float g0 = acc[ai][0][m][i >> 2][i & 3] * rs + bg[i], l0 = acc[ai][1][m][i >> 2][i & 3] * rs + bl[i];
                        const float g = fminf(g0, SWI_LIMIT), l = fminf(fmaxf(l0, -SWI_LIMIT), SWI_LIMIT);
                        o[i] = (l + 1.0f) * (g * sigmoid_fast(g * SWI_ALPHA)); }
                    u32x4 w; w.x = cvt_pk_bf16(o[0], o[1]); w.y = cvt_pk_bf16(o[2], o[3]); w.z = cvt_pk_bf16(o[4], o[5]); w.w = cvt_pk_bf16(o[6], o[7]);
                    *(u32x4*)(act + ((size_t)u.rb * 256 + r) * DFF + jj0) = w;
                }
                asm volatile("" ::: "memory");
            }
    }
};

struct EpiDown {
    static constexpr bool HAS_MID = false; int mid_t;
    const int* list; const float* gates; const float* bias; bf16_t* ys;
    __device__ __forceinline__ void mid(ACC_T, const pg8::Unit&, int, int, int, int) const {}
    __device__ __forceinline__ void operator()(CACC_T, const pg8::Unit& u, int wr, int wc, int fr_in, int fq_in) const {
        int fr = fr_in, fq = fq_in; asm volatile("" : "+v"(fr), "+v"(fq));
        const int col0 = u.pn * 256 + wc * 32 + fq * 8;
        f32x4 bv[2][2];
#pragma unroll
        for (int bj = 0; bj < 2; ++bj) { bv[bj][0] = *(const f32x4*)(bias + (size_t)u.e * DM + col0 + bj * 128); bv[bj][1] = *(const f32x4*)(bias + (size_t)u.e * DM + col0 + bj * 128 + 4); }
        asm volatile("" :: "v"(bv[0][0]), "v"(bv[0][1]), "v"(bv[1][0]), "v"(bv[1][1]));
#pragma unroll
        for (int ai = 0; ai < 2; ++ai)
#pragma unroll
            for (int m = 0; m < 4; ++m) {
                const int r = ai * 128 + wr * 64 + m * 16 + fr;
                if (r < u.rows) {
                    const int slot = list[u.e * SEQ + u.b * 256 + r]; const float g = gates[u.e * SEQ + u.b * 256 + r];
#pragma unroll
                    for (int bj = 0; bj < 2; ++bj)
                        *(u32x4*)(ys + (size_t)slot * DM + col0 + bj * 128) = pack8bf((acc[ai][bj][m][0] + bv[bj][0]) * g, (acc[ai][bj][m][1] + bv[bj][1]) * g);
                }
            }
    }
};

struct EpiPleGate {
    static constexpr bool HAS_MID = false; int mid_t;
    const bf16_t* ple; bf16_t* T; float* tss;
    __device__ __forceinline__ void mid(ACC_T, const pg8::Unit&, int, int, int, int) const {}
    __device__ __forceinline__ void operator()(CACC_T, const pg8::Unit& u, int wr, int wc, int fr_in, int fq_in) const {
        int fr = fr_in, fq = fq_in; asm volatile("" : "+v"(fr), "+v"(fq));
        const int row0 = u.pm * 256 + wr * 64 + fr, col0 = u.pn * 256 + wc * 32 + fq * 8;
#pragma unroll
        for (int ai = 0; ai < 2; ++ai)
#pragma unroll
            for (int m = 0; m < 4; ++m) { const size_t ro = (size_t)(row0 + ai * 128 + m * 16); float ss = 0.f;
#pragma unroll
                for (int bj = 0; bj < 2; ++bj) { float pv[8]; unpack8bf(*(const u32x4*)(ple + ro * DM + col0 + bj * 128), pv);
                    f32x4 t0, t1;
#pragma unroll
                    for (int i = 0; i < 4; ++i) { t0[i] = sigmoidf_(acc[ai][bj][m][0][i]) * pv[i]; t1[i] = sigmoidf_(acc[ai][bj][m][1][i]) * pv[4 + i]; ss += t0[i] * t0[i] + t1[i] * t1[i]; }
                    *(u32x4*)(T + ro * DM + col0 + bj * 128) = pack8bf(t0, t1); }
                ss += __shfl_xor(ss, 16); ss += __shfl_xor(ss, 32);
                if (fq == 0) tss[ro * 32 + u.pn * 4 + wc] = ss; }
    }
};
namespace att {
constexpr int D = 128, NW = 8, QBLK = 32, KVBLK = 64, QB = NW * QBLK;
constexpr int SHM_V = KVBLK * D * 2, SHM_K = KVBLK * D * 2;
constexpr int LDS_BYTES = 2 * SHM_V + 2 * SHM_K + NW * 64 * 4;
constexpr float SCALE = 0.08838834764831845f, THR = 8.f;
constexpr int QP = 1024, KP = 1024, OP = 2048;
#define KSWZ(row, colB) ((row) * 256 + ((colB) ^ (((row) & 7) << 4)))
#define SBAR() __builtin_amdgcn_sched_barrier(0)
__device__ __forceinline__ int v_st(int k, int c) { const int kk = (k & ~0xC) | ((k & 4) << 1) | ((k & 8) >> 1); return ((kk >> 3) * 4 + (c >> 5)) * 512 + ((kk & 7) * 32 + (c & 31)) * 2; }
__device__ __forceinline__ int v_rd_base(int lane) { return ((lane & 3) << 3) | (((lane >> 2) & 3) << 6) | (((lane >> 4) & 1) << 5) | (((lane >> 5) & 1) << 8); }
constexpr int v_rd_off(int d0, int ks, int half) { return d0 * 512 + ks * 4096 + half * 2048; }
__device__ __forceinline__ int crow(int r, int hi) { return (r & 3) + 8 * (r >> 2) + 4 * hi; }
__device__ __forceinline__ bf16x8 load8(const bf16_t* p) { return *reinterpret_cast<const bf16x8*>(p); }

__device__ __forceinline__ void mask_causal(f32x16& p0, f32x16& p1, int dq) {
    const float NEG = -__builtin_inff();
#pragma unroll
    for (int r = 0; r < 16; ++r) { const int c = (r & 3) + 8 * (r >> 2); if (dq - c < 0) p0[r] = NEG; if (dq - c - 32 < 0) p1[r] = NEG; }
}
__device__ __forceinline__ void mask_bits(f32x16& p0, f32x16& p1, unsigned lo, unsigned hi32, int hi) {
    const float NEG = -__builtin_inff(); lo >>= 4 * hi; hi32 >>= 4 * hi;
#pragma unroll
    for (int r = 0; r < 16; ++r) { const int c = (r & 3) + 8 * (r >> 2); if (!((lo >> c) & 1u)) p0[r] = NEG; if (!((hi32 >> c) & 1u)) p1[r] = NEG; }
}
__device__ __forceinline__ void mask_all(f32x16& p0, f32x16& p1, bool keep) {
    const float NEG = -__builtin_inff();
#pragma unroll
    for (int r = 0; r < 16; ++r) { p0[r] = keep ? p0[r] : NEG; p1[r] = keep ? p1[r] : NEG; }
}
__device__ __forceinline__ void partialSM(f32x16& p0, f32x16& p1, float& m_reg, float& mn, float& alpha) {
    float pmax = p0[0]; for (int r = 1; r < 16; ++r) pmax = fmaxf(pmax, p0[r]); for (int r = 0; r < 16; ++r) pmax = fmaxf(pmax, p1[r]);
    { auto rr = __builtin_amdgcn_permlane32_swap(__float_as_uint(pmax), __float_as_uint(pmax), false, false);
      pmax = fmaxf(__uint_as_float(rr[0]), __uint_as_float(rr[1])); }
    constexpr float C2 = 1.4426950408889634f * SCALE;
    if (__builtin_expect(__all((pmax - m_reg) * SCALE <= THR), 1)) { mn = m_reg; alpha = 1.f; }
    else { mn = fmaxf(m_reg, pmax); alpha = __builtin_amdgcn_exp2f((m_reg - mn) * C2); m_reg = mn; }
    const float mnL = -mn * C2;
    for (int r = 0; r < 16; ++r) p0[r] = fmaf(p0[r], C2, mnL); for (int r = 0; r < 16; ++r) p1[r] = fmaf(p1[r], C2, mnL);
    for (int r = 0; r < 16; ++r) p0[r] = __builtin_amdgcn_exp2f(p0[r]);
}
__device__ __forceinline__ void finishSM(f32x16& p0, f32x16& p1, float alpha, float& l_reg, bf16x8& pa0, bf16x8& pa1, bf16x8& pa2, bf16x8& pa3) {
    for (int r = 0; r < 16; ++r) p1[r] = __builtin_amdgcn_exp2f(p1[r]);
    float ps = 0; for (int r = 0; r < 16; ++r) ps += p0[r]; for (int r = 0; r < 16; ++r) ps += p1[r];
    { auto rr = __builtin_amdgcn_permlane32_swap(__float_as_uint(ps), __float_as_uint(ps), false, false);
      ps = __uint_as_float(rr[0]) + __uint_as_float(rr[1]); }
    l_reg = l_reg * alpha + ps;
#define PK4(P, B_, OUT) do { unsigned a0 = cvt_pk_bf16(P[B_+0], P[B_+1]), a1 = cvt_pk_bf16(P[B_+2], P[B_+3]);                          \
        unsigned b0 = cvt_pk_bf16(P[B_+4], P[B_+5]), b1 = cvt_pk_bf16(P[B_+6], P[B_+7]);                                             \
        auto r0 = __builtin_amdgcn_permlane32_swap(a0, b0, false, false); auto r1 = __builtin_amdgcn_permlane32_swap(a1, b1, false, false); \
        u32x4 w = {r0[0], r1[0], r0[1], r1[1]}; OUT = *reinterpret_cast<bf16x8*>(&w); } while (0)
    PK4(p0, 0, pa0); PK4(p0, 8, pa1); PK4(p1, 0, pa2); PK4(p1, 8, pa3);
#undef PK4
}
template <int KB>
__device__ __forceinline__ void qkt(f32x16& p0, f32x16& p1, const char* K_lds, int r32, int hi, const bf16x8* qr) {
    p0 = f32x16{}; p1 = f32x16{};
    const char* kb[4];
#pragma unroll
    for (int dd = 0; dd < 4; ++dd) kb[dd] = K_lds + KB * SHM_K + KSWZ(r32, (dd * 16 + hi * 8) * 2);
#pragma unroll
    for (int d0 = 0; d0 < 8; ++d0) { const char* a = kb[d0 & 3] + (d0 >> 2) * 128;
        bf16x8 b0 = *reinterpret_cast<const bf16x8*>(a);
        bf16x8 b1 = *reinterpret_cast<const bf16x8*>(a + 32 * 256);
        p0 = __builtin_amdgcn_mfma_f32_32x32x16_bf16(b0, qr[d0], p0, 0, 0, 0);
        p1 = __builtin_amdgcn_mfma_f32_32x32x16_bf16(b1, qr[d0], p1, 0, 0, 0); }
}
template <int VB>
__device__ __forceinline__ void pv_tile(f32x16* o, int vb0, bf16x8 pa0, bf16x8 pa1, bf16x8 pa2, bf16x8 pa3) {
#define TRRD(dst, off) asm volatile("ds_read_b64_tr_b16 %0, %1 offset:%2" : "=&v"(dst) : "v"(vb0), "i"(off) : "memory")
#define PV_D0(d0) do { s16x4 l0, l1, l2, l3, h0, h1, h2, h3; constexpr int b_ = VB * SHM_V + v_rd_off(d0, 0, 0); \
        TRRD(l0, b_); TRRD(h0, b_ + 2048); TRRD(l1, b_ + 4096); TRRD(h1, b_ + 6144); TRRD(l2, b_ + 8192); TRRD(h2, b_ + 10240); TRRD(l3, b_ + 12288); TRRD(h3, b_ + 14336); \
        asm volatile("s_waitcnt lgkmcnt(0)" ::: "memory"); SBAR();   \
        o[d0] = __builtin_amdgcn_mfma_f32_32x32x16_bf16(pa0, (bf16x8){l0[0], l0[1], l0[2], l0[3], h0[0], h0[1], h0[2], h0[3]}, o[d0], 0, 0, 0);   \
        o[d0] = __builtin_amdgcn_mfma_f32_32x32x16_bf16(pa1, (bf16x8){l1[0], l1[1], l1[2], l1[3], h1[0], h1[1], h1[2], h1[3]}, o[d0], 0, 0, 0);   \
        o[d0] = __builtin_amdgcn_mfma_f32_32x32x16_bf16(pa2, (bf16x8){l2[0], l2[1], l2[2], l2[3], h2[0], h2[1], h2[2], h2[3]}, o[d0], 0, 0, 0);   \
        o[d0] = __builtin_amdgcn_mfma_f32_32x32x16_bf16(pa3, (bf16x8){l3[0], l3[1], l3[2], l3[3], h3[0], h3[1], h3[2], h3[3]}, o[d0], 0, 0, 0); } while (0)
    PV_D0(0); PV_D0(1); PV_D0(2); PV_D0(3);
#undef PV_D0
#undef TRRD
}

struct BlockRef { const bf16_t* Q; const bf16_t* K; const bf16_t* V; bf16_t* O; int P0; int mode; const unsigned long long* bm; const unsigned* selw; };
struct Seam { bf16x8 qr[8]; bf16x8 st_v0, st_v1, st_k0, st_k1; };
#define ROWK(p, k0, rr) ((p) + (size_t)((k0) + (rr)) * KP + sc)
#define VMW() asm volatile("s_waitcnt vmcnt(0)" ::: "memory")
#define VMWN(n) asm volatile("s_waitcnt vmcnt(%0)" :: "i"(n) : "memory")
#define SLOAD_H(Kp, Vp, k0) do { S.st_v0 = load8(ROWK(Vp, k0, sr)); S.st_v1 = load8(ROWK(Vp, k0, 32 + sr));              \
                         S.st_k0 = load8(ROWK(Kp, k0, sr)); S.st_k1 = load8(ROWK(Kp, k0, 32 + sr)); } while (0)
#define SWRITE_HK(bf) do { *(bf16x8*)(K_lds + (bf) * SHM_K + kws) = S.st_k0; *(bf16x8*)(K_lds + (bf) * SHM_K + kws + 32 * 256) = S.st_k1; } while (0)
#define SWRITE_HV(bf) do { *(bf16x8*)(V_lds + (bf) * SHM_V + vst0) = S.st_v0; *(bf16x8*)(V_lds + (bf) * SHM_V + vst1) = S.st_v1; } while (0)
#define SWRITE_H(bf) do { SWRITE_HV(bf); SWRITE_HK(bf); } while (0)
__device__ __forceinline__ void attn_prime(const BlockRef& cur, char* lds, Seam& S, const int wid) {
    const int lane = lane_id_v(), tid = wid * 64 + lane, r32 = lane & 31, hi = lane >> 5;
    const int sr = tid >> 4, sc = (tid & 15) * 8, kws = KSWZ(sr, sc * 2); char* K_lds = lds + 2 * SHM_V;
    for (int d0 = 0; d0 < 8; ++d0) S.qr[d0] = load8(cur.Q + (size_t)(wid * QBLK + r32) * QP + d0 * 16 + hi * 8);
    SLOAD_H(cur.K, cur.V, 0); VMW(); SWRITE_HK(0);
    __syncthreads();
}
__device__ __forceinline__ void attn_block(const BlockRef& cur, const BlockRef& nxt, char* lds, Seam& S, const int wid) {
    const int lane = lane_id_v(), tid = wid * 64 + lane, r32 = lane & 31, hi = lane >> 5;
    const int NT = cur.P0 / KVBLK + 4;
    const int qlo = cur.P0 + wid * QBLK, qm = qlo + r32 - 4 * hi;
    char* V_lds = lds; char* K_lds = lds + 2 * SHM_V;
    float* ws = (float*)(lds + 2 * SHM_V + 2 * SHM_K) + wid * 64; float* li_l = ws, * al_l = ws + 32;
    float m_reg = -1e30f, l_reg = 0; f32x16 o[4] = {};
    const int sr = tid >> 4, sc = (tid & 15) * 8, vst0 = v_st(sr, sc), vst1 = v_st(32 + sr, sc), kws = KSWZ(sr, sc * 2);
    const int vb0 = (int)(uintptr_t)V_lds + v_rd_base(lane);
    const bf16_t* Kh = cur.K; const bf16_t* Vh = cur.V;
    const int mode = cur.mode, own = cur.P0 >> 8;
    unsigned mlo = 0u, mhi = 0u;
    if (mode == 1) mlo = cur.selw[(size_t)(wid * QBLK + r32) * NHEAD];
#define RESC(a) do { if (__any((a) < 1.f)) { if (hi == 0) al_l[r32] = (a); asm volatile("s_waitcnt lgkmcnt(0)" ::: "memory");              \
                     for (int d_ = 0; d_ < 4; ++d_) for (int r = 0; r < 16; ++r) o[d_][r] *= al_l[crow(r, hi)]; } } while (0)
#define KBASE(t) ((t) * KVBLK)
#define MLOAD(t) do { if (mode == 0) { unsigned r_ = (unsigned)r32; asm volatile("" : "+v"(r_));   \
        const u32x2 w_ = *(const u32x2*)(cur.bm + ((unsigned)(wid * QBLK) + r_) * (unsigned)(SEQ / 64) + (unsigned)(t)); mlo = w_.x; mhi = w_.y; } } while (0)
#define MASKT(P0_, P1_, t) do { const int kb_ = KBASE(t); \
        if (mode == 0) { mask_bits(P0_, P1_, mlo, mhi, hi); } \
        else { const int n_ = (t) >> 2; if (n_ == own) { if (kb_ + KVBLK - 1 > qlo) mask_causal(P0_, P1_, qm - kb_); } else mask_all(P0_, P1_, ((mlo >> n_) & 1u) != 0u); } } while (0)
    f32x16 pA0, pA1, pB0, pB1; float mnA, mnB, alA, alB; bf16x8 pa0, pa1, pa2, pa3;
    SWRITE_HV(0); SBAR();
    MLOAD(0);
    if (NT > 1) { SLOAD_H(Kh, Vh, KBASE(1)); }
    SBAR(); qkt<0>(pA0, pA1, K_lds, r32, hi, S.qr);
    MASKT(pA0, pA1, 0); partialSM(pA0, pA1, m_reg, mnA, alA);
    if (NT > 1) { VMW(); SWRITE_H(1); }
    __syncthreads();
#define HALF_STEP(PX0, PX1, mnX, alX, PY0, PY1, alY, t, KB, VB, SB) do {                                                      \
        SBAR(); MLOAD(t); qkt<KB>(PX0, PX1, K_lds, r32, hi, S.qr);                                             \
        finishSM(PY0, PY1, alY, l_reg, pa0, pa1, pa2, pa3); SBAR();                                                           \
        if ((t) + 1 < NT) { SLOAD_H(Kh, Vh, KBASE((t) + 1)); SBAR(); }                                               \
        pv_tile<VB>(o, vb0, pa0, pa1, pa2, pa3); MASKT(PX0, PX1, (t)); partialSM(PX0, PX1, m_reg, mnX, alX);                                        \
        __syncthreads();                                                                                                      \
        if ((t) + 1 < NT) { VMW(); SWRITE_H(SB); }                                                                          \
        RESC(alX); __syncthreads(); } while (0)
    for (int t = 1; t + 1 < NT; t += 2) {
        HALF_STEP(pB0, pB1, mnB, alB, pA0, pA1, alA, t, 1, 0, 0);
        HALF_STEP(pA0, pA1, mnA, alA, pB0, pB1, alB, t + 1, 0, 1, 1);
    }
    SBAR(); MLOAD(NT - 1); qkt<1>(pB0, pB1, K_lds, r32, hi, S.qr); SBAR();
    SLOAD_H(nxt.K, nxt.V, 0); SBAR();
#pragma unroll
    for (int d0 = 0; d0 < 8; ++d0) S.qr[d0] = load8(nxt.Q + (size_t)(wid * QBLK + r32) * QP + d0 * 16 + hi * 8);
    SBAR();
    finishSM(pA0, pA1, alA, l_reg, pa0, pa1, pa2, pa3); SBAR();
    pv_tile<0>(o, vb0, pa0, pa1, pa2, pa3);
    MASKT(pB0, pB1, NT - 1); partialSM(pB0, pB1, m_reg, mnB, alB); __syncthreads(); RESC(alB);
    finishSM(pB0, pB1, alB, l_reg, pa0, pa1, pa2, pa3); SBAR(); pv_tile<1>(o, vb0, pa0, pa1, pa2, pa3);
    SBAR(); VMWN(8); SWRITE_HK(0); SBAR();
    if (hi == 0) li_l[r32] = l_reg; asm volatile("s_waitcnt lgkmcnt(0)" ::: "memory");
    float rli[16];
#pragma unroll
    for (int r = 0; r < 16; ++r) rli[r] = __builtin_amdgcn_rcpf(li_l[crow(r, hi)]);
    bf16_t* Ow = cur.O + (size_t)(wid * QBLK) * OP;
    int r32e = r32, hie = hi; asm volatile("" : "+v"(r32e), "+v"(hie));
#pragma unroll
    for (int r = 0; r < 16; ++r) { const int orow = crow(r, hie);
#pragma unroll
        for (int d0 = 0; d0 < 4; ++d0) { const float v = o[d0][r] * rli[r];
            const float vn = __shfl_xor(v, 1);
            if ((r32e & 1) == 0) *(unsigned*)(Ow + (unsigned)(orow * OP + d0 * 32 + r32e)) = cvt_pk_bf16(v, vn); } }
    __syncthreads();
#undef RESC
#undef KBASE
#undef MLOAD
#undef MASKT
#undef HALF_STEP
}
#undef ROWK
#undef VMW
#undef VMWN
#undef SLOAD_H
#undef SWRITE_HK
#undef SWRITE_HV
#undef SWRITE_H
}
constexpr size_t MiB = 1u << 20;
constexpr size_t WS_CTL = 0, CTL_ZERO_BYTES = 1 * MiB;
constexpr int CW_TMO = 0, CW_BAR = 4096, CW_CNT = 16384;
constexpr size_t CTL_KMEAN = 512 * 1024;
constexpr size_t WS_ROPEA = 1 * MiB, WS_ROPEI = 2 * MiB;
constexpr size_t WS_WIN = 3 * MiB;
constexpr size_t WS_WBR = 48 * MiB, WS_WOUT = 56 * MiB, WS_WPG = 64 * MiB, WS_WPP = 72 * MiB;
constexpr size_t WS_WGU = 73 * MiB, WS_WD = 585 * MiB;
constexpr size_t WS_H1 = 841 * MiB, WS_PB = 873 * MiB;
constexpr size_t WS_QKV7 = 877 * MiB;
constexpr size_t WS_SG = 989 * MiB;
constexpr size_t WS_KI = 1053 * MiB, WS_WI = 1054 * MiB;
constexpr size_t WS_PLEB = 1055 * MiB;
constexpr size_t WS_SC = 1087 * MiB;
constexpr size_t WS_BM = 1343 * MiB, WS_SELB = 1351 * MiB;
constexpr size_t WS_OAB = 1352 * MiB, WS_MERGED = 1384 * MiB;
constexpr size_t WS_X1 = 1416 * MiB, WS_H2U = 1480 * MiB, WS_RSTD = 1512 * MiB;
constexpr size_t WS_LIST = 1513 * MiB, WS_GATES = 1514 * MiB;
constexpr size_t WS_ACT = 1515 * MiB;
constexpr size_t WS_YS = 1675 * MiB;
constexpr size_t WS_X2 = 1803 * MiB, WS_X2B = 1867 * MiB;
constexpr size_t WS_T = 1899 * MiB, WS_TSS = 1963 * MiB;
constexpr size_t WS_RSL = 1964 * MiB, WS_GTL = 1965 * MiB;
constexpr size_t WS_END = 1966 * MiB;

constexpr int NWAVES = 8;
constexpr int RING_BYTES = 131072, MISC_OFF = RING_BYTES, LDS_BYTES = RING_BYTES + 1024;
static_assert(att::LDS_BYTES <= RING_BYTES && pg8::STAGE_BYTES <= RING_BYTES, "LDS map");

typedef GAS unsigned gu32;
#define RLX_AGENT __ATOMIC_RELAXED, __HIP_MEMORY_SCOPE_AGENT
#define LDS_WAIT() asm volatile("s_waitcnt lgkmcnt(0)" ::: "memory")
#define VM_WAIT() asm volatile("s_waitcnt vmcnt(0)" ::: "memory")

#define XB_TMO      128
#define XB_XCNT(j)  (256  + 64 * (j))
#define XB_XSUB(j)  (1280 + 64 * (j))
#define XB_XGEN(j)  (2304 + 64 * (j))
#define XB_TOP      3328
#define XB_TOPGEN   3392
#define XCD_BAR_WORDS 3456
#define XB_SPIN_CAP (1u << 20)
__device__ __forceinline__ unsigned xb_ld(unsigned* p)              { return __hip_atomic_load(p, __ATOMIC_RELAXED, __HIP_MEMORY_SCOPE_AGENT); }
__device__ __forceinline__ unsigned xb_add(unsigned* p, unsigned v) { return __hip_atomic_fetch_add(p, v, __ATOMIC_RELAXED, __HIP_MEMORY_SCOPE_AGENT); }
__device__ __forceinline__ unsigned xb_xcc_id() { return (unsigned)__builtin_amdgcn_s_getreg((3 << 11) | 20) & 0xFu; }
#define XB_SPIN(cond, bar) do { unsigned _sp = 0; while (cond) { __builtin_amdgcn_s_sleep(1); \
    if ((++_sp & 255u) == 0u) { if (xb_ld(&(bar)[XB_TMO])) break; if (_sp > XB_SPIN_CAP) { atomicAdd(&(bar)[XB_TMO], 1u); break; } } } } while (0)
struct XcdBarrier { unsigned* bar; unsigned x; volatile LAS unsigned* st; int wave; };
__device__ __forceinline__ XcdBarrier xcd_barrier_post(unsigned* bar, volatile LAS unsigned* st, int wave) {
    XcdBarrier b; b.bar = bar; b.x = xb_xcc_id(); b.st = st; b.wave = wave;
    if (wave == 0 && lane_id_v() == 0) (void)xb_add(&bar[XB_XCNT(b.x)], 1u);
    return b;
}
__device__ __forceinline__ void xcd_barrier_complete(unsigned* bar, unsigned x, unsigned& nloc, unsigned& nx) {
    const unsigned G = gridDim.x * gridDim.y * gridDim.z;
    unsigned sum, cnt, mine, sp = 0u;
    for (;;) {
        sum = 0u; cnt = 0u; mine = 0u;
#pragma unroll
        for (unsigned j = 0; j < 16; ++j) { const unsigned c = xb_ld(&bar[XB_XCNT(j)]); sum += c; cnt += (c > 0u) ? 1u : 0u; mine = (j == x) ? c : mine; }
        if (sum == G) break;
        __builtin_amdgcn_s_sleep(1);
        if ((++sp & 255u) == 0u) { if (xb_ld(&bar[XB_TMO])) break; if (sp > XB_SPIN_CAP) { atomicAdd(&bar[XB_TMO], 1u); break; } }
    }
    nloc = mine > 0u ? mine : 1u; nx = cnt > 0u ? cnt : 1u;
}
__device__ __forceinline__ void xcd_barrier(const XcdBarrier& b) {
    asm volatile("s_waitcnt vmcnt(0)" ::: "memory");
    __syncthreads();
    if (b.wave == 0 && lane_id_v() == 0) {
        unsigned* bar = b.bar;
        __builtin_amdgcn_s_waitcnt(0);
        unsigned nloc = b.st[0], nx = b.st[1];
        if (nloc == 0u) { xcd_barrier_complete(bar, b.x, nloc, nx); b.st[0] = nloc; b.st[1] = nx; }
        const unsigned old = xb_add(&bar[XB_XSUB(b.x)], 1u);
        const unsigned gen = old / nloc;
        if (old + 1u == (gen + 1u) * nloc) {
            __builtin_amdgcn_fence(__ATOMIC_RELEASE, "agent");
            asm volatile("s_waitcnt vmcnt(0)" ::: "memory");
            const unsigned og = xb_add(&bar[XB_TOP], 1u);
            const unsigned tg = og / nx;
            if (og + 1u == (tg + 1u) * nx) xb_add(&bar[XB_TOPGEN], 1u);
            else XB_SPIN(xb_ld(&bar[XB_TOPGEN]) == tg, bar);
            __builtin_amdgcn_fence(__ATOMIC_ACQUIRE, "agent");
            xb_add(&bar[XB_XGEN(b.x)], 1u);
            asm volatile("s_waitcnt vmcnt(0)" ::: "memory");
        } else {
            XB_SPIN(xb_ld(&bar[XB_XGEN(b.x)]) == gen, bar);
            __builtin_amdgcn_fence(__ATOMIC_ACQUIRE, "agent");
            asm volatile("s_waitcnt vmcnt(0)" ::: "memory");
        }
    }
    __syncthreads();
}

__device__ __forceinline__ float wave_sum(float v) {
#pragma unroll
    for (int o = 1; o < 64; o <<= 1) v += __shfl_xor(v, o);
    return v;
}
__device__ __forceinline__ unsigned f2bf(float f) { unsigned u = __float_as_uint(f); return (u + 0x7fffu + ((u >> 16) & 1u)) >> 16; }
__device__ __forceinline__ unsigned pk2(float lo, float hi) { return f2bf(lo) | (f2bf(hi) << 16); }

struct MapId { __device__ __forceinline__ int operator()(int n) const { return n; } };
struct MapIn { __device__ __forceinline__ int operator()(int s) const {
    if (s < 4096) return s; if (s >= 4176) return s - 80;
    if (s < 4160) { const int j = s - 4096; return 11264 + (j < 32 ? j : 128 + (j - 32)); }
    return 11264 + 32 + (s - 4160); } };
struct MapGu { __device__ __forceinline__ int operator()(int s) const { return (s & ~255) + ((s & 1) << 7) + ((s & 255) >> 1); } };
constexpr int CV_PITCH = 128, CV_SCR = 12288;
struct P0Item { const float* W; int N; bf16_t* WT; int dpitch, koff, k0, n0, map; };
__device__ __forceinline__ void p0_item_load(const P0Item& it, int lane, f32x4 (&v)[16]) {
    int col = it.n0 + (lane & 15) * 4; if (col > it.N - 4) col = it.N - 4;
    const float* src = it.W + (size_t)(it.k0 + 2 * (lane >> 4)) * it.N + col;
#pragma unroll
    for (int i = 0; i < 8; ++i) { v[2 * i] = __builtin_nontemporal_load((const f32x4*)(src + (size_t)(8 * i) * it.N)); v[2 * i + 1] = __builtin_nontemporal_load((const f32x4*)(src + (size_t)(8 * i + 1) * it.N)); }
}
__device__ __forceinline__ void p0_item_load3(const P0Item& ia, const P0Item& ib, const P0Item& ic, int lane, f32x4 (&va)[16], f32x4 (&vb)[16], f32x4 (&vc)[16]) {
    int ca = ia.n0 + (lane & 15) * 4; if (ca > ia.N - 4) ca = ia.N - 4;
    int cb = ib.n0 + (lane & 15) * 4; if (cb > ib.N - 4) cb = ib.N - 4;
    int cc = ic.n0 + (lane & 15) * 4; if (cc > ic.N - 4) cc = ic.N - 4;
    const float* sa = ia.W + (size_t)(ia.k0 + 2 * (lane >> 4)) * ia.N + ca;
    const float* sb = ib.W + (size_t)(ib.k0 + 2 * (lane >> 4)) * ib.N + cb;
    const float* sc = ic.W + (size_t)(ic.k0 + 2 * (lane >> 4)) * ic.N + cc;
#pragma unroll
    for (int j = 0; j < 16; ++j) { const int ro = 8 * (j >> 1) + (j & 1);
        va[j] = __builtin_nontemporal_load((const f32x4*)(sa + (size_t)ro * ia.N)); vb[j] = __builtin_nontemporal_load((const f32x4*)(sb + (size_t)ro * ib.N)); vc[j] = __builtin_nontemporal_load((const f32x4*)(sc + (size_t)ro * ic.N));
        __builtin_amdgcn_sched_barrier(0); }
}
__device__ __forceinline__ void p0_item_finish(const P0Item& it, LAS unsigned char* scr, int lane, const f32x4 (&v)[16]) {
    const int nq = lane & 15, q = lane >> 4;
    LAS unsigned char* wb = scr + nq * 512 + 4 * q;
#pragma unroll
    for (int i = 0; i < 8; ++i) { LAS unsigned char* wp = wb + ((i ^ (nq & 7)) << 4);
#pragma unroll
        for (int e = 0; e < 4; ++e) *(LAS unsigned*)(wp + e * 128) = cvt_pk_bf16(v[2 * i][e], v[2 * i + 1][e]); }
    LDS_WAIT(); asm volatile("" ::: "memory");
    const int ar = lane >> 3, kc = lane & 7;
    bf16x8 pc[8];
#pragma unroll
    for (int s8 = 0; s8 < 8; ++s8) pc[s8] = *(const LAS bf16x8*)(scr + (8 * s8 + ar) * 128 + ((kc ^ ((2 * s8 + (ar >> 2)) & 7)) << 4));
    LDS_WAIT(); asm volatile("" ::: "memory");
#pragma unroll
    for (int s8 = 0; s8 < 8; ++s8) { const int sn = it.n0 + 8 * s8 + ar;
        const int dr = (it.map == 0 || it.map == 3) ? MapId()(sn) : (it.map == 1 ? MapIn()(sn) : MapGu()(sn));
        bf16_t* dst = (it.map >= 2) ? it.WT + ((size_t)(dr >> 6) * (it.dpitch >> 6) + (it.k0 >> 6)) * 4096 + (dr & 63) * 64
                                     : it.WT + (size_t)dr * it.dpitch + it.koff + it.k0;
        if (sn < it.N) *(bf16x8*)(dst + 8 * kc) = pc[s8]; }
}
struct Args { const float* in[20]; float* out; unsigned char* ws; int ph_lo, ph_hi; };
enum { IN_X = 0, IN_P, IN_GMIX, IN_WIN, IN_GIDX, IN_BIDX, IN_WBRA, IN_WBRB, IN_WOUT, IN_GFFN, IN_WROUTER, IN_BROUTER, IN_WGU, IN_BGU, IN_WDOWN, IN_BDOWN, IN_WPP, IN_WPG, IN_GPLE, IN_GFINAL };

constexpr int NB_IN = (INW + 63) / 64;
constexpr int CI_IN = 32 * NB_IN, CI_BR = 16 * 32, CI_SQ = 32 * 32, CI_PP = 4 * 32, CI_GU1 = 32 * 64, CI_D1 = 32 * 32;
constexpr int CD0 = CI_IN, CD1 = CD0 + CI_BR, CD2 = CD1 + CI_BR, CD3 = CD2 + CI_SQ, CD4 = CD3 + CI_SQ, CD5 = CD4 + CI_PP;
constexpr int CE_GU = NEXP * CI_GU1, CE_ALL = CE_GU + NEXP * CI_D1;
__device__ __forceinline__ P0Item p0_dense_item(const Args& a, int it) {
    unsigned char* ws = a.ws;
    if (it < CD0) return P0Item{a.in[IN_WIN], INW, (bf16_t*)(ws + WS_WIN), DM, 0, 64 * (it / NB_IN), 64 * (it % NB_IN), 1};
    if (it < CD1) { const int r = it - CD0; return P0Item{a.in[IN_WBRA], DM, (bf16_t*)(ws + WS_WBR), DM, 0, 64 * (r / 32), 64 * (r % 32), 0}; }
    if (it < CD2) { const int r = it - CD1; return P0Item{a.in[IN_WBRB], DM, (bf16_t*)(ws + WS_WBR), DM, BRW, 64 * (r / 32), 64 * (r % 32), 0}; }
    if (it < CD3) { const int r = it - CD2; return P0Item{a.in[IN_WOUT], DM, (bf16_t*)(ws + WS_WOUT), DM, 0, 64 * (r / 32), 64 * (r % 32), 0}; }
    if (it < CD4) { const int r = it - CD3; return P0Item{a.in[IN_WPG], DM, (bf16_t*)(ws + WS_WPG), DM, 0, 64 * (r / 32), 64 * (r % 32), 0}; }
    { const int r = it - CD4; return P0Item{a.in[IN_WPP], DM, (bf16_t*)(ws + WS_WPP), PLED, 0, 64 * (r / 32), 64 * (r % 32), 0}; }
}
__device__ __forceinline__ P0Item p0_expert_item(const Args& a, int it) {
    unsigned char* ws = a.ws;
    if (it < CE_GU) { const int e = it / CI_GU1, r = it % CI_GU1; return P0Item{a.in[IN_WGU] + (size_t)e * DM * (2 * DFF), 2 * DFF, (bf16_t*)(ws + WS_WGU) + (size_t)e * (2 * DFF) * DM, DM, 0, 64 * (r / 64), 64 * (r % 64), 2}; }
    { const int r2 = it - CE_GU, e = r2 / CI_D1, r = r2 % CI_D1; return P0Item{a.in[IN_WDOWN] + (size_t)e * DFF * DM, DM, (bf16_t*)(ws + WS_WD) + (size_t)e * DM * DFF, DFF, 0, 64 * (r / 32), 64 * (r % 32), 3}; }
}
template <int EXPERT>
__device__ __forceinline__ void p0_convert_strided(const Args& a, LAS unsigned char* scr, int lane, int first, int stride, int n_items) {
    if (first >= n_items) return;
    P0Item cur = EXPERT ? p0_expert_item(a, first) : p0_dense_item(a, first), nxt = cur; f32x4 va[16], vb[16];
    p0_item_load(cur, lane, va);
    for (int it = first; it < n_items; it += 2 * stride) {
        const bool h1 = it + stride < n_items;
        if (h1) { nxt = EXPERT ? p0_expert_item(a, it + stride) : p0_dense_item(a, it + stride); p0_item_load(nxt, lane, vb); }
        p0_item_finish(cur, scr, lane, va);
        if (!h1) break;
        const bool h2 = it + 2 * stride < n_items;
        if (h2) { cur = EXPERT ? p0_expert_item(a, it + 2 * stride) : p0_dense_item(a, it + 2 * stride); p0_item_load(cur, lane, va); }
        p0_item_finish(nxt, scr, lane, vb);
        if (!h2) break;
    }
}
__device__ __forceinline__ void p0_prologue(const Args& a, LAS unsigned char* lds, int c, int G, int wave, int lane) {
    unsigned char* ws = a.ws;
    LAS unsigned char* scr = lds + wave * CV_SCR;
    const int gw = c * NWAVES + wave, NGW = G * NWAVES;
    p0_convert_strided<0>(a, scr, lane, gw, NGW, CD5);
    { const float* X = a.in[IN_X]; const f32x4* g4 = (const f32x4*)a.in[IN_GMIX]; bf16_t* H1 = (bf16_t*)(ws + WS_H1);
      for (int m = gw; m < SEQ; m += NGW) { const f32x4* xr = (const f32x4*)(X + (size_t)m * DM) + lane; f32x4 v[8]; float s = 0.f;
#pragma unroll
          for (int j = 0; j < 8; ++j) { v[j] = __builtin_nontemporal_load(xr + 64 * j); s += (v[j].x * v[j].x + v[j].y * v[j].y) + (v[j].z * v[j].z + v[j].w * v[j].w); }
          const float rstd = rsqrtf(wave_sum(s) * (1.f / DM) + EPS);
          unsigned long long* o8 = (unsigned long long*)(H1 + (size_t)m * DM) + lane;
#pragma unroll
          for (int j = 0; j < 8; ++j) { const f32x4 g = g4[lane + 64 * j];
              o8[64 * j] = (unsigned long long)pk2(v[j].x * rstd * g.x, v[j].y * rstd * g.y) | ((unsigned long long)pk2(v[j].z * rstd * g.z, v[j].w * rstd * g.w) << 32); } } }
    { const f32x4* P4 = (const f32x4*)a.in[IN_P]; unsigned long long* o8 = (unsigned long long*)(ws + WS_PB);
      for (int i = gw * 64 + lane; i < SEQ * PLED / 4; i += NGW * 64) { const f32x4 v = P4[i]; o8[i] = (unsigned long long)pk2(v.x, v.y) | ((unsigned long long)pk2(v.z, v.w) << 32); } }
    { float* RA = (float*)(ws + WS_ROPEA); float* RI = (float*)(ws + WS_ROPEI);
      for (int i = gw * 64 + lane; i < SEQ * 24; i += NGW * 64) { const int pos = i / 24, j = i % 24;
          const double ex = (j < 16) ? (double)j / 16.0 : (double)(j - 16) / 8.0;
          const float inv = (float)(1.0 / pow(500000.0, ex)); const float ang = (float)pos * inv;
          const float cv = (float)cos((double)ang), sv = (float)sin((double)ang);
          if (j < 16) { RA[((size_t)pos * 16 + j) * 2] = cv; RA[((size_t)pos * 16 + j) * 2 + 1] = sv; } else { RI[((size_t)pos * 8 + (j - 16)) * 2] = cv; RI[((size_t)pos * 8 + (j - 16)) * 2 + 1] = sv; } } }
}

__device__ __forceinline__ int cv_ticket(volatile LAS unsigned* ctr, int lane) {
    unsigned t = 0; if (lane == 0) t = __hip_atomic_fetch_add((LAS unsigned*)ctr, 1u, __ATOMIC_RELAXED, __HIP_MEMORY_SCOPE_WORKGROUP);
    return (int)__builtin_amdgcn_readfirstlane(t);
}
__device__ __forceinline__ void p2_convert_experts(const Args& a, LAS unsigned char* scr, volatile LAS unsigned* ctr, int c, int G, int lane, volatile LAS unsigned* flag, unsigned stop_at) {
    const int n_cu = (CE_ALL - c + G - 1) / G;
    const bool adj = (CE_ALL % (6 * G)) == 0;
#define CV_ITEM(j) (adj ? ((tk / 6) * G + c) * 6 + (j) : (tk + (j)) * G + c)
    for (;;) {
        if (stop_at != 0xffffffffu && (unsigned)__builtin_amdgcn_readfirstlane((int)*flag) >= stop_at) return;
        unsigned t0 = 0; if (lane == 0) t0 = __hip_atomic_fetch_add((LAS unsigned*)ctr, 6u, __ATOMIC_RELAXED, __HIP_MEMORY_SCOPE_WORKGROUP);
        const int tk = (int)__builtin_amdgcn_readfirstlane(t0);
        if (tk >= n_cu) return;
        if (tk + 6 <= n_cu) {
            f32x4 va[16], vb[16], vc[16];
#pragma unroll 1
            for (int h = 0; h < 2; ++h) {
                const P0Item i0 = p0_expert_item(a, CV_ITEM(3 * h + 0)), i1 = p0_expert_item(a, CV_ITEM(3 * h + 1)), i2 = p0_expert_item(a, CV_ITEM(3 * h + 2));
                p0_item_load3(i0, i1, i2, lane, va, vb, vc);
                p0_item_finish(i0, scr, lane, va); p0_item_finish(i1, scr, lane, vb); p0_item_finish(i2, scr, lane, vc);
            }
        } else {
            for (int k = tk; k < n_cu; ++k) { f32x4 v[16]; const P0Item it = p0_expert_item(a, k * G + c); p0_item_load(it, lane, v); p0_item_finish(it, scr, lane, v); }
        }
    }
#undef CV_ITEM
}
#ifndef REPEAT_MASK
#define REPEAT_MASK 0
#endif
#define P2_NREP(k) ((((REPEAT_MASK) >> (k)) & 1) ? 2 : 1)
#ifndef P2_NIDX
#define P2_NIDX 4
#endif
__device__ __forceinline__ unsigned f2ord(float f) { unsigned b = __float_as_uint(f); if ((b << 1) == 0u) b = 0u; return b ^ ((b >> 31) ? 0xffffffffu : 0x80000000u); }
__device__ __forceinline__ void idx_scores(const Args& a, int q0, int lane_in) {
    unsigned char* ws = a.ws;
    const bf16_t* QI = (const bf16_t*)(ws + WS_QKV7) + (size_t)3 * SEQ * BRW; const bf16_t* KI = (const bf16_t*)(ws + WS_KI); const float* WI = (const float*)(ws + WS_WI);
    float* SC = (float*)(ws + WS_SC);
    int lane = lane_in; asm volatile("" : "+v"(lane));
    const int r = lane & 31, hh = lane >> 5;
    {
        bf16x8 af[2][4]; float wreg[2][16];
#pragma unroll
        for (int t2 = 0; t2 < 2; ++t2) { const int qa = q0 + 2 * t2 + (r >> 4);
#pragma unroll
            for (int s = 0; s < 4; ++s) af[t2][s] = *(const bf16x8*)(QI + (size_t)qa * BRW + (r & 15) * IDXD + 16 * s + 8 * hh);
#pragma unroll
            for (int i = 0; i < 16; ++i) { const int row = (i & 3) + 8 * (i >> 2) + 4 * hh; wreg[t2][i] = WI[(size_t)(q0 + 2 * t2 + (row >> 4)) * IDXH + (row & 15)]; } }
        const int ntile = ((q0 + 3) >> 5) + 1;
#define IDX_LOADB(dst, tile) do { const int tl_ = (tile) < 256 ? (tile) : 255; _Pragma("unroll") for (int s = 0; s < 4; ++s) dst[s] = *(const bf16x8*)(KI + (size_t)(32 * tl_ + r) * IDXD + 16 * s + 8 * hh); } while (0)
#define IDX_TILE(bc, jt_) do { _Pragma("unroll") for (int t2 = 0; t2 < 2; ++t2) { \
            f32x16 ac = {}; \
            _Pragma("unroll") for (int s = 0; s < 4; ++s) ac = __builtin_amdgcn_mfma_f32_32x32x16_bf16(af[t2][s], bc[s], ac, 0, 0, 0); \
            float s0 = 0.f, s1 = 0.f; \
            _Pragma("unroll") for (int i = 0; i < 8; ++i) { s0 += wreg[t2][i] * __builtin_amdgcn_fmed3f(ac[i], 0.f, 3.0e38f); s1 += wreg[t2][8 + i] * __builtin_amdgcn_fmed3f(ac[8 + i], 0.f, 3.0e38f); }     \
            const float send = hh ? s0 : s1, keep = hh ? s1 : s0; \
            const float tot = keep + __shfl_xor(send, 32); \
            SC[(size_t)(q0 + 2 * t2 + hh) * SEQ + 32 * (jt_) + r] = tot; } } while (0)
        bf16x8 b0[4], b1[4], b2[4], b3[4];
        IDX_LOADB(b0, 0); IDX_LOADB(b1, 1); IDX_LOADB(b2, 2); IDX_LOADB(b3, 3);
        for (int jt = 0; jt < ntile; jt += 4) {
            { bf16x8 bc[4]; _Pragma("unroll") for (int s = 0; s < 4; ++s) bc[s] = b0[s]; IDX_LOADB(b0, jt + 4); IDX_TILE(bc, jt); }
            if (jt + 1 < ntile) { bf16x8 bc[4]; _Pragma("unroll") for (int s = 0; s < 4; ++s) bc[s] = b1[s]; IDX_LOADB(b1, jt + 5); IDX_TILE(bc, jt + 1); }
            if (jt + 2 < ntile) { bf16x8 bc[4]; _Pragma("unroll") for (int s = 0; s < 4; ++s) bc[s] = b2[s]; IDX_LOADB(b2, jt + 6); IDX_TILE(bc, jt + 2); }
            if (jt + 3 < ntile) { bf16x8 bc[4]; _Pragma("unroll") for (int s = 0; s < 4; ++s) bc[s] = b3[s]; IDX_LOADB(b3, jt + 7); IDX_TILE(bc, jt + 3); }
        }
#undef IDX_LOADB
#undef IDX_TILE
    }
}
__device__ __forceinline__ void idx_select_rows(const Args& a, int q0, int nrows, int lane_in) {
    unsigned char* ws = a.ws;
    float* SC = (float*)(ws + WS_SC); unsigned long long* BM = (unsigned long long*)(ws + WS_BM);
    int lane = lane_in;
    {
        for (int qq = 0; qq < nrows; ++qq) {
            asm volatile("" : "+v"(lane));
            const int t = q0 + qq;
            unsigned long long* brow = BM + (size_t)t * (SEQ / 64);
            if (t < DSA_TOPK) {
#pragma unroll
                for (int w2 = 0; w2 < 2; ++w2) { const int j = lane + 64 * w2, lo = 64 * j;
                    brow[j] = (t >= lo + 63) ? ~0ull : (t < lo ? 0ull : ((2ull << (t - lo)) - 1ull)); }
                continue;
            }
            const int nj = (t >> 6) + 1;
            unsigned u[128];
            const float* srow = SC + (size_t)t * SEQ;
#pragma unroll
            for (int ch = 0; ch < 8; ++ch) {
                const float* cb = (ch * 16 < nj) ? srow : srow - 1024 * ch;
#pragma unroll
                for (int jj = 0; jj < 16; ++jj) { const int j = ch * 16 + jj;
                    u[j] = __float_as_uint(__builtin_nontemporal_load(cb + lane + 64 * j)); }
            }
#pragma unroll
            for (int ch = 0; ch < 8; ++ch) {
                if (ch * 16 < nj) {
#pragma unroll
                    for (int jj = 0; jj < 16; ++jj) { const int j = ch * 16 + jj, key = 64 * j + lane; const int neg = (t - key) >> 31;
                        u[j] = f2ord(__uint_as_float(u[j])) & ~(unsigned)neg; }
                } else {
#pragma unroll
                    for (int jj = 0; jj < 16; ++jj) u[ch * 16 + jj] = 0u;
                }
            }
            unsigned T = 0u; int Ti = 0; bool exact = false;
            for (int b = 31; b >= 0; --b) {
                const unsigned Tc = T | (1u << b); int cnt = 0;
#pragma unroll
                for (int ch = 0; ch < 8; ++ch) {
                    if (ch * 16 < nj) {
#pragma unroll
                        for (int jj = 0; jj < 16; ++jj) { cnt += __popcll(__ballot(u[ch * 16 + jj] >= Tc)); if ((jj & 3) == 3) __builtin_amdgcn_sched_barrier(0); }
                    }
                }
                if (cnt >= DSA_TOPK) T = Tc;
                if (cnt == DSA_TOPK) { exact = true; break; }
            }
            if (!exact) {
                for (int b = 12; b >= 0; --b) {
                    const int Tic = Ti | (1 << b); int cnt = 0; unsigned Tl = T; asm volatile("" : "+s"(Tl));
#pragma unroll
                    for (int ch = 0; ch < 8; ++ch) {
                        if (ch * 16 < nj) {
#pragma unroll
                            for (int jj = 0; jj < 16; ++jj) { const int j = ch * 16 + jj;
                                cnt += __popcll(__ballot((u[j] > Tl) || (u[j] == Tl && lane <= (SEQ - 1 - 64 * j) - Tic))); if ((jj & 3) == 3) __builtin_amdgcn_sched_barrier(0); }
                        }
                    }
                    if (cnt >= DSA_TOPK) Ti = Tic;
                    if (cnt == DSA_TOPK) break;
                }
            }
            int w0l = 0, w0h = 0, w1l = 0, w1h = 0; asm volatile("" : "+s"(T), "+s"(Ti));
#pragma unroll
            for (int ch = 0; ch < 8; ++ch) {
                if (ch * 16 < nj) {
#pragma unroll
                    for (int jj = 0; jj < 16; ++jj) { const int j = ch * 16 + jj;
                        const unsigned long long word = __ballot((u[j] > T) || (u[j] == T && lane <= (SEQ - 1 - 64 * j) - Ti));
                        const int lo = (int)(unsigned)word, hi = (int)(unsigned)(word >> 32);
                        if (j < 64) { w0l = (lane == (j & 63)) ? lo : w0l; w0h = (lane == (j & 63)) ? hi : w0h; }
                        else { w1l = (lane == (j & 63)) ? lo : w1l; w1h = (lane == (j & 63)) ? hi : w1h; }
                        if ((jj & 3) == 3) __builtin_amdgcn_sched_barrier(0); }
                }
            }
            brow[lane] = ((unsigned long long)(unsigned)w0h << 32) | (unsigned)w0l;
            brow[64 + lane] = ((unsigned long long)(unsigned)w1h << 32) | (unsigned)w1l;
        }
    }
}
__device__ __forceinline__ void p2_indexer_and_convert(const Args& a, LAS unsigned char* lds, volatile LAS unsigned* MISC, int c, int G, int wave, int lane) {
    const int w = wave & 3; volatile LAS unsigned* flag = MISC + 24 + w; volatile LAS unsigned* ctr = MISC + 16;
    LAS unsigned char* scr = lds + wave * CV_SCR;
    if (wave < 4) {
        for (int p = c; p < 256; p += G) {
            const int qh = (511 - p) * 16 + w * 4, ql = p * 16 + w * 4;
            for (int rep_s = 0; rep_s < P2_NREP(12); ++rep_s) { idx_scores(a, qh, lane); idx_scores(a, ql, lane); }
        }
        VM_WAIT();
    }
    p2_convert_experts(a, scr, ctr, c, G, lane, flag, 0xffffffffu);
    __syncthreads();
    for (int p = c; p < 256; p += G) {
        for (int rep_q = 0; rep_q < P2_NREP(13); ++rep_q) { idx_select_rows(a, p * 16 + 2 * wave, 2, lane); idx_select_rows(a, (511 - p) * 16 + 2 * wave, 2, lane); }
    }
}
__device__ __forceinline__ void p2_moba_gate(const Args& a, LAS unsigned char* lds, int c, int G, int wave, int lane) {
    unsigned char* ws = a.ws;
    const bf16_t* QBp = (const bf16_t*)(ws + WS_QKV7) + (size_t)4 * SEQ * BRW; const float* KM = (const float*)(ws + WS_CTL + CTL_KMEAN); unsigned* SELB = (unsigned*)(ws + WS_SELB);
    const int r = lane & 31, hh = lane >> 5;
    LAS float* scr = (LAS float*)(lds + wave * 4352);
    for (int base = c * 256; base < SEQ * NHEAD; base += G * 256) {
        const int h = base >> 13, t0 = (base & (SEQ - 1)) + 32 * wave, own = t0 >> 8;
        if (own > 0) {
            f32x16 acc = {};
#pragma unroll
            for (int s8 = 0; s8 < 8; ++s8) {
                const bf16x8 af = *(const bf16x8*)(QBp + (size_t)(t0 + r) * BRW + h * HD + 16 * s8 + 8 * hh);
                const f32x4 k0 = *(const f32x4*)(KM + (size_t)r * BRW + h * HD + 16 * s8 + 8 * hh), k1 = *(const f32x4*)(KM + (size_t)r * BRW + h * HD + 16 * s8 + 8 * hh + 4);
                float kv[8];
#pragma unroll
                for (int i = 0; i < 4; ++i) { kv[i] = k0[i] * (1.f / MOBA_BLK); kv[4 + i] = k1[i] * (1.f / MOBA_BLK); }
                unsigned bh[4], bl[4];
#pragma unroll
                for (int i = 0; i < 4; ++i) { bh[i] = cvt_pk_bf16(kv[2 * i], kv[2 * i + 1]); bl[i] = cvt_pk_bf16(kv[2 * i] - bf_lo(bh[i]), kv[2 * i + 1] - bf_hi(bh[i])); }
                u32x4 BH = {bh[0], bh[1], bh[2], bh[3]}, BL = {bl[0], bl[1], bl[2], bl[3]};
                acc = __builtin_amdgcn_mfma_f32_32x32x16_bf16(af, *(bf16x8*)&BH, acc, 0, 0, 0);
                acc = __builtin_amdgcn_mfma_f32_32x32x16_bf16(af, *(bf16x8*)&BL, acc, 0, 0, 0);
            }
#pragma unroll
            for (int i = 0; i < 16; ++i) scr[((i & 3) + 8 * (i >> 2) + 4 * hh) * 33 + r] = acc[i];
            LDS_WAIT(); asm volatile("" ::: "memory");
            float v[32];
#pragma unroll
            for (int m = 0; m < 32; ++m) v[m] = scr[r * 33 + m];
            unsigned selw = 0u;
#pragma unroll
            for (int rd = 0; rd < 3; ++rd) { float best = -__builtin_inff(); int bi = -1;
#pragma unroll
                for (int m = 0; m < 32; ++m) { if (m < own && v[m] > best) { best = v[m]; bi = m; } }
                if (bi >= 0) selw |= 1u << bi;
#pragma unroll
                for (int m = 0; m < 32; ++m) v[m] = (m == bi) ? -__builtin_inff() : v[m]; }
            if (lane < 32) SELB[(size_t)(t0 + r) * NHEAD + h] = selw;
            LDS_WAIT(); asm volatile("" ::: "memory");
        } else { if (lane < 32) SELB[(size_t)(t0 + r) * NHEAD + h] = 0u; }
    }
}

__device__ __forceinline__ void p6_route(const Args& a, LAS unsigned char* lds, int c, int G, int wave, int lane) {
    unsigned char* ws = a.ws;
    const float* X1 = (const float*)(ws + WS_X1); const float* gf = a.in[IN_GFFN]; const float* WR = a.in[IN_WROUTER]; const float* BR = a.in[IN_BROUTER];
    bf16_t* H2U = (bf16_t*)(ws + WS_H2U); float* RSTD = (float*)(ws + WS_RSTD); int* LIST = (int*)(ws + WS_LIST); float* GATES = (float*)(ws + WS_GATES);
    float* RSL = (float*)(ws + WS_RSL); float* GTL = (float*)(ws + WS_GTL);
    unsigned* CNT = (unsigned*)(ws + WS_CTL) + CW_CNT;
    LAS float* part = (LAS float*)lds;
    LAS float* ssp = (LAS float*)(lds + 32768);
    LAS int* hist = (LAS int*)(lds + 32768 + 2048);
    LAS int* hbase = hist + 32;
    const int r = lane & 31, hh = lane >> 5;
    for (int un = c; un < SEQ / 32; un += G) {
        const int t0 = un * 32;
        f32x16 acc = {}; float ss = 0.f;
        const int kbase = wave * 256;
        for (int ks = 0; ks < 16; ++ks) {
            const int k0 = kbase + ks * 16 + 8 * hh;
            const f32x4 xa = *(const f32x4*)(X1 + (size_t)(t0 + r) * DM + k0), xb = *(const f32x4*)(X1 + (size_t)(t0 + r) * DM + k0 + 4);
            const f32x4 ga = *(const f32x4*)(gf + k0), gb = *(const f32x4*)(gf + k0 + 4);
            float av[8], bv[8];
#pragma unroll
            for (int i = 0; i < 4; ++i) { ss += xa[i] * xa[i] + xb[i] * xb[i]; av[i] = xa[i] * ga[i]; av[4 + i] = xb[i] * gb[i]; }
#pragma unroll
            for (int i = 0; i < 8; ++i) bv[i] = WR[(size_t)(k0 + i) * NEXP + r];
            unsigned ahi[4], alo[4], bhi[4], blo[4];
#pragma unroll
            for (int i = 0; i < 4; ++i) { ahi[i] = cvt_pk_bf16(av[2 * i], av[2 * i + 1]); alo[i] = cvt_pk_bf16(av[2 * i] - bf_lo(ahi[i]), av[2 * i + 1] - bf_hi(ahi[i]));
                                          bhi[i] = cvt_pk_bf16(bv[2 * i], bv[2 * i + 1]); blo[i] = cvt_pk_bf16(bv[2 * i] - bf_lo(bhi[i]), bv[2 * i + 1] - bf_hi(bhi[i])); }
            u32x4 AH = {ahi[0], ahi[1], ahi[2], ahi[3]}, AL = {alo[0], alo[1], alo[2], alo[3]}, BH = {bhi[0], bhi[1], bhi[2], bhi[3]}, BL = {blo[0], blo[1], blo[2], blo[3]};
            *(u32x4*)(H2U + (size_t)(t0 + r) * DM + k0) = AH;
            acc = __builtin_amdgcn_mfma_f32_32x32x16_bf16(*(bf16x8*)&AH, *(bf16x8*)&BH, acc, 0, 0, 0);
            acc = __builtin_amdgcn_mfma_f32_32x32x16_bf16(*(bf16x8*)&AH, *(bf16x8*)&BL, acc, 0, 0, 0);
            acc = __builtin_amdgcn_mfma_f32_32x32x16_bf16(*(bf16x8*)&AL, *(bf16x8*)&BH, acc, 0, 0, 0);
        }
#pragma unroll
        for (int i = 0; i < 16; ++i) part[(wave * 32 + (i & 3) + 8 * (i >> 2) + 4 * hh) * 32 + r] = acc[i];
        ssp[(wave * 32 + r) * 2 + hh] = ss;
        const bool w0 = (wave == 0) && (lane < 32);
        if (w0) hist[lane] = 0;
        __syncthreads();
        int ek[4]; int pl[4]; float gk[4]; float rstd = 0.f;
        if (w0) {
            const int tk = lane; float lg[32]; float s2 = 0.f;
#pragma unroll
            for (int w = 0; w < 8; ++w) s2 += ssp[(w * 32 + tk) * 2] + ssp[(w * 32 + tk) * 2 + 1];
            rstd = rsqrtf(s2 * (1.f / DM) + EPS);
#pragma unroll
            for (int e = 0; e < 32; ++e) { float s = 0.f;
#pragma unroll
                for (int w = 0; w < 8; ++w) s += part[(w * 32 + tk) * 32 + e];
                lg[e] = s * rstd + BR[e]; }
            float tv[4];
#pragma unroll
            for (int k = 0; k < 4; ++k) { float best = -__builtin_inff(); int bi = 0;
#pragma unroll
                for (int e = 0; e < 32; ++e) { if (lg[e] > best) { best = lg[e]; bi = e; } }
                tv[k] = best; ek[k] = bi;
#pragma unroll
                for (int e = 0; e < 32; ++e) lg[e] = (e == bi) ? -__builtin_inff() : lg[e]; }
            float den = 0.f;
#pragma unroll
            for (int k = 0; k < 4; ++k) { gk[k] = __expf(tv[k] - tv[0]); den += gk[k]; }
            const float rden = 1.f / den;
#pragma unroll
            for (int k = 0; k < 4; ++k) { gk[k] *= rden; pl[k] = __hip_atomic_fetch_add(&hist[ek[k]], 1, __ATOMIC_RELAXED, __HIP_MEMORY_SCOPE_WORKGROUP); }
        }
        __syncthreads();
        if (w0) { const int hc = hist[lane]; hbase[lane] = hc > 0 ? (int)atomicAdd(&CNT[lane], (unsigned)hc) : 0; }
        __syncthreads();
        if (w0) { const int tok = t0 + lane; RSTD[tok] = rstd;
#pragma unroll
            for (int k = 0; k < 4; ++k) { const int pos = hbase[ek[k]] + pl[k]; if (pos < SEQ) { LIST[(size_t)ek[k] * SEQ + pos] = tok * 4 + k; RSL[(size_t)ek[k] * SEQ + pos] = rstd; GTL[(size_t)ek[k] * SEQ + pos] = gk[k]; } GATES[tok * 4 + k] = gk[k]; } }
        __syncthreads();
    }
}

__device__ __forceinline__ void p9_x2(const Args& a, int c, int G, int wave, int lane) {
    unsigned char* ws = a.ws; const float* X1 = (const float*)(ws + WS_X1); const bf16_t* YS = (const bf16_t*)(ws + WS_YS); bf16_t* X2B = (bf16_t*)(ws + WS_X2B);
    const int gw = c * NWAVES + wave, NGW = G * NWAVES;
    for (int m = gw; m < SEQ; m += NGW) {
#pragma unroll
        for (int j = 0; j < 4; ++j) { const int col = (j * 64 + lane) * 8; const size_t o = (size_t)m * DM + col;
            f32x4 v0 = __builtin_nontemporal_load((const f32x4*)(X1 + o)), v1 = __builtin_nontemporal_load((const f32x4*)(X1 + o + 4));
#pragma unroll
            for (int k = 0; k < 4; ++k) { float y[8]; unpack8bf(__builtin_nontemporal_load((const u32x4*)(YS + ((size_t)m * 4 + k) * DM + col)), y);
#pragma unroll
                for (int i = 0; i < 4; ++i) { v0[i] += y[i]; v1[i] += y[4 + i]; } }
            *(u32x4*)(X2B + o) = pack8bf(v0, v1); }
    }
}
__device__ __forceinline__ void p11_final(const Args& a, int c, int G, int wave, int lane) {
    unsigned char* ws = a.ws; const bf16_t* X2B = (const bf16_t*)(ws + WS_X2B); const bf16_t* T = (const bf16_t*)(ws + WS_T); const float* TSS = (const float*)(ws + WS_TSS);
    const float* gp = a.in[IN_GPLE]; const float* gfin = a.in[IN_GFINAL]; float* out = a.out;
    const int gw = c * NWAVES + wave, NGW = G * NWAVES;
    for (int m = gw; m < SEQ; m += NGW) {
        float ts = (lane < 32) ? TSS[(size_t)m * 32 + lane] : 0.f; ts = wave_sum(ts);
        const float rt = rsqrtf(ts * (1.f / DM) + EPS);
        f32x4 v[8]; float s = 0.f;
#pragma unroll
        for (int j = 0; j < 8; ++j) { const size_t o = (size_t)m * DM + (j * 64 + lane) * 4; const u32x2 xw = __builtin_nontemporal_load((const u32x2*)(X2B + o)), tw = __builtin_nontemporal_load((const u32x2*)(T + o)); const f32x4 g = *(const f32x4*)(gp + (j * 64 + lane) * 4);
            const f32x4 x = {bf_lo(xw.x), bf_hi(xw.x), bf_lo(xw.y), bf_hi(xw.y)}, t = {bf_lo(tw.x), bf_hi(tw.x), bf_lo(tw.y), bf_hi(tw.y)};
            v[j] = x + t * rt * g; s += (v[j].x * v[j].x + v[j].y * v[j].y) + (v[j].z * v[j].z + v[j].w * v[j].w); }
        const float r3 = rsqrtf(wave_sum(s) * (1.f / DM) + EPS);
#pragma unroll
        for (int j = 0; j < 8; ++j) { const f32x4 g = *(const f32x4*)(gfin + (j * 64 + lane) * 4); *(f32x4*)(out + (size_t)m * DM + (j * 64 + lane) * 4) = v[j] * r3 * g; }
    }
}
constexpr int N_PHASES = 12;
__global__ void __launch_bounds__(NWAVES * 64, 2) hybrid_fwd(Args args) {
    extern __shared__ __attribute__((aligned(16))) unsigned char lds_raw[];
    LAS unsigned char* lds = (LAS unsigned char*)lds_raw;
    volatile LAS unsigned* MISC = (volatile LAS unsigned*)(lds + MISC_OFF);
    const int wave = __builtin_amdgcn_readfirstlane(threadIdx.x >> 6);
    const int G = gridDim.x, c = blockIdx.x;
    unsigned char* ws = args.ws;
    unsigned* ctl = (unsigned*)(ws + WS_CTL);
    for (int u = wave * 64 + lane_id_v(); u < (LDS_BYTES - MISC_OFF) / 4; u += NWAVES * 64) ((LAS unsigned*)(lds + MISC_OFF))[u] = 0u;
    __syncthreads();
    const int lo = args.ph_lo, hi = args.ph_hi;
    XcdBarrier bar; bar.bar = ctl + CW_BAR; bar.x = 0; bar.st = nullptr; bar.wave = wave;
    if (hi - lo > 1) bar = xcd_barrier_post(ctl + CW_BAR, MISC + 8, wave);
#ifndef PH_MASK
#define PH_MASK 0xFFF
#endif
#define IN(k) ((((PH_MASK) >> (k)) & 1) && lo <= (k) && (k) < hi)
#define BOTH(k) (IN(k) && IN((k) + 1))
#define SEAM(k) do { if (BOTH(k)) xcd_barrier(bar); } while (0)
#ifndef REPEAT_MASK
#define REPEAT_MASK 0
#endif
#define NREP(k) ((((REPEAT_MASK) >> (k)) & 1) ? 2 : 1)
#define REP_BEGIN(k) for (int rep_ = 0; rep_ < NREP(k); ++rep_) { if (rep_) xcd_barrier(bar);
#define REP_END }

    bf16_t* QKV7 = (bf16_t*)(ws + WS_QKV7);
    if (IN(0)) { REP_BEGIN(0) p0_prologue(args, lds, c, G, wave, lane_id_v()); REP_END SEAM(0); }

    if (IN(1)) {
        REP_BEGIN(1)
        { pg8::DenseOrder S; S.init(SEQ, NPRJ, G, c);
          EpiInProj E{0, QKV7, (bf16_t*)(ws + WS_SG), (bf16_t*)(ws + WS_KI), (float*)(ws + WS_WI), (float*)(ws + WS_CTL + CTL_KMEAN), (const float*)(ws + WS_ROPEA), (const float*)(ws + WS_ROPEI), args.in[IN_GIDX], args.in[IN_BIDX]};
          pg8::gemm_phase<EpiInProj, pg8::DenseOrder, false, true>(lds, (const bf16_t*)(ws + WS_H1), (const bf16_t*)(ws + WS_WIN), DM, S, E, wave); }
        { constexpr int NU_IN = (SEQ / 256) * (NPRJ / 256); const int rem = NU_IN % G;
          pg8::DenseOrder S; if (rem == 0) S.init(SEQ, DM, G, c); else S.init(SEQ, DM, G - rem, c >= rem ? c - rem : (1 << 30));
          EpiBf16Plain E{0, (bf16_t*)(ws + WS_PLEB), DM};
          pg8::gemm_phase<EpiBf16Plain, pg8::DenseOrder, false, true>(lds, (const bf16_t*)(ws + WS_PB), (const bf16_t*)(ws + WS_WPP), PLED, S, E, wave); }
        REP_END
        SEAM(1);
    }
    if (IN(2)) { REP_BEGIN(2)
        if (rep_) { if (wave == 0 && lane_id_v() == 0) MISC[16] = 0u; __syncthreads(); }
        for (int rg_ = 0; rg_ < P2_NREP(14); ++rg_) p2_moba_gate(args, lds, c, G, wave, lane_id_v());
        __syncthreads();
        p2_indexer_and_convert(args, lds, MISC, c, G, wave, lane_id_v());
        REP_END SEAM(2); }

    if (IN(3)) {
        const unsigned long long* BM = (const unsigned long long*)(ws + WS_BM); const unsigned* SELB = (const unsigned*)(ws + WS_SELB); bf16_t* OAB = (bf16_t*)(ws + WS_OAB);
        REP_BEGIN(3)
        int L = c;
        if (L < 256) {
#define ATT_REF(R, L_, pass_) do { const int bh_ = (L_) >> 4, x_ = (L_) & 15, br_ = bh_ >> 3, h_ = bh_ & 7, qb_ = (pass_) ? 31 - x_ : x_, P0_ = qb_ * 256; \
            const bf16_t* qt_ = QKV7 + (size_t)(br_ ? 4 : 0) * SEQ * BRW; \
            R.Q = qt_ + (size_t)P0_ * BRW + h_ * HD; R.K = qt_ + (size_t)SEQ * BRW + h_ * HD; R.V = qt_ + (size_t)2 * SEQ * BRW + h_ * HD; \
            R.O = OAB + (size_t)P0_ * DM + br_ * BRW + h_ * HD; R.P0 = P0_; R.mode = br_; R.bm = BM + (size_t)P0_ * (SEQ / 64); R.selw = SELB + (size_t)P0_ * NHEAD + h_; } while (0)
            att::BlockRef cur, nxt; int pass = 0; ATT_REF(cur, L, 0);
            att::Seam S;
            att::attn_prime(cur, (char*)lds_raw, S, wave);
            for (;;) {
                const bool more_pass = (pass == 0), more_item = (L + G < 256), last = !more_pass && !more_item;
                int Ln = L, passn = pass + 1;
                if (!more_pass) { passn = 0; Ln = more_item ? L + G : L; }
                if (last) nxt = cur; else ATT_REF(nxt, Ln, passn);
                att::attn_block(cur, nxt, (char*)lds_raw, S, wave);
                if (last) break;
                cur = nxt; pass = passn; L = Ln;
            }
#undef ATT_REF
        }
        REP_END
        SEAM(3);
    }
    if (IN(4)) {
        pg8::DenseOrder S; S.init(SEQ, DM, G, c);
        EpiMerged E{16, (const bf16_t*)(ws + WS_SG), (bf16_t*)(ws + WS_MERGED)};
        REP_BEGIN(4)
        pg8::gemm_phase<EpiMerged, pg8::DenseOrder, false, true>(lds, (const bf16_t*)(ws + WS_OAB), (const bf16_t*)(ws + WS_WBR), DM, S, E, wave);
        REP_END
        SEAM(4);
    }
    if (IN(5)) {
        pg8::DenseOrder S; S.init(SEQ, DM, G, c);
        EpiResF32 E{0, args.in[IN_X], (float*)(ws + WS_X1)};
        REP_BEGIN(5)
        pg8::gemm_phase<EpiResF32, pg8::DenseOrder, false, true>(lds, (const bf16_t*)(ws + WS_MERGED), (const bf16_t*)(ws + WS_WOUT), DM, S, E, wave);
        REP_END
        SEAM(5);
    }
    if (IN(6)) { p6_route(args, lds, c, G, wave, lane_id_v()); SEAM(6); }
    if (IN(7)) {
        const int vcu = (G % 8 == 0) ? (c % 8) * (G / 8) + c / 8 : c;
        MoeOrder S; S.init((const int*)(ctl + CW_CNT), (const int*)(ws + WS_LIST), 16, G, vcu);
        EpiGateUp E{0, (const int*)(ws + WS_LIST), (const float*)(ws + WS_RSL), args.in[IN_BGU], (bf16_t*)(ws + WS_ACT)};
        REP_BEGIN(7)
        pg8::gemm_phase<EpiGateUp, MoeOrder, true, true, true>(lds, (const bf16_t*)(ws + WS_H2U), (const bf16_t*)(ws + WS_WGU), DM, S, E, wave);
        REP_END
        SEAM(7);
    }
    if (IN(8)) {
        const int vcu = (G % 8 == 0) ? (c % 8) * (G / 8) + c / 8 : c;
        MoeOrder S; S.init((const int*)(ctl + CW_CNT), (const int*)(ws + WS_LIST), 8, G, vcu);
        EpiDown E{0, (const int*)(ws + WS_LIST), (const float*)(ws + WS_GTL), args.in[IN_BDOWN], (bf16_t*)(ws + WS_YS)};
        REP_BEGIN(8)
        pg8::gemm_phase<EpiDown, MoeOrder, false, true, true>(lds, (const bf16_t*)(ws + WS_ACT), (const bf16_t*)(ws + WS_WD), DFF, S, E, wave);
        REP_END
        SEAM(8);
    }
    if (IN(9)) { REP_BEGIN(9) p9_x2(args, c, G, wave, lane_id_v()); REP_END SEAM(9); }
    if (IN(10)) {
        pg8::DenseOrder S; S.init(SEQ, DM, G, c);
        EpiPleGate E{0, (const bf16_t*)(ws + WS_PLEB), (bf16_t*)(ws + WS_T), (float*)(ws + WS_TSS)};
        REP_BEGIN(10)
        pg8::gemm_phase<EpiPleGate, pg8::DenseOrder, false, true>(lds, (const bf16_t*)(ws + WS_X2B), (const bf16_t*)(ws + WS_WPG), DM, S, E, wave);
        REP_END
        SEAM(10);
    }
    if (IN(11)) { REP_BEGIN(11) p11_final(args, c, G, wave, lane_id_v()); REP_END }
#undef IN
#undef BOTH
#undef SEAM
#undef NREP
#undef REP_BEGIN
#undef REP_END
}

#ifndef MK_N_LAUNCHES
#define MK_N_LAUNCHES 1
#endif
extern "C" void kernel_launch(void* const* d_in, const int* in_sizes, int n_in, void* d_out, int out_size, void* d_ws, size_t ws_size, hipStream_t stream) {
    static int grid = 0;
    if (grid == 0) {
        if (n_in != 20 || in_sizes[0] != SEQ * DM || out_size != SEQ * DM || ws_size < WS_END) { fprintf(stderr, "kernel_launch: unexpected shapes (n_in %d, in0 %d, out %d, ws %zu)\n", n_in, n_in > 0 ? in_sizes[0] : -1, out_size, ws_size); grid = -1; return; }
        int dev = 0, cus = 0, per_cu = 0;
        if (hipGetDevice(&dev) != hipSuccess || hipDeviceGetAttribute(&cus, hipDeviceAttributeMultiprocessorCount, dev) != hipSuccess) { grid = -1; return; }
        if (hipFuncSetAttribute((const void*)hybrid_fwd, hipFuncAttributeMaxDynamicSharedMemorySize, LDS_BYTES) != hipSuccess) { fprintf(stderr, "kernel_launch: hipFuncSetAttribute failed\n"); grid = -1; return; }
        if (hipOccupancyMaxActiveBlocksPerMultiprocessor(&per_cu, (const void*)hybrid_fwd, NWAVES * 64, LDS_BYTES) != hipSuccess || per_cu < 1) { fprintf(stderr, "kernel_launch: occupancy query says %d blocks per CU\n", per_cu); }
        (void)hipGetLastError();
        grid = cus > 0 ? cus : 256;
    }
    if (grid < 0) return;
    if (hipMemsetAsync((char*)d_ws + WS_CTL, 0, CTL_ZERO_BYTES, stream) != hipSuccess) return;
    Args a{};
    for (int i = 0; i < 20; ++i) a.in[i] = (const float*)d_in[i];
    a.out = (float*)d_out; a.ws = (unsigned char*)d_ws;
    if (MK_N_LAUNCHES == 1) { a.ph_lo = 0; a.ph_hi = N_PHASES; hipLaunchKernelGGL(hybrid_fwd, dim3(grid), dim3(NWAVES * 64), LDS_BYTES, stream, a); }
    else { for (int p = 0; p < N_PHASES; ++p) { a.ph_lo = p; a.ph_hi = p + 1; hipLaunchKernelGGL(hybrid_fwd, dim3(grid), dim3(NWAVES * 64), LDS_BYTES, stream, a); } }
    const hipError_t le = hipPeekAtLastError();
    if (le != hipSuccess) fprintf(stderr, "kernel_launch: launch failed: %s\n", hipGetErrorName(le));
}
```
